# Optimizing an MI355X kernel written in HIP

```python
import math
import jax, jax.numpy as jnp
from jax import lax
import numpy as np

D_MODEL = 1024
BATCH = 1
SEQ = 16384
DEPTH = 2

HEAD_DIM = 64
ROT_DIM = HEAD_DIM // 4
ROPE_THETA = 500000.0
BLK = 128
DSW_HEADS = 8
DSW_WIDTH = DSW_HEADS * HEAD_DIM
DSW_PATTERNS = ((128, 1), (512, 4), (2048, 16))
DIFF_HEADS = 4
DIFF_QK_WIDTH = DIFF_HEADS * 2 * HEAD_DIM
DIFF_V_DIM = 2 * HEAD_DIM
DIFF_WIDTH = DIFF_HEADS * DIFF_V_DIM
ATT_SPLITS = (DSW_WIDTH, DSW_WIDTH, DSW_WIDTH, DSW_WIDTH,
              DIFF_QK_WIDTH, DIFF_QK_WIDTH, DIFF_WIDTH, DIFF_WIDTH)
ATT_IN = sum(ATT_SPLITS)
ATT_OUT_IN = DSW_WIDTH + DIFF_WIDTH
SGU_WIDTH = 2 * D_MODEL
SGU_GROUPS = 8
SGU_CHUNK = 128
SGU_IN = 3 * SGU_WIDTH
N_EVEN = (DEPTH + 1) // 2
N_ODD = DEPTH // 2
RMS_EPS = 1e-6
LN_EPS = 1e-5
NEG_INF = -1e30

kernel_name = "hybrid_dilated_diff_sgu_trunk"


def rms_norm(x, g, eps=RMS_EPS):
    xf = x.astype(jnp.float32)
    y = xf * lax.rsqrt(jnp.mean(xf * xf, axis=-1, keepdims=True) + eps)
    return (y * g.astype(jnp.float32)).astype(x.dtype)


def layer_norm(x, g, b, eps=LN_EPS):
    xf = x.astype(jnp.float32)
    mu = jnp.mean(xf, axis=-1, keepdims=True)
    xc = xf - mu
    y = xc * lax.rsqrt(jnp.mean(xc * xc, axis=-1, keepdims=True) + eps)
    return (y * g.astype(jnp.float32) + b.astype(jnp.float32)).astype(x.dtype)


def rope_tables(seq_len):
    pos = jnp.arange(seq_len, dtype=jnp.float32)
    inv = 1.0 / (ROPE_THETA ** (jnp.arange(0, ROT_DIM, 2, dtype=jnp.float32) / ROT_DIM))
    ang = pos[:, None] * inv[None, :]
    return jnp.cos(ang), jnp.sin(ang)


def partial_rope(x, cos, sin):
    half = ROT_DIM // 2
    shp = (cos.shape[0],) + (1,) * (x.ndim - 3) + (half,)
    c, s = cos.reshape(shp), sin.reshape(shp)
    xf = x.astype(jnp.float32)
    x1, x2 = xf[..., :half], xf[..., half:ROT_DIM]
    out = jnp.concatenate([x1 * c - x2 * s, x2 * c + x1 * s, xf[..., ROT_DIM:]], axis=-1)
    return out.astype(x.dtype)


def dilated_branch(q, k, v, dil, wsub):
    b, s, h, d = q.shape
    unit = dil * BLK
    s_pad = -(-s // unit) * unit
    n_sub = s_pad // dil
    nb = n_sub // BLK

    def to_sub(t):
        t = jnp.pad(t, ((0, 0), (0, s_pad - s), (0, 0), (0, 0)))
        return t.reshape(b, n_sub, dil, h, d).transpose(0, 2, 3, 1, 4).reshape(b, dil, h, nb, BLK, d)

    def with_prev(t):
        prev = jnp.pad(t[:, :, :, :-1], ((0, 0), (0, 0), (0, 0), (1, 0), (0, 0), (0, 0)))
        return jnp.concatenate([prev, t], axis=4)

    qs = to_sub(q)
    kk = with_prev(to_sub(k))
    vv = with_prev(to_sub(v))
    sc = jnp.einsum('brhnqd,brhnkd->brhnqk', qs, kk,
                    preferred_element_type=jnp.float32) * (d ** -0.5)
    qi = jnp.arange(BLK)[:, None] + BLK
    kj = jnp.arange(2 * BLK)[None, :]
    dist = qi - kj
    band = (dist >= 0) & (dist <= wsub)
    has_prev = (jnp.arange(nb)[:, None, None] > 0) | (kj[None] >= BLK)
    mask = band[None] & has_prev
    sc = jnp.where(mask, sc, NEG_INF)
    m = jnp.max(sc, axis=-1, keepdims=True)
    p = jnp.exp(sc - m)
    l = jnp.sum(p, axis=-1, keepdims=True)
    o = jnp.einsum('brhnqk,brhnkd->brhnqd', p.astype(v.dtype), vv,
                   preferred_element_type=jnp.float32) / l
    lse = (m + jnp.log(l))[..., 0]
    o = o.reshape(b, dil, h, n_sub, d).transpose(0, 3, 1, 2, 4).reshape(b, s_pad, h, d)[:, :s]
    lse = lse.reshape(b, dil, h, n_sub).transpose(0, 3, 1, 2).reshape(b, s_pad, h)[:, :s]
    return o, lse


def dsw_attention(q, k, v):
    outs, lses = [], []
    for window, dil in DSW_PATTERNS:
        o, lse = dilated_branch(q, k, v, dil, window // dil)
        outs.append(o)
        lses.append(lse)
    wts = jax.nn.softmax(jnp.stack(lses, axis=0), axis=0)
    return jnp.sum(wts[..., None] * jnp.stack(outs, axis=0), axis=0)


def diff_attention(q, k, v, lam):
    b, s, h, _, d = q.shape
    nblk = s // BLK
    qb = q.reshape(b, nblk, BLK, h, 2, d).transpose(1, 0, 4, 3, 2, 5)
    kt = k.transpose(0, 3, 2, 1, 4)
    vt = v.transpose(0, 2, 1, 3)
    kpos = jnp.arange(s)
    scale = d ** -0.5

    def one_block(args):
        qblk, i = args
        sc = jnp.einsum('bchqd,bchkd->bchqk', qblk, kt,
                        preferred_element_type=jnp.float32) * scale
        qpos = i * BLK + jnp.arange(BLK)
        sc = jnp.where(kpos[None, :] <= qpos[:, None], sc, NEG_INF)
        p = jax.nn.softmax(sc, axis=-1)
        a = p[:, 0] - lam * p[:, 1]
        return jnp.einsum('bhqk,bhkd->bhqd', a.astype(vt.dtype), vt,
                          preferred_element_type=jnp.float32)

    o = lax.map(one_block, (qb, jnp.arange(nblk)))
    return o.transpose(1, 0, 3, 2, 4).reshape(b, s, h, 2 * d)


def hybrid_attention_layer(x, norm_g, w_in, dsw_qg, dsw_kg, diff_qg, diff_kg,
                           lq1, lk1, lq2, lk2, subln_g, w_out, cos, sin, lam_init):
    b, s, _ = x.shape
    h = rms_norm(x, norm_g)
    proj = jnp.einsum('bsd,de->bse', h, w_in)
    offs = [int(o) for o in np.cumsum(ATT_SPLITS)[:-1]]
    qa, ka, va, ga, qd, kd, vd, gd = jnp.split(proj, offs, axis=-1)
    qa = partial_rope(rms_norm(qa.reshape(b, s, DSW_HEADS, HEAD_DIM), dsw_qg), cos, sin)
    ka = partial_rope(rms_norm(ka.reshape(b, s, DSW_HEADS, HEAD_DIM), dsw_kg), cos, sin)
    va = va.reshape(b, s, DSW_HEADS, HEAD_DIM)
    oa = dsw_attention(qa, ka, va).reshape(b, s, DSW_WIDTH)
    qd = partial_rope(rms_norm(qd.reshape(b, s, DIFF_HEADS, 2, HEAD_DIM), diff_qg), cos, sin)
    kd = partial_rope(rms_norm(kd.reshape(b, s, DIFF_HEADS, 2, HEAD_DIM), diff_kg), cos, sin)
    vd = vd.reshape(b, s, DIFF_HEADS, DIFF_V_DIM)
    f32 = jnp.float32
    lam = (jnp.exp(jnp.sum(lq1.astype(f32) * lk1.astype(f32)))
           - jnp.exp(jnp.sum(lq2.astype(f32) * lk2.astype(f32))) + lam_init)
    od = diff_attention(qd, kd, vd, lam)
    od = (rms_norm(od, subln_g) * (1.0 - lam_init)).reshape(b, s, DIFF_WIDTH)
    y = jnp.concatenate([oa.astype(x.dtype) * jax.nn.silu(ga),
                         od.astype(x.dtype) * jax.nn.silu(gd)], axis=-1)
    return x + jnp.einsum('bse,ed->bsd', y, w_out)


def sgu_layer(x, norm_g, w_in, ln_g, ln_b, w_s, b_s, w_out):
    b, s, _ = x.shape
    h = rms_norm(x, norm_g)
    proj = jnp.einsum('bsd,de->bse', h, w_in)
    u, v, g = jnp.split(proj, [SGU_WIDTH, 2 * SGU_WIDTH], axis=-1)
    u = jax.nn.gelu(u, approximate=False)
    v = layer_norm(jax.nn.gelu(v, approximate=False), ln_g, ln_b)
    nc = s // SGU_CHUNK
    vg = v.reshape(b, nc, SGU_CHUNK, SGU_GROUPS, SGU_WIDTH // SGU_GROUPS)
    causal = jnp.tril(jnp.ones((SGU_CHUNK, SGU_CHUNK), dtype=bool))
    ws = jnp.where(causal[None], w_s, 0)
    sp = jnp.einsum('gts,bnsgc->bntgc', ws, vg) + b_s.T[None, None, :, :, None]
    sp = sp.reshape(b, s, SGU_WIDTH)
    y = u * sp * jax.nn.silu(g)
    return x + jnp.einsum('bse,ed->bsd', y, w_out)


def setup_inputs(seed: int = 0) -> dict:
    key = jax.random.key(seed)
    ks = jax.random.split(key, 20)
    nrm = jax.random.normal
    f32 = jnp.float32
    D = D_MODEL
    return {
        "x": nrm(ks[0], (BATCH, SEQ, D), f32),
        "att_norm": 1.0 + 0.02 * nrm(ks[1], (N_EVEN, D), f32),
        "att_w_in": nrm(ks[2], (N_EVEN, D, ATT_IN), f32) * D ** -0.5,
        "dsw_q_norm": 1.0 + 0.02 * nrm(ks[3], (N_EVEN, HEAD_DIM), f32),
        "dsw_k_norm": 1.0 + 0.02 * nrm(ks[4], (N_EVEN, HEAD_DIM), f32),
        "diff_q_norm": 1.0 + 0.02 * nrm(ks[5], (N_EVEN, HEAD_DIM), f32),
        "diff_k_norm": 1.0 + 0.02 * nrm(ks[6], (N_EVEN, HEAD_DIM), f32),
        "diff_lam_q1": 0.1 * nrm(ks[7], (N_EVEN, HEAD_DIM), f32),
        "diff_lam_k1": 0.1 * nrm(ks[8], (N_EVEN, HEAD_DIM), f32),
        "diff_lam_q2": 0.1 * nrm(ks[9], (N_EVEN, HEAD_DIM), f32),
        "diff_lam_k2": 0.1 * nrm(ks[10], (N_EVEN, HEAD_DIM), f32),
        "diff_subln": 1.0 + 0.02 * nrm(ks[11], (N_EVEN, DIFF_V_DIM), f32),
        "att_w_out": nrm(ks[12], (N_EVEN, ATT_OUT_IN, D), f32) * ATT_OUT_IN ** -0.5,
        "sgu_norm": 1.0 + 0.02 * nrm(ks[13], (N_ODD, D), f32),
        "sgu_w_in": nrm(ks[14], (N_ODD, D, SGU_IN), f32) * D ** -0.5,
        "sgu_ln_g": 1.0 + 0.02 * nrm(ks[15], (N_ODD, SGU_WIDTH), f32),
        "sgu_ln_b": 0.02 * nrm(ks[16], (N_ODD, SGU_WIDTH), f32),
        "sgu_w_s": nrm(ks[17], (N_ODD, SGU_GROUPS, SGU_CHUNK, SGU_CHUNK), f32) * SGU_CHUNK ** -0.5,
        "sgu_b_s": 1.0 + 0.1 * nrm(ks[18], (N_ODD, SGU_GROUPS, SGU_CHUNK), f32),
        "sgu_w_out": nrm(ks[19], (N_ODD, SGU_WIDTH, D), f32) * SGU_WIDTH ** -0.5,
    }


def reference(x, att_norm, att_w_in, dsw_q_norm, dsw_k_norm, diff_q_norm, diff_k_norm,
              diff_lam_q1, diff_lam_k1, diff_lam_q2, diff_lam_k2, diff_subln, att_w_out,
              sgu_norm, sgu_w_in, sgu_ln_g, sgu_ln_b, sgu_w_s, sgu_b_s, sgu_w_out):
    cos, sin = rope_tables(x.shape[1])
    for i in range(DEPTH):
        j = i // 2
        if i % 2 == 0:
            lam_init = 0.8 - 0.6 * math.exp(-0.3 * i)
            x = hybrid_attention_layer(
                x, att_norm[j], att_w_in[j], dsw_q_norm[j], dsw_k_norm[j],
                diff_q_norm[j], diff_k_norm[j], diff_lam_q1[j], diff_lam_k1[j],
                diff_lam_q2[j], diff_lam_k2[j], diff_subln[j], att_w_out[j],
                cos, sin, lam_init)
        else:
            x = sgu_layer(x, sgu_norm[j], sgu_w_in[j], sgu_ln_g[j], sgu_ln_b[j],
                          sgu_w_s[j], sgu_b_s[j], sgu_w_out[j])
    return x
```

```cpp
#include <hip/hip_runtime.h>
#include <cstdint>
#include <cstdio>

constexpr int SEQ = 16384, DM = 1024;
constexpr int ATT_IN = 4096, SGU_W = 2048, SGU_IN = 6144;
constexpr float RMS_EPS = 1e-6f, LN_EPS = 1e-5f;
constexpr float C2 = 0.18033688011112042f;
constexpr float LAM_INIT = 0.2f;

typedef unsigned short bf16;
typedef float f32x4 __attribute__((ext_vector_type(4)));
typedef float f32x2 __attribute__((ext_vector_type(2)));

constexpr size_t MiB = 1u << 20;
constexpr size_t WS_CTL = 0;
constexpr size_t WS_ROPE = 1 * MiB;
constexpr size_t WS_W1T = 2 * MiB, WS_WOT = 10 * MiB, WS_W2T = 12 * MiB, WS_W3T = 24 * MiB;
constexpr size_t WS_STAT = 28 * MiB;
constexpr size_t WS_XN = 32 * MiB;
constexpr size_t WS_DO0 = 32 * MiB, WS_DO1 = 48 * MiB;
constexpr size_t WS_QA = 64 * MiB, WS_KA = 80 * MiB, WS_VA = 96 * MiB, WS_QD = 112 * MiB, WS_KD = 128 * MiB, WS_VD = 144 * MiB;
constexpr size_t WS_G = 160 * MiB;
constexpr size_t WS_OP = 192 * MiB;
constexpr size_t WS_LSE = 240 * MiB;
constexpr size_t WS_MUR = 242 * MiB;
constexpr size_t WS_UG = 64 * MiB;
constexpr size_t WS_GV = 128 * MiB;
constexpr size_t WS_END = 256 * MiB;

__device__ __forceinline__ unsigned f2bf(float f) { unsigned u = __builtin_bit_cast(unsigned, f); return (u + 0x7fffu + ((u >> 16) & 1u)) >> 16; }
__device__ __forceinline__ float bf2f(unsigned h) { return __builtin_bit_cast(float, h << 16); }
__device__ __forceinline__ float wave_sum(float v) {
#pragma unroll
    for (int o = 1; o < 64; o <<= 1) v += __shfl_xor(v, o);
    return v;
}
__device__ __forceinline__ float silu_f(float v) { return v / (1.f + __expf(-v)); }
__device__ __forceinline__ float gelu_f(float v) { return 0.5f * v * (1.f + erff(v * 0.70710678118654752f)); }

struct Ptrs {
    const float* x; const float* att_norm; const float* att_w_in; const float* dsw_qg; const float* dsw_kg; const float* diff_qg; const float* diff_kg;
    const float* lq1; const float* lk1; const float* lq2; const float* lk2; const float* subln; const float* att_w_out;
    const float* sgu_norm; const float* sgu_w_in; const float* ln_g; const float* ln_b; const float* w_s; const float* b_s; const float* sgu_w_out;
    float* out; unsigned char* ws;
};

__global__ void k_rope(float2* tab) {
    const int idx = blockIdx.x * blockDim.x + threadIdx.x; if (idx >= SEQ * 8) return;
    const int pos = idx >> 3, i = idx & 7;
    const double inv[8] = {1.0, 0.19392274474868576, 0.03760603093086393, 0.007292664737217109, 0.001414213562373095, 0.0002742481756762073, 5.318295896944988e-05, 1.031338537721246e-05};
    double iv = inv[0];
#pragma unroll
    for (int k = 1; k < 8; ++k) iv = (i == k) ? inv[k] : iv;
    const double ang = (double)pos * iv;
    const double a = ang * 0.63661977236758134308;
    const double q = __builtin_rint(a);
    const double th = (a - q) * 1.57079632679489661923;
    const double t2 = th * th;
    double sn = th * (1.0 + t2 * (-1.0 / 6 + t2 * (1.0 / 120 + t2 * (-1.0 / 5040 + t2 * (1.0 / 362880 + t2 * (-1.0 / 39916800 + t2 * (1.0 / 6227020800.0)))))));
    double cs = 1.0 + t2 * (-0.5 + t2 * (1.0 / 24 + t2 * (-1.0 / 720 + t2 * (1.0 / 40320 + t2 * (-1.0 / 3628800 + t2 * (1.0 / 479001600.0 + t2 * (-1.0 / 87178291200.0)))))));
    const int qi = ((int)q) & 3;
    double c, s;
    if (qi == 0) { c = cs; s = sn; } else if (qi == 1) { c = -sn; s = cs; } else if (qi == 2) { c = -cs; s = -sn; } else { c = sn; s = -cs; }
    tab[idx] = make_float2((float)c, (float)s);
}

__global__ void __launch_bounds__(256) k_rmsnorm(const float* x, const float* g, bf16* out) {
    const int row = blockIdx.x * 4 + (threadIdx.x >> 6), lane = threadIdx.x & 63;
    const f32x4* xr = (const f32x4*)(x + (size_t)row * DM) + lane;
    f32x4 v[4]; float s = 0.f;
#pragma unroll
    for (int j = 0; j < 4; ++j) { v[j] = xr[64 * j]; s += (v[j].x * v[j].x + v[j].y * v[j].y) + (v[j].z * v[j].z + v[j].w * v[j].w); }
    const float r = rsqrtf(wave_sum(s) * (1.f / DM) + RMS_EPS);
    unsigned long long* o8 = (unsigned long long*)(out + (size_t)row * DM) + lane;
#pragma unroll
    for (int j = 0; j < 4; ++j) { const f32x4 gg = ((const f32x4*)g)[lane + 64 * j];
        const unsigned lo = f2bf(v[j].x * r * gg.x) | (f2bf(v[j].y * r * gg.y) << 16), hi = f2bf(v[j].z * r * gg.z) | (f2bf(v[j].w * r * gg.w) << 16);
        o8[64 * j] = (unsigned long long)lo | ((unsigned long long)hi << 32); }
}

struct NEpi { Ptrs p; };
template <int MODE> __global__ void __launch_bounds__(256) k_ngemm(const bf16* A, int lda, const float* B, int N, int K, Ptrs P) {
    __shared__ float As[16][68];
    __shared__ float Bs[16][68];
    __shared__ float Bs2[16][68];
    __shared__ float T[64][65];
    __shared__ float T2[64][65];
    __shared__ float rinv[64];
    constexpr bool DUAL = (MODE == 3);
    const int tid = threadIdx.x, tx = tid & 15, ty = tid >> 4;
    const int row0 = blockIdx.y * 64, grp = blockIdx.x;
    int col0 = grp * 64, col0b = 0;
    bool dual = false;
    if (MODE == 3) { if (grp < 32) { col0 = grp * 64; col0b = 4096 + grp * 64; dual = true; } else { col0 = 2048 + (grp - 32) * 64; } }
    float acc[4][4], acc2[4][4];
#pragma unroll
    for (int i = 0; i < 4; ++i)
#pragma unroll
        for (int j = 0; j < 4; ++j) { acc[i][j] = 0.f; acc2[i][j] = 0.f; }
    for (int k0 = 0; k0 < K; k0 += 16) {
        { const int r = tid >> 2, kk = (tid & 3) * 4; const uint2 a = *(const uint2*)(A + (size_t)(row0 + r) * lda + k0 + kk);
          As[kk + 0][r] = bf2f(a.x & 0xffffu); As[kk + 1][r] = bf2f(a.x >> 16); As[kk + 2][r] = bf2f(a.y & 0xffffu); As[kk + 3][r] = bf2f(a.y >> 16); }
        { const int kk = tid >> 4, c = (tid & 15) * 4; const f32x4 b = *(const f32x4*)(B + (size_t)(k0 + kk) * N + col0 + c);
          Bs[kk][c] = b.x; Bs[kk][c + 1] = b.y; Bs[kk][c + 2] = b.z; Bs[kk][c + 3] = b.w;
          if (DUAL && dual) { const f32x4 b2 = *(const f32x4*)(B + (size_t)(k0 + kk) * N + col0b + c); Bs2[kk][c] = b2.x; Bs2[kk][c + 1] = b2.y; Bs2[kk][c + 2] = b2.z; Bs2[kk][c + 3] = b2.w; } }
        __syncthreads();
#pragma unroll
        for (int k = 0; k < 16; ++k) {
            float a[4], b[4], b2[4];
#pragma unroll
            for (int i = 0; i < 4; ++i) { a[i] = As[k][ty * 4 + i]; b[i] = Bs[k][tx * 4 + i]; b2[i] = DUAL ? Bs2[k][tx * 4 + i] : 0.f; }
#pragma unroll
            for (int i = 0; i < 4; ++i)
#pragma unroll
                for (int j = 0; j < 4; ++j) { acc[i][j] += a[i] * b[j]; if (DUAL) acc2[i][j] += a[i] * b2[j]; }
        }
        __syncthreads();
    }
#pragma unroll
    for (int i = 0; i < 4; ++i)
#pragma unroll
        for (int j = 0; j < 4; ++j) { T[ty * 4 + i][tx * 4 + j] = acc[i][j]; if (DUAL) T2[ty * 4 + i][tx * 4 + j] = acc2[i][j]; }
    __syncthreads();
    unsigned char* ws = P.ws;
    if (MODE == 1) {
        const int type = grp >> 3, hd = grp & 7;
        const bool isq = (type == 0 || type == 4), isk = (type == 1 || type == 5), isg = (type == 3 || type == 7);
        const float* gain = (type == 0) ? P.dsw_qg : (type == 1) ? P.dsw_kg : (type == 4) ? P.diff_qg : P.diff_kg;
        if (isq || isk) {
            if (tid < 64) { float ss = 0.f; for (int j = 0; j < 64; ++j) ss += T[tid][j] * T[tid][j]; rinv[tid] = rsqrtf(ss * (1.f / 64.f) + RMS_EPS); }
            __syncthreads();
        }
        bf16* dst; int pitch, cb;
        if (type == 0) { dst = (bf16*)(ws + WS_QA); pitch = 512; cb = hd * 64; } else if (type == 1) { dst = (bf16*)(ws + WS_KA); pitch = 512; cb = hd * 64; }
        else if (type == 2) { dst = (bf16*)(ws + WS_VA); pitch = 512; cb = hd * 64; } else if (type == 3) { dst = (bf16*)(ws + WS_G); pitch = 1024; cb = hd * 64; }
        else if (type == 4) { dst = (bf16*)(ws + WS_QD); pitch = 512; cb = hd * 64; } else if (type == 5) { dst = (bf16*)(ws + WS_KD); pitch = 512; cb = hd * 64; }
        else if (type == 6) { dst = (bf16*)(ws + WS_VD); pitch = 512; cb = hd * 64; } else { dst = (bf16*)(ws + WS_G); pitch = 1024; cb = 512 + hd * 64; }
        const float2* tab = (const float2*)(ws + WS_ROPE);
        const int r = tid >> 2;
        for (int jj = 0; jj < 16; ++jj) {
            const int j = (tid & 3) * 16 + jj; float val = T[r][j];
            if (isq || isk) {
                const float ri = rinv[r];
                val = val * ri * gain[j];
                if (j < 16) { const int i = j & 7; const float2 cs = tab[(size_t)(row0 + r) * 8 + i];
                    const float x1 = T[r][i] * ri * gain[i], x2 = T[r][i + 8] * ri * gain[i + 8];
                    val = (j < 8) ? (x1 * cs.x - x2 * cs.y) : (x2 * cs.x + x1 * cs.y); }
                if (isq) val *= C2;
            } else if (isg) val = silu_f(val);
            dst[(size_t)(row0 + r) * pitch + cb + j] = (bf16)f2bf(val);
        }
    } else if (MODE == 2) {
        const int r = tid >> 2;
        for (int jj = 0; jj < 16; ++jj) { const int j = (tid & 3) * 16 + jj; const size_t o = (size_t)(row0 + r) * DM + col0 + j; P.out[o] = P.x[o] + T[r][j]; }
    } else if (MODE == 3) {
        const int r = tid >> 2;
        if (dual) {
            bf16* ug = (bf16*)(ws + WS_UG);
            for (int jj = 0; jj < 16; ++jj) { const int j = (tid & 3) * 16 + jj; ug[(size_t)(row0 + r) * SGU_W + col0 + j] = (bf16)f2bf(gelu_f(T[r][j]) * silu_f(T2[r][j])); }
        } else {
            bf16* gv = (bf16*)(ws + WS_GV);
            for (int jj = 0; jj < 16; ++jj) { const int j = (tid & 3) * 16 + jj; const float v = gelu_f(T[r][j]); T[r][j] = v; gv[(size_t)(row0 + r) * SGU_W + (col0 - 2048) + j] = (bf16)f2bf(v); }
            __syncthreads();
            if (tid < 64) { float s = 0.f, s2 = 0.f; for (int j = 0; j < 64; ++j) { const float v = T[tid][j]; s += v; s2 += v * v; }
                ((float2*)(ws + WS_STAT))[(size_t)(row0 + tid) * 32 + (grp - 32)] = make_float2(s, s2); }
        }
    } else {
        const int r = tid >> 2;
        for (int jj = 0; jj < 16; ++jj) { const int j = (tid & 3) * 16 + jj; const size_t o = (size_t)(row0 + r) * DM + col0 + j; P.out[o] = P.out[o] + T[r][j]; }
    }
}

__global__ void __launch_bounds__(256) k_ndsw(Ptrs P) {
    const int w = blockIdx.x * 4 + (threadIdx.x >> 6), lane = threadIdx.x & 63;
    const int p = w / (SEQ * 8), rem = w % (SEQ * 8), t = rem >> 3, h = rem & 7;
    const int dil = (p == 0) ? 1 : (p == 1) ? 4 : 16;
    const bf16* QA = (const bf16*)(P.ws + WS_QA); const bf16* KA = (const bf16*)(P.ws + WS_KA); const bf16* VA = (const bf16*)(P.ws + WS_VA);
    const float q = bf2f(QA[(size_t)t * 512 + h * 64 + lane]);
    float m = -INFINITY, l = 0.f, o = 0.f;
    for (int j = 0; j <= 128; ++j) {
        const int tk = t - j * dil; if (tk < 0) break;
        const float s = wave_sum(q * bf2f(KA[(size_t)tk * 512 + h * 64 + lane]));
        const float mn = fmaxf(m, s), a = exp2f(m - mn), pe = exp2f(s - mn);
        l = l * a + pe; o = o * a + pe * bf2f(VA[(size_t)tk * 512 + h * 64 + lane]); m = mn;
    }
    ((bf16*)(P.ws + WS_OP))[((size_t)p * SEQ + t) * 512 + h * 64 + lane] = (bf16)f2bf(o / l);
    if (lane == 0) ((float*)(P.ws + WS_LSE))[((size_t)p * SEQ + t) * 8 + h] = m + log2f(l);
}
__global__ void __launch_bounds__(256) k_ndiff(Ptrs P) {
    const int w = blockIdx.x * 4 + (threadIdx.x >> 6), lane = threadIdx.x & 63;
    const int t = SEQ - 1 - (w >> 3), vq = w & 7, h = vq >> 1, c = vq & 1;
    const bf16* QD = (const bf16*)(P.ws + WS_QD); const bf16* KD = (const bf16*)(P.ws + WS_KD); const bf16* VD = (const bf16*)(P.ws + WS_VD);
    const float q = bf2f(QD[(size_t)t * 512 + vq * 64 + lane]);
    float m = -INFINITY, l = 0.f, o0 = 0.f, o1 = 0.f;
    int tk = 0;
    for (; tk + 3 <= t; tk += 4) {
        float s[4];
#pragma unroll
        for (int u = 0; u < 4; ++u) s[u] = q * bf2f(KD[(size_t)(tk + u) * 512 + vq * 64 + lane]);
#pragma unroll
        for (int o = 1; o < 64; o <<= 1) {
#pragma unroll
            for (int u = 0; u < 4; ++u) s[u] += __shfl_xor(s[u], o); }
        const float mn = fmaxf(fmaxf(m, fmaxf(s[0], s[1])), fmaxf(s[2], s[3])), a = exp2f(m - mn);
        l *= a; o0 *= a; o1 *= a; m = mn;
#pragma unroll
        for (int u = 0; u < 4; ++u) { const float pe = exp2f(s[u] - mn); l += pe;
            o0 += pe * bf2f(VD[(size_t)(tk + u) * 512 + h * 128 + lane]); o1 += pe * bf2f(VD[(size_t)(tk + u) * 512 + h * 128 + 64 + lane]); }
    }
    for (; tk <= t; ++tk) {
        const float s = wave_sum(q * bf2f(KD[(size_t)tk * 512 + vq * 64 + lane]));
        const float mn = fmaxf(m, s), a = exp2f(m - mn), pe = exp2f(s - mn);
        l = l * a + pe; o0 = o0 * a + pe * bf2f(VD[(size_t)tk * 512 + h * 128 + lane]); o1 = o1 * a + pe * bf2f(VD[(size_t)tk * 512 + h * 128 + 64 + lane]); m = mn;
    }
    bf16* O = (bf16*)(P.ws + (c ? WS_DO1 : WS_DO0));
    O[(size_t)t * 512 + h * 128 + lane] = (bf16)f2bf(o0 / l); O[(size_t)t * 512 + h * 128 + 64 + lane] = (bf16)f2bf(o1 / l);
}

__device__ __forceinline__ void merge_row(const Ptrs& P, int t, int lane, float lam) {
    unsigned char* ws = P.ws;
    bf16* G = (bf16*)(ws + WS_G) + (size_t)t * 1024 + lane * 16;
    const uint4 g0 = *(const uint4*)G, g1 = *(const uint4*)(G + 8);
    const unsigned gw[8] = {g0.x, g0.y, g0.z, g0.w, g1.x, g1.y, g1.z, g1.w};
    float y[16];
    if (lane < 32) {
        const int h = lane >> 2; const float* L = (const float*)(ws + WS_LSE);
        const float l0 = L[((size_t)0 * SEQ + t) * 8 + h], l1 = L[((size_t)1 * SEQ + t) * 8 + h], l2 = L[((size_t)2 * SEQ + t) * 8 + h];
        const float mx = fmaxf(l0, fmaxf(l1, l2)); float w0 = exp2f(l0 - mx), w1 = exp2f(l1 - mx), w2 = exp2f(l2 - mx); const float wi = 1.f / (w0 + w1 + w2); w0 *= wi; w1 *= wi; w2 *= wi;
        const bf16* O = (const bf16*)(ws + WS_OP) + (size_t)t * 512 + lane * 16;
        const float wt[3] = {w0, w1, w2};
#pragma unroll
        for (int i = 0; i < 16; ++i) y[i] = 0.f;
#pragma unroll
        for (int p = 0; p < 3; ++p) { const uint4 a = *(const uint4*)(O + (size_t)p * SEQ * 512), b = *(const uint4*)(O + (size_t)p * SEQ * 512 + 8);
            const unsigned ow[8] = {a.x, a.y, a.z, a.w, b.x, b.y, b.z, b.w};
#pragma unroll
            for (int i = 0; i < 8; ++i) { y[2 * i] += wt[p] * bf2f(ow[i] & 0xffffu); y[2 * i + 1] += wt[p] * bf2f(ow[i] >> 16); } }
    } else {
        const int cidx = (lane - 32) * 16;
        const bf16* A = (const bf16*)(ws + WS_DO0) + (size_t)t * 512 + cidx; const bf16* B = (const bf16*)(ws + WS_DO1) + (size_t)t * 512 + cidx;
        const uint4 a0 = *(const uint4*)A, a1 = *(const uint4*)(A + 8), b0 = *(const uint4*)B, b1 = *(const uint4*)(B + 8);
        const unsigned aw[8] = {a0.x, a0.y, a0.z, a0.w, a1.x, a1.y, a1.z, a1.w}, bw[8] = {b0.x, b0.y, b0.z, b0.w, b1.x, b1.y, b1.z, b1.w};
#pragma unroll
        for (int i = 0; i < 8; ++i) { y[2 * i] = bf2f(aw[i] & 0xffffu) - lam * bf2f(bw[i] & 0xffffu); y[2 * i + 1] = bf2f(aw[i] >> 16) - lam * bf2f(bw[i] >> 16); }
    }
    float ss = 0.f;
#pragma unroll
    for (int i = 0; i < 16; ++i) ss += y[i] * y[i];
    ss += __shfl_xor(ss, 1); ss += __shfl_xor(ss, 2); ss += __shfl_xor(ss, 4);
    if (lane >= 32) {
        const float r = rsqrtf(ss * (1.f / 128.f) + RMS_EPS) * (1.f - LAM_INIT);
        const float* sg = P.subln + ((lane - 32) & 7) * 16;
#pragma unroll
        for (int i = 0; i < 16; ++i) y[i] = y[i] * r * sg[i];
    }
    unsigned ow[8];
#pragma unroll
    for (int i = 0; i < 8; ++i) ow[i] = f2bf(y[2 * i] * bf2f(gw[i] & 0xffffu)) | (f2bf(y[2 * i + 1] * bf2f(gw[i] >> 16)) << 16);
    *(uint4*)G = make_uint4(ow[0], ow[1], ow[2], ow[3]); *(uint4*)(G + 8) = make_uint4(ow[4], ow[5], ow[6], ow[7]);
}
__device__ __forceinline__ float lam_value(const Ptrs& P, int lane) {
    const float a = wave_sum(P.lq1[lane] * P.lk1[lane]), b = wave_sum(P.lq2[lane] * P.lk2[lane]);
    return expf(a) - expf(b) + LAM_INIT;
}
__global__ void __launch_bounds__(256) k_merge(Ptrs P) {
    const int t = blockIdx.x * 4 + (threadIdx.x >> 6), lane = threadIdx.x & 63;
    const float lam = lam_value(P, lane);
    merge_row(P, t, lane, lam);
}

__global__ void k_nstats(Ptrs P) {
    const int t = blockIdx.x * blockDim.x + threadIdx.x; if (t >= SEQ) return;
    const float2* st = (const float2*)(P.ws + WS_STAT) + (size_t)t * 32; float s = 0.f, s2 = 0.f;
    for (int i = 0; i < 32; ++i) { s += st[i].x; s2 += st[i].y; }
    const float mu = s * (1.f / SGU_W), var = s2 * (1.f / SGU_W) - mu * mu;
    ((float2*)(P.ws + WS_MUR))[t] = make_float2(mu, rsqrtf(var + LN_EPS));
}
__global__ void __launch_bounds__(256) k_nsgu(Ptrs P) {
    const int n = blockIdx.x >> 3, g = blockIdx.x & 7, c = g * 256 + threadIdx.x;
    const bf16* GV = (const bf16*)(P.ws + WS_GV); bf16* UG = (bf16*)(P.ws + WS_UG); const float2* mur = (const float2*)(P.ws + WS_MUR);
    const float lg = P.ln_g[c], lb = P.ln_b[c];
    for (int t = 0; t < 128; ++t) {
        const float* wrow = P.w_s + ((size_t)g * 128 + t) * 128; float acc = 0.f;
        for (int s = 0; s <= t; ++s) { const float2 mr = mur[n * 128 + s]; const float vn = (bf2f(GV[(size_t)(n * 128 + s) * SGU_W + c]) - mr.x) * mr.y * lg + lb; acc += wrow[s] * vn; }
        acc += P.b_s[g * 128 + t];
        const size_t o = (size_t)(n * 128 + t) * SGU_W + c;
        UG[o] = (bf16)f2bf(bf2f(UG[o]) * acc);
    }
}

extern "C" void kernel_launch(void* const* d_in, const int* in_sizes, int n_in, void* d_out, int out_size, void* d_ws, size_t ws_size, hipStream_t stream) {
    if (n_in != 20 || out_size != SEQ * DM || ws_size < WS_END) { fprintf(stderr, "kernel_launch: unexpected shapes (n_in %d out %d ws %zu)\n", n_in, out_size, ws_size); return; }
    Ptrs P{};
    const float** pp = (const float**)&P;
    for (int i = 0; i < 20; ++i) pp[i] = (const float*)d_in[i];
    P.out = (float*)d_out; P.ws = (unsigned char*)d_ws;
    unsigned char* ws = P.ws;
    k_rope<<<SEQ * 8 / 256, 256, 0, stream>>>((float2*)(ws + WS_ROPE));
    k_rmsnorm<<<SEQ / 4, 256, 0, stream>>>(P.x, P.att_norm, (bf16*)(ws + WS_XN));
    k_ngemm<1><<<dim3(64, SEQ / 64), 256, 0, stream>>>((const bf16*)(ws + WS_XN), DM, P.att_w_in, ATT_IN, DM, P);
    k_ndsw<<<3 * SEQ * 8 / 4, 256, 0, stream>>>(P);
    k_ndiff<<<SEQ * 8 / 4, 256, 0, stream>>>(P);
    k_merge<<<SEQ / 4, 256, 0, stream>>>(P);
    k_ngemm<2><<<dim3(16, SEQ / 64), 256, 0, stream>>>((const bf16*)(ws + WS_G), DM, P.att_w_out, DM, DM, P);
    k_rmsnorm<<<SEQ / 4, 256, 0, stream>>>(P.out, P.sgu_norm, (bf16*)(ws + WS_XN));
    k_ngemm<3><<<dim3(64, SEQ / 64), 256, 0, stream>>>((const bf16*)(ws + WS_XN), DM, P.sgu_w_in, SGU_IN, DM, P);
    k_nstats<<<SEQ / 256, 256, 0, stream>>>(P);
    k_nsgu<<<128 * 8, 256, 0, stream>>>(P);
    k_ngemm<4><<<dim3(16, SEQ / 64), 256, 0, stream>>>((const bf16*)(ws + WS_UG), SGU_W, P.sgu_w_out, DM, SGU_W, P);
}
```

```cpp
#include <hip/hip_runtime.h>
#include <hip/hip_bf16.h>
#include <cstdint>
#include <cstdio>
#include <cmath>

constexpr int SEQ = 16384, DM = 1024;
constexpr int ATT_IN = 4096, SGU_W = 2048, SGU_IN = 6144;
constexpr float RMS_EPS = 1e-6f, LN_EPS = 1e-5f;
constexpr float C2 = 0.18033688011112042f;
constexpr float LAM_INIT = 0.2f;

typedef unsigned short bf16;
typedef float f32x4 __attribute__((ext_vector_type(4)));

constexpr size_t MiB = 1u << 20;
constexpr size_t WS_CTL = 0, CTL_ZERO_BYTES = 1 * MiB;
constexpr size_t WS_ROPE = 1 * MiB;
constexpr size_t WS_W1T = 2 * MiB, WS_WOT = 10 * MiB, WS_W2T = 12 * MiB, WS_W3T = 24 * MiB;
constexpr size_t WS_STAT = 28 * MiB;
constexpr size_t WS_XN = 32 * MiB;
constexpr size_t WS_DO0 = 32 * MiB, WS_DO1 = 48 * MiB;
constexpr size_t WS_QA = 64 * MiB, WS_KA = 80 * MiB, WS_VA = 96 * MiB, WS_QD = 112 * MiB, WS_KD = 128 * MiB, WS_VD = 144 * MiB;
constexpr size_t WS_G = 160 * MiB;
constexpr size_t WS_OP = 192 * MiB;
constexpr size_t WS_LSE = 240 * MiB;
constexpr size_t WS_MUR = 242 * MiB;
constexpr size_t WS_WSB = 243 * MiB;
constexpr size_t WS_GAIN = 243 * MiB + 262144;
constexpr size_t WS_UG = 64 * MiB;
constexpr size_t WS_GV = 128 * MiB;
constexpr size_t WS_END = 256 * MiB;

__device__ __forceinline__ float bf2f(unsigned h) { return __builtin_bit_cast(float, h << 16); }
__device__ __forceinline__ float wave_sum(float v) {
#pragma unroll
    for (int o = 1; o < 64; o <<= 1) v += __shfl_xor(v, o);
    return v;
}
__device__ __forceinline__ float silu_f(float v) { return v / (1.f + __expf(-v)); }
__device__ __forceinline__ float gelu_f(float v) { return 0.5f * v * (1.f + erff(v * 0.70710678118654752f)); }

__device__ __forceinline__ int opaque_lane() { unsigned m = ~0u; asm volatile("" : "+s"(m)); return (int)__builtin_amdgcn_mbcnt_hi(m, __builtin_amdgcn_mbcnt_lo(m, 0u)); }

struct Ptrs {
    const float* x; const float* att_norm; const float* att_w_in; const float* dsw_qg; const float* dsw_kg; const float* diff_qg; const float* diff_kg;
    const float* lq1; const float* lk1; const float* lq2; const float* lk2; const float* subln; const float* att_w_out;
    const float* sgu_norm; const float* sgu_w_in; const float* ln_g; const float* ln_b; const float* w_s; const float* b_s; const float* sgu_w_out;
    float* out; unsigned char* ws;
};
#define FAST_MASK 0x1FF
#define DEBUG_NAIVE 0
namespace pg8 {
#define PG8_LAS __attribute__((address_space(3)))
typedef unsigned short bf16_t;
typedef short bf16x8 __attribute__((ext_vector_type(8)));
typedef float f32x4 __attribute__((ext_vector_type(4)));
typedef unsigned u32x4 __attribute__((ext_vector_type(4)));
constexpr int BM = 256, BK = 64, HALF = 128, HTB = HALF * BK * 2  , STAGE_BYTES = 8 * HTB, NXCD = 8, WGM = 8;

__host__ __device__ __forceinline__ int lds_byte(int r, int c) { const int st = (r >> 4) * 2 + (c >> 5), rr = r & 15, cc = c & 31, ob = rr * 64 + cc * 2; return st * 1024 + (ob ^ (((ob >> 9) & 1) << 5)); }
__host__ __device__ __forceinline__ void stage_rc(int b, int& R, int& C) { const int st = b / 1024, sb = b % 1024, swz = sb ^ (((sb >> 9) & 1) << 5); R = (st >> 1) * 16 + swz / 64; C = (st & 1) * 32 + (swz % 64) / 2; }
__host__ __device__ __forceinline__ int perm32(int rho) { const int n = rho >> 4, i = rho & 15; return 8 * (i >> 2) + 4 * n + (i & 3); }

struct Unit { int pm, pn; };
struct Gemm { const bf16_t* A; const bf16_t* Bt; int M, N, K; };

struct StaticOrder {
    int nM, nN, nwg, G, c;
    __host__ __device__ void init(int M, int N, int G_, int c_) { nM = M / BM; nN = N / BM; nwg = nM * nN; G = G_; c = c_; }
    __host__ __device__ bool next(int i, Unit& u) const {
        const long L = (long)i * G + c; if (L >= nwg) return false;
        int wgid = (int)L; { const int q = nwg / NXCD, r = nwg % NXCD, xcd = wgid % NXCD, off = wgid / NXCD; wgid = (xcd < r ? xcd * (q + 1) : r * (q + 1) + (xcd - r) * q) + off; }
        const int nig = WGM * nN, gid = wgid / nig, fm = gid * WGM, gsz = (nM - fm) < WGM ? (nM - fm) : WGM;
        u.pm = fm + ((wgid % nig) % gsz); u.pn = (wgid % nig) / gsz; return true;
    }
    __device__ __forceinline__ void a_ready(const Unit&) const {}
    __device__ __forceinline__ void done(const Unit&) const {}
};

__device__ __forceinline__ unsigned cvt_pk_bf16(float lo, float hi) { unsigned r; asm volatile("v_cvt_pk_bf16_f32 %0, %1, %2" : "=v"(r) : "v"(lo), "v"(hi)); return r; }
typedef float f32x2 __attribute__((ext_vector_type(2)));
__device__ __forceinline__ f32x2 gelu_pk(f32x2 v) {
    const f32x2 av = __builtin_elementwise_abs(v), d = av * 0.2316418882f + 1.0f;
    f32x2 t; t.x = __builtin_amdgcn_rcpf(d.x); t.y = __builtin_amdgcn_rcpf(d.y);
    f32x2 q = t * 0.5307027145f + (-0.7265760135f); q = q * t + 0.7107068705f; q = q * t + (-0.142248368f); q = q * t + 0.127414796f; q = q * t;
    const f32x2 s = (v * v) * (-0.72134752044f);
    f32x2 e; e.x = __builtin_amdgcn_exp2f(s.x); e.y = __builtin_amdgcn_exp2f(s.y);
    const f32x2 m = v * (q * e), r = v - m;
    f32x2 o; o.x = v.x < 0.f ? m.x : r.x; o.y = v.y < 0.f ? m.y : r.y; return o;
}
typedef float f32x2e __attribute__((ext_vector_type(2)));
__device__ __forceinline__ f32x4 silu4(f32x4 v) { f32x4 o; o.x = v.x / (1.f + __expf(-v.x)); o.y = v.y / (1.f + __expf(-v.y)); o.z = v.z / (1.f + __expf(-v.z)); o.w = v.w / (1.f + __expf(-v.w)); return o; }
__device__ __forceinline__ f32x4 gelu4(f32x4 v) { const f32x2 a = gelu_pk((f32x2){v.x, v.y}), b = gelu_pk((f32x2){v.z, v.w}); return (f32x4){a.x, a.y, b.x, b.y}; }
__device__ __forceinline__ u32x4 pack8(f32x4 a, f32x4 b) { u32x4 w; w.x = cvt_pk_bf16(a.x, a.y); w.y = cvt_pk_bf16(a.z, a.w); w.z = cvt_pk_bf16(b.x, b.y); w.w = cvt_pk_bf16(b.z, b.w); return w; }

struct EpiProj1 {
    static constexpr bool PERM = true, AFTER_DRAIN = false;
    unsigned char* ws;
    __device__ __forceinline__ void operator()(const f32x4 (&acc)[2][2][4][2], const Unit& u, int wr, int wc, int fr, int fq) const {
        const int type = u.pn >> 1;
        const int row0 = u.pm * BM + wr * 64 + fr;
        const int hcol = (u.pn & 1) * 256 + wc * 64 + 8 * fq;
        const bool isg = (type & 3) == 3;
        const int slot = type - (type >> 2);
        const size_t boff = isg ? (WS_G + (size_t)(type >> 2) * 1024) : (WS_QA + (size_t)slot * (16 * MiB));
        const int pitch = isg ? 1024 : 512;
        bf16_t* dst = (bf16_t*)(ws + boff) + hcol;
        if ((type & 2) == 0) {
            const float* gp = (const float*)(ws + WS_GAIN) + ((type & 1) + 2 * (type >> 2)) * 64;
            const float qs = (type & 1) ? 1.f : C2;
            f32x4 gn[2][2];
#pragma unroll
            for (int bj = 0; bj < 2; ++bj)
#pragma unroll
                for (int n = 0; n < 2; ++n) gn[bj][n] = *(const f32x4*)(gp + 32 * bj + 8 * fq + 4 * n);
            const float2* tab = (const float2*)(ws + WS_ROPE);
#pragma unroll
            for (int ai = 0; ai < 2; ++ai)
#pragma unroll
                for (int m = 0; m < 4; ++m) {
                    const int row = row0 + ai * HALF + m * 16;
                    f32x4 v[2][2]; float ss = 0.f;
#pragma unroll
                    for (int bj = 0; bj < 2; ++bj)
#pragma unroll
                        for (int n = 0; n < 2; ++n) { v[bj][n] = acc[ai][bj][m][n]; const f32x4 q = v[bj][n] * v[bj][n]; ss += (q.x + q.y) + (q.z + q.w); }
                    ss += __shfl_xor(ss, 16); ss += __shfl_xor(ss, 32);
                    const float ri = rsqrtf(ss * (1.f / 64.f) + RMS_EPS) * qs;
#pragma unroll
                    for (int bj = 0; bj < 2; ++bj)
#pragma unroll
                        for (int n = 0; n < 2; ++n) v[bj][n] = v[bj][n] * ri * gn[bj][n];
                    f32x4 ot[2];
#pragma unroll
                    for (int n = 0; n < 2; ++n) { ot[n].x = __shfl_xor(v[0][n].x, 16); ot[n].y = __shfl_xor(v[0][n].y, 16); ot[n].z = __shfl_xor(v[0][n].z, 16); ot[n].w = __shfl_xor(v[0][n].w, 16); }
                    if (fq < 2) {
                        const f32x4* tp = (const f32x4*)(tab + (size_t)row * 8);
                        const float sg = (fq == 0) ? -1.f : 1.f;
#pragma unroll
                        for (int n = 0; n < 2; ++n) { const f32x4 t0 = tp[2 * n], t1 = tp[2 * n + 1];
                            v[0][n].x = v[0][n].x * t0.x + sg * ot[n].x * t0.y; v[0][n].y = v[0][n].y * t0.z + sg * ot[n].y * t0.w;
                            v[0][n].z = v[0][n].z * t1.x + sg * ot[n].z * t1.y; v[0][n].w = v[0][n].w * t1.z + sg * ot[n].w * t1.w; }
                    }
                    bf16_t* rowp = dst + (size_t)row * pitch;
                    *(u32x4*)(rowp) = pack8(v[0][0], v[0][1]); *(u32x4*)(rowp + 32) = pack8(v[1][0], v[1][1]);
                }
        } else {
            const bool gate = (type & 1);
#pragma unroll
            for (int ai = 0; ai < 2; ++ai)
#pragma unroll
                for (int m = 0; m < 4; ++m) {
                    bf16_t* rowp = dst + (size_t)(row0 + ai * HALF + m * 16) * pitch;
#pragma unroll
                    for (int bj = 0; bj < 2; ++bj) { f32x4 a = acc[ai][bj][m][0], b = acc[ai][bj][m][1]; if (gate) { a = silu4(a); b = silu4(b); }
                        *(u32x4*)(rowp + 32 * bj) = pack8(a, b); }
                }
        }
    }
};
struct EpiRes {
    static constexpr bool PERM = false, AFTER_DRAIN = false;
    const float* base; float* out;
    __device__ __forceinline__ void operator()(const f32x4 (&acc)[2][2][4][2], const Unit& u, int wr, int wc, int fr, int fq) const {
        const int row0 = u.pm * BM + wr * 64 + fr, col0 = u.pn * BM + wc * 32 + 4 * fq;
#pragma unroll
        for (int ai = 0; ai < 2; ++ai)
#pragma unroll
            for (int m = 0; m < 4; ++m) { const size_t off = (size_t)(row0 + ai * HALF + m * 16) * DM + col0;
#pragma unroll
                for (int bj = 0; bj < 2; ++bj)
#pragma unroll
                    for (int n = 0; n < 2; ++n) { const f32x4 b = *(const f32x4*)(base + off + bj * HALF + n * 16); *(f32x4*)(out + off + bj * HALF + n * 16) = b + acc[ai][bj][m][n]; } }
    }
};
struct EpiProj2 {
    static constexpr bool PERM = true, AFTER_DRAIN = false;
    unsigned char* ws;
    __device__ __forceinline__ void operator()(const f32x4 (&acc)[2][2][4][2], const Unit& u, int wr, int wc, int fr, int fq) const {
        const int row0 = u.pm * BM + wr * 64 + fr;
        if (u.pn < 16) {
            bf16_t* dst = (bf16_t*)(ws + WS_UG) + u.pn * 128 + wc * 32 + 8 * fq;
#pragma unroll
            for (int ai = 0; ai < 2; ++ai)
#pragma unroll
                for (int m = 0; m < 4; ++m) {
                    const f32x4 a = gelu4(acc[ai][0][m][0]) * silu4(acc[ai][1][m][0]), b = gelu4(acc[ai][0][m][1]) * silu4(acc[ai][1][m][1]);
                    *(u32x4*)(dst + (size_t)(row0 + ai * HALF + m * 16) * SGU_W) = pack8(a, b);
                }
        } else {
            const int t = u.pn - 16;
            bf16_t* dst = (bf16_t*)(ws + WS_GV) + t * 256 + wc * 32 + 8 * fq;
            float2* st = (float2*)(ws + WS_STAT) + t * 4 + wc;
#pragma unroll
            for (int ai = 0; ai < 2; ++ai)
#pragma unroll
                for (int m = 0; m < 4; ++m) {
                    const int row = row0 + ai * HALF + m * 16; float s = 0.f, s2 = 0.f;
#pragma unroll
                    for (int bj = 0; bj < 2; ++bj) { const f32x4 a = gelu4(acc[ai][bj][m][0]), b = gelu4(acc[ai][bj][m][1]);
                        s += ((a.x + a.y) + (a.z + a.w)) + ((b.x + b.y) + (b.z + b.w));
                        s2 += ((a.x * a.x + a.y * a.y) + (a.z * a.z + a.w * a.w)) + ((b.x * b.x + b.y * b.y) + (b.z * b.z + b.w * b.w));
                        *(u32x4*)(dst + (size_t)row * SGU_W + bj * HALF) = pack8(a, b); }
                    s += __shfl_xor(s, 16); s += __shfl_xor(s, 32); s2 += __shfl_xor(s2, 16); s2 += __shfl_xor(s2, 32);
                    if (fq == 0) st[(size_t)row * 32] = make_float2(s, s2);
                }
        }
    }
};
template <class Epi, class Sched, bool ALIGN_EPI = false, bool SP2 = false>
__device__ __forceinline__ void gemm_phase(PG8_LAS unsigned char* lds, const Gemm g, const Sched& S, const Epi& E, const int wave_) {
    const int tid = wave_ * 64 + opaque_lane(), wid = wave_    , lane = tid & 63, wr = wid >> 2, wc = wid & 3, fr = lane & 15, fq = lane >> 4;
    const int K = g.K, nt = K / BK;
    unsigned voffA[2], voffB[2];
#pragma unroll
    for (int i = 0; i < 2; ++i) { int R, C; stage_rc(tid * 16 + i * 8192, R, C); const int Rb = Epi::PERM ? ((R & ~31) + perm32(R & 31)) : R;
        voffA[i] = (unsigned)(R * K + C) * 2u; voffB[i] = (unsigned)(Rb * K + C) * 2u; }
    const size_t kstep = (size_t)(BK * 2);
    const size_t hstep = (size_t)HALF * K * 2;
    const size_t tstep = 2 * hstep;
    const unsigned ldsw = (unsigned)wid * 1024u;
    const int aoff = lds_byte(wr * 64 + fr, fq * 8), boff = lds_byte(wc * 32 + fr, fq * 8);
#define PG8_SA(b, h) (((b) * 2 + (h)) * HTB)
#define PG8_SB(b, h) ((4 + (b) * 2 + (h)) * HTB)
#define PG8_STAGE(bufoff, gbase, voff) do { _Pragma("unroll") for (int _i = 0; _i < 2; ++_i) \
        __builtin_amdgcn_global_load_lds((const unsigned*)((const char*)(gbase) + (voff)[_i]), (PG8_LAS unsigned*)(lds + (bufoff) + ldsw + _i * 8192), 16, 0, 0); } while (0)
#define PG8_LDA(dst, b, h) do { _Pragma("unroll") for (int m = 0; m < 4; ++m) _Pragma("unroll") for (int k = 0; k < 2; ++k) dst[m][k] = *(const PG8_LAS bf16x8*)(lds + PG8_SA(b, h) + aoff + m * 2048 + k * 1024); } while (0)
#define PG8_LDB(dst, b, h) do { _Pragma("unroll") for (int n = 0; n < 2; ++n) _Pragma("unroll") for (int k = 0; k < 2; ++k) dst[n][k] = *(const PG8_LAS bf16x8*)(lds + PG8_SB(b, h) + boff + n * 2048 + k * 1024); } while (0)
#define PG8_MMA(ai, bj, At, Bt) do { __builtin_amdgcn_s_setprio(1); _Pragma("unroll") for (int m = 0; m < 4; ++m) _Pragma("unroll") for (int n = 0; n < 2; ++n) _Pragma("unroll") for (int k = 0; k < 2; ++k) \
        acc[ai][bj][m][n] = __builtin_amdgcn_mfma_f32_16x16x32_bf16(Bt[n][k], At[m][k], acc[ai][bj][m][n], 0, 0, 0); __builtin_amdgcn_s_setprio(0); } while (0)
#define PG8_WAIT_V(n) asm volatile("s_waitcnt vmcnt(" #n ")" ::: "memory")
#define PG8_WAIT_L(n) asm volatile("s_waitcnt lgkmcnt(" #n ")" ::: "memory")
#define PG8_BAR __builtin_amdgcn_s_barrier()
#define PG8_SCHED __builtin_amdgcn_sched_barrier(0)
    Unit cur, nxt; int ui = 0;
    if (!S.next(0, cur)) return;
    f32x4 acc[2][2][4][2];
#pragma unroll
    for (int a = 0; a < 2; ++a)
#pragma unroll
        for (int b = 0; b < 2; ++b)
#pragma unroll
            for (int m = 0; m < 4; ++m)
#pragma unroll
                for (int n = 0; n < 2; ++n) acc[a][b][m][n] = (f32x4){0.f, 0.f, 0.f, 0.f};
    bf16x8 At[4][2], B0[2][2], B1[2][2];
    const char* cA = (const char*)g.A + (size_t)cur.pm * tstep; const char* cB = (const char*)g.Bt + (size_t)cur.pn * tstep;
    S.a_ready(cur);
    if constexpr (SP2) {
        PG8_STAGE(PG8_SB(0, 0), cB, voffB); PG8_STAGE(PG8_SB(0, 1), cB + hstep, voffB); PG8_STAGE(PG8_SA(0, 0), cA, voffA); PG8_STAGE(PG8_SA(0, 1), cA + hstep, voffA);
        if (wr == 1) PG8_BAR;
        PG8_WAIT_V(2); PG8_BAR;
        PG8_STAGE(PG8_SB(1, 0), cB + kstep, voffB); PG8_STAGE(PG8_SA(1, 0), cA + kstep, voffA); PG8_STAGE(PG8_SB(1, 1), cB + hstep + kstep, voffB);
        PG8_WAIT_V(6); PG8_BAR;
    } else {
        PG8_STAGE(PG8_SB(0, 0), cB, voffB); PG8_STAGE(PG8_SA(0, 0), cA, voffA); PG8_STAGE(PG8_SB(0, 1), cB + hstep, voffB); PG8_STAGE(PG8_SA(0, 1), cA + hstep, voffA);
        if (wr == 1) PG8_BAR;
        PG8_WAIT_V(4); PG8_BAR;
        PG8_STAGE(PG8_SB(1, 0), cB + kstep, voffB); PG8_STAGE(PG8_SA(1, 0), cA + kstep, voffA); PG8_STAGE(PG8_SB(1, 1), cB + hstep + kstep, voffB);
        PG8_WAIT_V(6); PG8_BAR;
    }
    for (;;) {
        const bool has_next = S.next(ui + 1, nxt);
        const char* nA = has_next ? (const char*)g.A + (size_t)nxt.pm * tstep : cA; const char* nB = has_next ? (const char*)g.Bt + (size_t)nxt.pn * tstep : cB;
        for (int t = 0; t < nt; t += 2) {
            const bool last = (t == nt - 2);
            const char* a1 = cA + (size_t)(t + 1) * kstep;
            const char* a2 = last ? nA : cA + (size_t)(t + 2) * kstep; const char* b2 = last ? nB : cB + (size_t)(t + 2) * kstep;
            const char* a3 = a2 + kstep; const char* b3 = b2 + kstep;
            if (last && has_next) S.a_ready(nxt);
            if constexpr (SP2) {
            PG8_LDB(B0, 0, 0); PG8_LDB(B1, 0, 1); PG8_SCHED; PG8_LDA(At, 0, 0); PG8_STAGE(PG8_SA(1, 1), a1 + hstep, voffA);
            PG8_WAIT_V(8); PG8_WAIT_L(0); PG8_BAR; PG8_MMA(0, 0, At, B0); PG8_MMA(0, 1, At, B1); PG8_BAR; PG8_SCHED;
            PG8_LDA(At, 0, 1); PG8_STAGE(PG8_SB(0, 0), b2, voffB); PG8_STAGE(PG8_SB(0, 1), b2 + hstep, voffB); PG8_STAGE(PG8_SA(0, 0), a2, voffA);
            PG8_WAIT_V(8); PG8_WAIT_L(0); PG8_BAR; PG8_MMA(1, 0, At, B0); PG8_MMA(1, 1, At, B1); PG8_BAR; PG8_SCHED;
            PG8_LDB(B0, 1, 0); PG8_LDB(B1, 1, 1); PG8_SCHED; PG8_LDA(At, 1, 0); PG8_STAGE(PG8_SA(0, 1), a2 + hstep, voffA);
            PG8_WAIT_V(8); PG8_WAIT_L(0); PG8_BAR; PG8_MMA(0, 0, At, B0); PG8_MMA(0, 1, At, B1); PG8_BAR; PG8_SCHED;
            PG8_LDA(At, 1, 1); PG8_STAGE(PG8_SB(1, 0), b3, voffB); PG8_STAGE(PG8_SB(1, 1), b3 + hstep, voffB); PG8_STAGE(PG8_SA(1, 0), a3, voffA);
            PG8_WAIT_V(8); PG8_WAIT_L(0); PG8_BAR; PG8_MMA(1, 0, At, B0); PG8_MMA(1, 1, At, B1); PG8_BAR; PG8_SCHED;
            } else {
            PG8_LDB(B0, 0, 0); PG8_SCHED; PG8_LDA(At, 0, 0); PG8_STAGE(PG8_SA(1, 1), a1 + hstep, voffA);
            PG8_WAIT_L(8); PG8_BAR; PG8_WAIT_L(0); PG8_MMA(0, 0, At, B0); PG8_BAR; PG8_SCHED;
            PG8_LDB(B1, 0, 1); PG8_STAGE(PG8_SB(0, 0), b2, voffB);
            PG8_BAR; PG8_WAIT_L(0); PG8_MMA(0, 1, At, B1); PG8_BAR;
            PG8_LDA(At, 0, 1); PG8_STAGE(PG8_SA(0, 0), a2, voffA);
            PG8_BAR; PG8_WAIT_L(0); PG8_MMA(1, 0, At, B0); PG8_BAR; PG8_SCHED;
            PG8_STAGE(PG8_SB(0, 1), b2 + hstep, voffB);
            PG8_WAIT_V(6); PG8_BAR; PG8_MMA(1, 1, At, B1); PG8_BAR;
            PG8_LDB(B0, 1, 0); PG8_SCHED; PG8_LDA(At, 1, 0); PG8_STAGE(PG8_SA(0, 1), a2 + hstep, voffA);
            PG8_WAIT_L(8); PG8_BAR; PG8_WAIT_L(0); PG8_MMA(0, 0, At, B0); PG8_BAR; PG8_SCHED;
            PG8_LDB(B1, 1, 1); PG8_STAGE(PG8_SB(1, 0), b3, voffB);
            PG8_BAR; PG8_WAIT_L(0); PG8_MMA(0, 1, At, B1); PG8_BAR;
            PG8_LDA(At, 1, 1); PG8_STAGE(PG8_SA(1, 0), a3, voffA);
            PG8_BAR; PG8_WAIT_L(0); PG8_MMA(1, 0, At, B0); PG8_BAR; PG8_SCHED;
            PG8_STAGE(PG8_SB(1, 1), b3 + hstep, voffB);
            PG8_WAIT_V(6); PG8_BAR; PG8_MMA(1, 1, At, B1); PG8_BAR;
            }
        }
        if constexpr (ALIGN_EPI) { if (wr == 0) PG8_BAR; }
        if constexpr (!Epi::AFTER_DRAIN) { E(acc, cur, wr, wc, fr, fq); S.done(cur); }
        if (!has_next) break;
#pragma unroll
        for (int a = 0; a < 2; ++a)
#pragma unroll
            for (int b = 0; b < 2; ++b)
#pragma unroll
                for (int m = 0; m < 4; ++m)
#pragma unroll
                    for (int n = 0; n < 2; ++n) acc[a][b][m][n] = (f32x4){0.f, 0.f, 0.f, 0.f};
        cur = nxt; cA = nA; cB = nB; ++ui;
        if constexpr (ALIGN_EPI) { if (wr == 1) PG8_BAR; }
    }
    PG8_WAIT_V(0);
    if constexpr (!ALIGN_EPI) { if (wr == 0) PG8_BAR; }
    PG8_BAR;
    if constexpr (Epi::AFTER_DRAIN) { E.fused(acc, cur, wr, wc, fr, fq, lds, wid, lane); S.done(cur); }
#undef PG8_SA
#undef PG8_SB
#undef PG8_STAGE
#undef PG8_LDA
#undef PG8_LDB
#undef PG8_MMA
#undef PG8_WAIT_V
#undef PG8_WAIT_L
#undef PG8_BAR
#undef PG8_SCHED
}
}

#ifndef PG8_SP2
#define PG8_SP2 true
#endif
#ifndef PG8_ALIGN
#define PG8_ALIGN true
#endif
#include <hip/hip_bf16.h>
#include <cmath>
namespace attn_body {
using bf16=__hip_bfloat16;
using bf16x8=__attribute__((ext_vector_type(8)))short;
using s16x4=__attribute__((ext_vector_type(4)))short;
using f32x16=__attribute__((ext_vector_type(16)))float;
using u32x4=__attribute__((ext_vector_type(4)))unsigned;
constexpr int SEQ=16384,D=64,DM=512;
constexpr int NW=8,QBLK=32,QB=QBLK*NW,KVBLK=64,NQB=SEQ/QB;
constexpr int ATTN_PITCH=DM, ATTN_UNIT_ROWS=QB;
__device__ __forceinline__ int crow(int r,int hi){return (r&3)+8*(r>>2)+4*hi;}
#define SBAR() __builtin_amdgcn_sched_barrier(0)
__device__ __forceinline__ void cmask(f32x16&p0,f32x16&p1,int jb,int qrel,int hi){
  const float NEG=-INFINITY; int kb=64*jb+4*hi;
  #pragma unroll
  for(int r=0;r<16;++r){int kv=kb+(r&3)+8*(r>>2); if(kv>qrel)p0[r]=NEG; if(kv+32>qrel)p1[r]=NEG;}
}

constexpr int NSLOT=3, SLOTB=8192;
constexpr int LDS_K=0, LDS_V=NSLOT*SLOTB, LDS_WS=2*NSLOT*SLOTB, LDS_OST=LDS_WS+NW*64*4, LDS_BYTES=LDS_OST+NW*4096;
constexpr float C2=0.125f*1.4426950408889634f;
__device__ __forceinline__ void glds16(const void*gsrc,unsigned lds_dst){unsigned keep;
  asm volatile("s_mov_b32 %0, m0\n\ts_mov_b32 m0, %2\n\ts_nop 0\n\tglobal_load_lds_dwordx4 %1, off\n\ts_mov_b32 m0, %0":"=&s"(keep):"v"(gsrc),"s"(lds_dst):"memory");}
__device__ __forceinline__ float max3f(float a,float b,float c){float r;asm("v_max3_f32 %0, %1, %2, %3":"=v"(r):"v"(a),"v"(b),"v"(c));return r;}
__device__ __forceinline__ float max2f(float a,float b){float r;asm("v_max_f32_e32 %0, %1, %2":"=v"(r):"v"(a),"v"(b));return r;}
__device__ __forceinline__ float fadd_s(float a,float b){float r;asm("v_add_f32_e32 %0, %1, %2":"=v"(r):"v"(a),"v"(b));return r;}
__device__ __forceinline__ float fsub_s(float a,float b){float r;asm("v_sub_f32_e32 %0, %1, %2":"=v"(r):"v"(a),"v"(b));return r;}
typedef float f32x2_t __attribute__((ext_vector_type(2))); typedef __bf16 bf16x2_t __attribute__((ext_vector_type(2)));
__device__ __forceinline__ unsigned cvtpk_s(float lo,float hi){f32x2_t v={lo,hi};bf16x2_t b=__builtin_convertvector(v,bf16x2_t);return __builtin_bit_cast(unsigned,b);}
#define WAIT_BAR(N) asm volatile("s_waitcnt vmcnt(" #N ") lgkmcnt(0)\n\ts_barrier":::"memory")

__device__ __forceinline__ void qkt(f32x16&p0,f32x16&p1,const char*Kslot,const bf16x8*qr,const f32x16&negm,int r32,int hi){
  const char*kb=Kslot+hi*1024+r32*16;
  #pragma unroll
  for(int d0=0;d0<4;++d0){
    const bf16x8 b0=*reinterpret_cast<const bf16x8*>(kb+d0*2048);
    const bf16x8 b1=*reinterpret_cast<const bf16x8*>(kb+d0*2048+512);
    if(d0==0){p0=__builtin_amdgcn_mfma_f32_32x32x16_bf16(b0,qr[0],negm,0,0,0);p1=__builtin_amdgcn_mfma_f32_32x32x16_bf16(b1,qr[0],negm,0,0,0);}
    else{p0=__builtin_amdgcn_mfma_f32_32x32x16_bf16(b0,qr[d0],p0,0,0,0);p1=__builtin_amdgcn_mfma_f32_32x32x16_bf16(b1,qr[d0],p1,0,0,0);}}
}
typedef __attribute__((address_space(3))) const char* lds_cptr;
typedef short v4i16_t __attribute__((ext_vector_type(4)));
__device__ __forceinline__ void kload8(bf16x8*kf,lds_cptr kp){
  kf[0]=*(const __attribute__((address_space(3))) bf16x8*)(kp);      kf[1]=*(const __attribute__((address_space(3))) bf16x8*)(kp+512);
  kf[2]=*(const __attribute__((address_space(3))) bf16x8*)(kp+2048); kf[3]=*(const __attribute__((address_space(3))) bf16x8*)(kp+2560);
  kf[4]=*(const __attribute__((address_space(3))) bf16x8*)(kp+4096); kf[5]=*(const __attribute__((address_space(3))) bf16x8*)(kp+4608);
  kf[6]=*(const __attribute__((address_space(3))) bf16x8*)(kp+6144); kf[7]=*(const __attribute__((address_space(3))) bf16x8*)(kp+6656);
}
__device__ __forceinline__ void kload2(bf16x8*kf,lds_cptr kp,int j){ kf[2*j]=*(const __attribute__((address_space(3))) bf16x8*)(kp+j*2048); kf[2*j+1]=*(const __attribute__((address_space(3))) bf16x8*)(kp+j*2048+512); }
__device__ __forceinline__ s16x4 vtr(lds_cptr p){ return __builtin_bit_cast(s16x4,__builtin_amdgcn_ds_read_tr16_b64_v4i16((__attribute__((address_space(3))) v4i16_t*)p)); }
__device__ __forceinline__ float rowmax(const f32x16&p0,const f32x16&p1){
  float a=max3f(p0[0],p0[1],p1[0]),b=max3f(p0[2],p0[3],p1[1]);a=max3f(a,p1[2],p1[3]);
  #pragma unroll
  for(int r=4;r<16;r+=4){a=max3f(a,p0[r],p0[r+1]);b=max3f(b,p0[r+2],p0[r+3]);a=max3f(a,p1[r],p1[r+1]);b=max3f(b,p1[r+2],p1[r+3]);}
  const float m=max2f(a,b);
  auto rr=__builtin_amdgcn_permlane32_swap(__float_as_uint(m),__float_as_uint(m),false,false);
  return max2f(__uint_as_float(rr[0]),__uint_as_float(rr[1]));
}
__device__ __forceinline__ void pv(f32x16*o,int vb,bf16x8 pa0,bf16x8 pa1,bf16x8 pa2,bf16x8 pa3){
  #pragma unroll
  for(int d0=0;d0<2;++d0){s16x4 lo[4],hi[4];
    #pragma unroll
    for(int ks=0;ks<4;++ks){
      asm volatile("ds_read_b64_tr_b16 %0,%1 offset:%c2":"=&v"(lo[ks]):"v"(vb),"i"(d0*4096+ks*1024):"memory");
      asm volatile("ds_read_b64_tr_b16 %0,%1 offset:%c2":"=&v"(hi[ks]):"v"(vb),"i"(d0*4096+ks*1024+512):"memory");}
    asm volatile("s_waitcnt lgkmcnt(0)":::"memory");SBAR();
    #define PK(k) (bf16x8){lo[k][0],lo[k][1],lo[k][2],lo[k][3],hi[k][0],hi[k][1],hi[k][2],hi[k][3]}
    o[d0]=__builtin_amdgcn_mfma_f32_32x32x16_bf16(pa0,PK(0),o[d0],0,0,0);
    o[d0]=__builtin_amdgcn_mfma_f32_32x32x16_bf16(pa1,PK(1),o[d0],0,0,0);
    o[d0]=__builtin_amdgcn_mfma_f32_32x32x16_bf16(pa2,PK(2),o[d0],0,0,0);
    o[d0]=__builtin_amdgcn_mfma_f32_32x32x16_bf16(pa3,PK(3),o[d0],0,0,0);
    #undef PK
  }
}

#ifndef ATTN_STORE16
#define ATTN_STORE16(p,v) (*(u32x4*)(p)=(v))
#endif
template<int THRL> __device__ __forceinline__ void attn_unit(int qb,const bf16*Qh,const bf16*__restrict__ Kh,const bf16*__restrict__ Vh,bf16*Oh,char*shm,const int wid){
  const int lane=opaque_lane(),tid=wid*64+lane,r32=lane&31,hi=lane>>5;
  const int q0=qb*QB;
  const bf16*Qw=Qh+(long)(q0+wid*QBLK)*DM;
  const unsigned lds0=(unsigned)(uintptr_t)shm;
  float*wsf=(float*)(shm+LDS_WS)+wid*64;
  const bf16*ksrc=Kh+(long)lane*DM+wid*8;
  const bf16*vsrc=Vh+(long)(16*(wid&3)+(lane>>2))*DM+(wid>>2)*32+(lane&3)*8;
  const unsigned kdst=lds0+LDS_K+wid*1024, vdst=lds0+LDS_V+wid*1024;
  #define DMA_K(t,slot) glds16(ksrc+(long)(t)*KVBLK*DM,(unsigned)__builtin_amdgcn_readfirstlane(kdst+(slot)))
  #define DMA_V(t,slot) glds16(vsrc+(long)(t)*KVBLK*DM,(unsigned)__builtin_amdgcn_readfirstlane(vdst+(slot)))
  const int vb0=(int)(lds0+LDS_V)+((lane>>4)&1)*32+(lane&3)*8+(4*hi+((lane&15)>>2))*64;
  const char*Kbase=shm+LDS_K; bf16x8 kf[8];
  const lds_cptr shm3=(lds_cptr)shm; const lds_cptr kp0=shm3+LDS_K+hi*1024+r32*16; const lds_cptr vp0=shm3+LDS_V+((lane>>4)&1)*32+(lane&3)*8+(4*hi+((lane&15)>>2))*64;
  const int NT=(q0+QB)/KVBLK;
  DMA_K(0,0);DMA_V(0,0);DMA_K(1,SLOTB);
  bf16x8 qr[4];
  #pragma unroll
  for(int d0=0;d0<4;++d0)qr[d0]=*reinterpret_cast<const bf16x8*>(&Qw[(long)r32*DM+d0*16+hi*8]);
  float mhat=0.f,l_reg=0.f; float zz_=0.f; asm volatile("":"+v"(zz_));
  f32x16 o[2]; f32x16 negm;
  #pragma unroll
  for(int r=0;r<16;++r){o[0][r]=zz_;o[1][r]=zz_;negm[r]=zz_;}
  asm volatile("":"+v"(negm));
  const int qrel=wid*QBLK+r32;
  #define CMASK(P0,P1,t) do{int jb_=(t)-(NT-4); if(jb_>=0)cmask(P0,P1,jb_,qrel,hi);}while(0)
  bool resc=false;
  #define START(P0,P1) do{ const float rm=rowmax(P0,P1); resc=false; \
    { const float dl=rm; mhat=fadd_s(mhat,dl); \
      _Pragma("unroll") for(int r=0;r<16;++r){P0[r]=fsub_s(P0[r],dl);P1[r]=fsub_s(P1[r],dl);} \
      _Pragma("unroll") for(int r=0;r<16;++r)negm[r]=-mhat; asm volatile("":"+v"(negm)); } \
    _Pragma("unroll") for(int r=0;r<16;++r)P0[r]=__builtin_amdgcn_exp2f(P0[r]); }while(0)
  #define RESC() do{ if(resc){ asm volatile("s_waitcnt lgkmcnt(0)":::"memory"); \
      _Pragma("unroll") for(int d_=0;d_<2;++d_) _Pragma("unroll") for(int r=0;r<16;++r)o[d_][r]*=wsf[crow(r,hi)]; } }while(0)
  f32x16 pA0,pA1,pB0,pB1;
  int sl_prev=0,sl_cur=0,sl_next=SLOTB;
  #define ROT() do{sl_prev=sl_cur;sl_cur=sl_next;sl_next=(sl_next==(NSLOT-1)*SLOTB)?0:sl_next+SLOTB;}while(0)
  DMA_K(2,2*SLOTB);
  WAIT_BAR(3);
  qkt(pA0,pA1,Kbase,qr,negm,r32,hi);asm volatile("s_nop 15\n\ts_nop 7":"+v"(pA0),"+v"(pA1));CMASK(pA0,pA1,0);
  START(pA0,pA1);
  _Pragma("unroll") for(int r=0;r<16;++r)pA1[r]=__builtin_amdgcn_exp2f(pA1[r]);
  WAIT_BAR(0);
  DMA_K(3,0);DMA_V(1,SLOTB);
  ROT();
  kload8(kf,kp0+sl_cur);
  WAIT_BAR(2);
  s16x4 vlo[8],vhi[8]; u32x4 pw0,pw1,pw2,pw3;
  #define PKW(P,B) cvtpk_s(P[B],P[B+1])
  #define PAF(k) __builtin_bit_cast(bf16x8,pw##k)
  #define VFR(i) (bf16x8){vlo[i][0],vlo[i][1],vlo[i][2],vlo[i][3],vhi[i][0],vhi[i][1],vhi[i][2],vhi[i][3]}
  #define PIN(x) asm volatile("":"+v"(x))
  #define MX3(a,b,c) __builtin_fmaxf(__builtin_fmaxf((a),(b)),(c))
  #define GAPA(MF,A0,A1,A2,A3,W0,W1,PW) do{ MF; sacc+=A0; sacc+=A1; sacc+=A2; sacc+=A3; PIN(sacc); W0; W1; PIN(PW); SBAR(); }while(0)
  #define EX(v) __builtin_amdgcn_exp2f(v)
  #define GAPB(MF,X,B) do{ MF; X[B]=EX(X[B]); X[B+1]=EX(X[B+1]); X[B+2]=EX(X[B+2]); X[B+3]=EX(X[B+3]); PIN(X); SBAR(); }while(0)
  #define VRD(i) do{ vlo[i]=vtr(vp_+(((i)>>2)*4096+((i)&3)*1024)); vhi[i]=vtr(vp_+(((i)>>2)*4096+((i)&3)*1024+512)); }while(0)
  #define KRD(G,j) do{ if(G){ kload2(kf,kp0+sl_next,j); SBAR(); } }while(0)
  #define STEP(C0,C1,P0,P1,t,GK,GV,GL) do{ SBAR(); \
    const lds_cptr vp_=vp0+sl_prev; \
    VRD(0); SBAR(); float sacc=(P0[0]+P0[1]); \
    GAPA(C0=__builtin_amdgcn_mfma_f32_32x32x16_bf16(kf[0],qr[0],negm,0,0,0), P0[2],P0[3],P0[4],P0[5],     pw0[0]=PKW(P0,0), pw0[1]=PKW(P0,2), pw0); \
    VRD(4); SBAR(); GAPA(C1=__builtin_amdgcn_mfma_f32_32x32x16_bf16(kf[1],qr[0],negm,0,0,0), P0[6],P0[7],P0[8],P0[9],     pw0[2]=PKW(P0,4), pw0[3]=PKW(P0,6), pw0); \
    VRD(1); SBAR(); GAPA(C0=__builtin_amdgcn_mfma_f32_32x32x16_bf16(kf[2],qr[1],C0,0,0,0),   P0[10],P0[11],P0[12],P0[13], pw1[0]=PKW(P0,8), pw1[1]=PKW(P0,10), pw1); \
    VRD(5); SBAR(); GAPA(C1=__builtin_amdgcn_mfma_f32_32x32x16_bf16(kf[3],qr[1],C1,0,0,0),   P0[14],P0[15],P1[0],P1[1],   pw1[2]=PKW(P0,12),pw1[3]=PKW(P0,14), pw1); \
    VRD(2); SBAR(); GAPA(C0=__builtin_amdgcn_mfma_f32_32x32x16_bf16(kf[4],qr[2],C0,0,0,0),   P1[2],P1[3],P1[4],P1[5],     pw2[0]=PKW(P1,0), pw2[1]=PKW(P1,2), pw2); \
    VRD(6); SBAR(); GAPA(C1=__builtin_amdgcn_mfma_f32_32x32x16_bf16(kf[5],qr[2],C1,0,0,0),   P1[6],P1[7],P1[8],P1[9],     pw2[2]=PKW(P1,4), pw2[3]=PKW(P1,6), pw2); \
    VRD(3); SBAR(); GAPA(C0=__builtin_amdgcn_mfma_f32_32x32x16_bf16(kf[6],qr[3],C0,0,0,0),   P1[10],P1[11],P1[12],P1[13], pw3[0]=PKW(P1,8), pw3[1]=PKW(P1,10), pw3); \
    VRD(7); SBAR(); GAPA(C1=__builtin_amdgcn_mfma_f32_32x32x16_bf16(kf[7],qr[3],C1,0,0,0),   P1[14],P1[15],0.f,0.f,       pw3[2]=PKW(P1,12),pw3[3]=PKW(P1,14), pw3); \
    l_reg+=sacc; \
    if(GK){DMA_K((t)+3,sl_cur);} if(GV){DMA_V((t)+1,sl_next);} \
    CMASK(C0,C1,t); \
    { float a=MX3(C0[0],C0[1],C1[0]),b=MX3(C0[2],C0[3],C1[1]); a=MX3(a,C1[2],C1[3]); \
      _Pragma("unroll") for(int r=4;r<16;r+=4){a=MX3(a,C0[r],C0[r+1]);b=MX3(b,C0[r+2],C0[r+3]);a=MX3(a,C1[r],C1[r+1]);b=MX3(b,C1[r+2],C1[r+3]);} \
      float rm=__builtin_fmaxf(a,b); { auto rr=__builtin_amdgcn_permlane32_swap(__float_as_uint(rm),__float_as_uint(rm),false,false); rm=__builtin_fmaxf(__uint_as_float(rr[0]),__uint_as_float(rr[1])); } \
      resc=false; \
      if(__builtin_expect(__any(rm>(float)THRL),0)){ const float dl=__builtin_fmaxf(rm,0.f); mhat+=dl; \
        _Pragma("unroll") for(int r=0;r<16;++r){C0[r]-=dl;C1[r]-=dl;} \
        _Pragma("unroll") for(int r=0;r<16;++r)negm[r]=-mhat; asm volatile("":"+v"(negm)); \
        const float f=__builtin_amdgcn_exp2f(-dl); l_reg*=f; if(hi==0)wsf[r32]=f; resc=true; } } \
    SBAR(); \
    GAPB(o[0]=__builtin_amdgcn_mfma_f32_32x32x16_bf16(PAF(0),VFR(0),o[0],0,0,0), C0,0); \
    GAPB(o[1]=__builtin_amdgcn_mfma_f32_32x32x16_bf16(PAF(0),VFR(4),o[1],0,0,0), C0,4); \
    KRD(GL,0); GAPB(o[0]=__builtin_amdgcn_mfma_f32_32x32x16_bf16(PAF(1),VFR(1),o[0],0,0,0), C0,8); \
    KRD(GL,1); GAPB(o[1]=__builtin_amdgcn_mfma_f32_32x32x16_bf16(PAF(1),VFR(5),o[1],0,0,0), C0,12); \
    KRD(GL,2); GAPB(o[0]=__builtin_amdgcn_mfma_f32_32x32x16_bf16(PAF(2),VFR(2),o[0],0,0,0), C1,0); \
    KRD(GL,3); GAPB(o[1]=__builtin_amdgcn_mfma_f32_32x32x16_bf16(PAF(2),VFR(6),o[1],0,0,0), C1,4); \
    GAPB(o[0]=__builtin_amdgcn_mfma_f32_32x32x16_bf16(PAF(3),VFR(3),o[0],0,0,0), C1,8); \
    GAPB(o[1]=__builtin_amdgcn_mfma_f32_32x32x16_bf16(PAF(3),VFR(7),o[1],0,0,0), C1,12); \
    }while(0)
  int t=1;
  #undef CMASK
  #define CMASK(P0,P1,t) do{}while(0)
  for(;t+5<NT;t+=2){
    STEP(pB0,pB1,pA0,pA1,t,true,true,true);     WAIT_BAR(2); RESC(); ROT();
    STEP(pA0,pA1,pB0,pB1,t+1,true,true,true);   WAIT_BAR(2); RESC(); ROT();
  }
  #undef CMASK
  #define CMASK(P0,P1,t) do{int jb_=(t)-(NT-4); if(jb_>=0)cmask(P0,P1,jb_,qrel,hi);}while(0)
  #define ENDW(tt) do{ if((tt)+3<NT){WAIT_BAR(2);} else if((tt)+2<NT){WAIT_BAR(1);} else {WAIT_BAR(0);} }while(0)
  for(;t+1<NT;t+=2){
    STEP(pB0,pB1,pA0,pA1,t,(t+3<NT),(t+1<NT),(t+1<NT));       ENDW(t);   RESC(); ROT();
    STEP(pA0,pA1,pB0,pB1,t+1,(t+4<NT),(t+2<NT),(t+2<NT));     ENDW(t+1); RESC(); ROT();
  }
  STEP(pB0,pB1,pA0,pA1,NT-1,false,false,false); RESC();
  { float sacc=pB0[0]+pB0[1]; _Pragma("unroll") for(int r=2;r<16;++r)sacc+=pB0[r]; _Pragma("unroll") for(int r=0;r<16;++r)sacc+=pB1[r]; l_reg+=sacc;
    pw0=(u32x4){PKW(pB0,0),PKW(pB0,2),PKW(pB0,4),PKW(pB0,6)};pw1=(u32x4){PKW(pB0,8),PKW(pB0,10),PKW(pB0,12),PKW(pB0,14)};pw2=(u32x4){PKW(pB1,0),PKW(pB1,2),PKW(pB1,4),PKW(pB1,6)};pw3=(u32x4){PKW(pB1,8),PKW(pB1,10),PKW(pB1,12),PKW(pB1,14)};
    SBAR(); pv(o,vb0+sl_cur,PAF(0),PAF(1),PAF(2),PAF(3)); }
  #undef PKW
  #undef PAF
  #undef VFR
  #undef PIN
  #undef MX3
  #undef GAPA
  #undef GAPB
  #undef EX
  #undef VRD
  #undef KRD
  #undef STEP
  #undef ENDW
  {auto rr=__builtin_amdgcn_permlane32_swap(__float_as_uint(l_reg),__float_as_uint(l_reg),false,false);l_reg=__uint_as_float(rr[0])+__uint_as_float(rr[1]);}
  if(hi==0)wsf[32+r32]=l_reg;asm volatile("s_waitcnt lgkmcnt(0)":::"memory");
  float rli[16];
  #pragma unroll
  for(int r=0;r<16;++r)rli[r]=__builtin_amdgcn_rcpf(wsf[32+crow(r,hi)]);
  bf16*Ow=Oh+(long)(q0+wid*QBLK)*DM;
  { bf16*stg=(bf16*)(shm+LDS_OST)+wid*2048;
    #pragma unroll
    for(int r=0;r<16;++r){const int orow=crow(r,hi);
      #pragma unroll
      for(int d0=0;d0<2;++d0)stg[orow*64+d0*32+r32]=__float2bfloat16(o[d0][r]*rli[r]);}
    asm volatile("s_waitcnt lgkmcnt(0)":::"memory");
    #pragma unroll
    for(int i=0;i<4;++i){const int row=i*8+(lane>>3),ch=lane&7; const u32x4 v=*(const u32x4*)(stg+row*64+ch*8); ATTN_STORE16(Ow+(long)row*DM+ch*8,v);} }
  asm volatile("s_waitcnt lgkmcnt(0)\n\ts_barrier":::"memory");
  #undef DMA_K
  #undef DMA_V
  #undef CMASK
  #undef START
  #undef RESC
  #undef ROT
}
constexpr int ATTN_LDS_BYTES=LDS_BYTES;
constexpr int DSW_K=0, DSW_V=6*SLOTB, DSW_WS=12*SLOTB, DSW_OST=DSW_WS+NW*64*4, DSW_LDS_BYTES=DSW_OST+NW*4096;
__device__ __forceinline__ void dsw_unit(int dil,int r,int blk,const bf16*Qh,const bf16*__restrict__ Kh,const bf16*__restrict__ Vh,bf16*Oh,float*lse,char*shm,const int wid){
  const int lane=opaque_lane(),r32=lane&31,hi=lane>>5;
  const int L=256*blk;
  const unsigned lds0=(unsigned)(uintptr_t)shm;
  float*wsf=(float*)(shm+DSW_WS)+wid*64;
  #pragma unroll
  for(int tau=0;tau<6;++tau){
    int lk=L-128+64*tau+lane; lk=lk<0?0:lk;
    glds16(Kh+((long)lk*dil+r)*DM+wid*8,(unsigned)__builtin_amdgcn_readfirstlane(lds0+DSW_K+tau*SLOTB+wid*1024));
    int lv=L-128+64*tau+16*(wid&3)+(lane>>2); lv=lv<0?0:lv;
    glds16(Vh+((long)lv*dil+r)*DM+(wid>>2)*32+(lane&3)*8,(unsigned)__builtin_amdgcn_readfirstlane(lds0+DSW_V+tau*SLOTB+wid*1024));
  }
  const long tq=(long)(L+wid*QBLK+r32)*dil+r;
  bf16x8 qr[4];
  #pragma unroll
  for(int d0=0;d0<4;++d0)qr[d0]=*reinterpret_cast<const bf16x8*>(&Qh[tq*DM+d0*16+hi*8]);
  WAIT_BAR(0);
  const int tau0=wid>>1;
  const f32x16 zero=f32x16{};
  f32x16 s00,s01,s10,s11,s20,s21;
  qkt(s00,s01,shm+DSW_K+(tau0+0)*SLOTB,qr,zero,r32,hi);
  qkt(s10,s11,shm+DSW_K+(tau0+1)*SLOTB,qr,zero,r32,hi);
  qkt(s20,s21,shm+DSW_K+(tau0+2)*SLOTB,qr,zero,r32,hi);
  const int lq=wid*QBLK+r32;
  #define DSW_MASK(P0,P1,jj) do{ const int kb_=-128+64*(tau0+(jj))+4*hi; _Pragma("unroll") for(int rr=0;rr<16;++rr){ const int lk_=kb_+(rr&3)+8*(rr>>2); \
      const bool ok0=(L+lk_>=0)&&(lk_<=lq)&&(lq-lk_<=128); const bool ok1=(L+lk_+32>=0)&&(lk_+32<=lq)&&(lq-lk_-32<=128); \
      P0[rr]=ok0?P0[rr]:-INFINITY; P1[rr]=ok1?P1[rr]:-INFINITY; } }while(0)
  DSW_MASK(s00,s01,0); DSW_MASK(s10,s11,1); DSW_MASK(s20,s21,2);
  #undef DSW_MASK
  float mx=-INFINITY;
  #pragma unroll
  for(int rr=0;rr<16;++rr){ mx=__builtin_fmaxf(mx,__builtin_fmaxf(__builtin_fmaxf(s00[rr],s01[rr]),__builtin_fmaxf(__builtin_fmaxf(s10[rr],s11[rr]),__builtin_fmaxf(s20[rr],s21[rr])))); }
  { auto pr=__builtin_amdgcn_permlane32_swap(__float_as_uint(mx),__float_as_uint(mx),false,false); mx=__builtin_fmaxf(__uint_as_float(pr[0]),__uint_as_float(pr[1])); }
  float l=0.f;
  #define DSW_EXP(P) do{ _Pragma("unroll") for(int rr=0;rr<16;++rr){ P[rr]=__builtin_amdgcn_exp2f(P[rr]-mx); l+=P[rr]; } }while(0)
  DSW_EXP(s00); DSW_EXP(s01); DSW_EXP(s10); DSW_EXP(s11); DSW_EXP(s20); DSW_EXP(s21);
  #undef DSW_EXP
  { auto pr=__builtin_amdgcn_permlane32_swap(__float_as_uint(l),__float_as_uint(l),false,false); l=__uint_as_float(pr[0])+__uint_as_float(pr[1]); }
  f32x16 o[2]; o[0]=f32x16{}; o[1]=f32x16{};
  const int vb0=(int)(lds0+DSW_V)+((lane>>4)&1)*32+(lane&3)*8+(4*hi+((lane&15)>>2))*64;
  #define DSW_PV(P0,P1,jj) do{ u32x4 w0,w1,w2,w3; \
      w0=(u32x4){cvtpk_s(P0[0],P0[1]),cvtpk_s(P0[2],P0[3]),cvtpk_s(P0[4],P0[5]),cvtpk_s(P0[6],P0[7])}; w1=(u32x4){cvtpk_s(P0[8],P0[9]),cvtpk_s(P0[10],P0[11]),cvtpk_s(P0[12],P0[13]),cvtpk_s(P0[14],P0[15])}; \
      w2=(u32x4){cvtpk_s(P1[0],P1[1]),cvtpk_s(P1[2],P1[3]),cvtpk_s(P1[4],P1[5]),cvtpk_s(P1[6],P1[7])}; w3=(u32x4){cvtpk_s(P1[8],P1[9]),cvtpk_s(P1[10],P1[11]),cvtpk_s(P1[12],P1[13]),cvtpk_s(P1[14],P1[15])}; \
      SBAR(); pv(o,vb0+(tau0+(jj))*SLOTB,__builtin_bit_cast(bf16x8,w0),__builtin_bit_cast(bf16x8,w1),__builtin_bit_cast(bf16x8,w2),__builtin_bit_cast(bf16x8,w3)); }while(0)
  DSW_PV(s00,s01,0); DSW_PV(s10,s11,1); DSW_PV(s20,s21,2);
  #undef DSW_PV
  if(hi==0){ wsf[32+r32]=l; lse[tq*8]=mx+__builtin_log2f(l); }
  asm volatile("s_waitcnt lgkmcnt(0)":::"memory");
  float rli[16];
  #pragma unroll
  for(int rr=0;rr<16;++rr)rli[rr]=__builtin_amdgcn_rcpf(wsf[32+crow(rr,hi)]);
  { bf16*stg=(bf16*)(shm+DSW_OST)+wid*2048;
    #pragma unroll
    for(int rr=0;rr<16;++rr){const int orow=crow(rr,hi);
      #pragma unroll
      for(int d0=0;d0<2;++d0)stg[orow*64+d0*32+r32]=__float2bfloat16(o[d0][rr]*rli[rr]);}
    asm volatile("s_waitcnt lgkmcnt(0)":::"memory");
    #pragma unroll
    for(int i=0;i<4;++i){const int row=i*8+(lane>>3),ch=lane&7; const u32x4 v=*(const u32x4*)(stg+row*64+ch*8);
      *(u32x4*)(Oh+((long)(L+wid*QBLK+row)*dil+r)*DM+ch*8)=v;} }
  asm volatile("s_waitcnt lgkmcnt(0)\n\ts_barrier":::"memory");
}
struct AttnArgs { const bf16*QD; const bf16*KD; const bf16*VD; bf16*DO0; bf16*DO1; const bf16*QA; const bf16*KA; const bf16*VA; bf16*OP; float*LSE; };
template<int THRL=8> __device__ __forceinline__ void attn_phase_all(char*lds,const AttnArgs&A,int vcu,const int wid){
#ifndef NO_DIFF
  { const int vh=vcu>>4,s=vcu&15,h=vh>>2,c=(vh>>1)&1,half=vh&1;
    const bf16*Qh=A.QD+(2*h+c)*64; const bf16*Kh=A.KD+(2*h+c)*64; const bf16*Vh=A.VD+h*128+half*64; bf16*Oh=(c?A.DO1:A.DO0)+h*128+half*64;
    for(int i=0;i<4;++i){ const int qb=(i==0)?63-s:(i==1)?32+s:(i==2)?31-s:s; attn_unit<THRL>(qb,Qh,Kh,Vh,Oh,lds,wid); } }
#endif
#ifndef NO_DSW
  for(int i=0;i<6;++i){ const int u=vcu+256*i; const int p=u>>9,h=(u>>6)&7,idx=u&63; const int dil=(p==0)?1:(p==1)?4:16; const int nblk=64/dil; const int r=idx/nblk,blk=idx-r*nblk;
    dsw_unit(dil,r,blk,A.QA+h*64,A.KA+h*64,A.VA+h*64,A.OP+(size_t)p*SEQ*DM+h*64,A.LSE+(size_t)p*SEQ*8+h,lds,wid); }
#endif
}
#undef SBAR
#undef WAIT_BAR
}
#define GAS __attribute__((address_space(1)))
#define LAS __attribute__((address_space(3)))
typedef unsigned short bf16;
typedef unsigned v4u __attribute__((ext_vector_type(4)));
typedef float f32x4 __attribute__((ext_vector_type(4)));
typedef short bf16x8 __attribute__((ext_vector_type(8)));
typedef GAS unsigned gu32;
typedef GAS unsigned long long gu64;
#define RLX_AGENT __ATOMIC_RELAXED, __HIP_MEMORY_SCOPE_AGENT
#define LDS_WAIT() asm volatile("s_waitcnt lgkmcnt(0)" ::: "memory")
#define VM_WAIT() asm volatile("s_waitcnt vmcnt(0)" ::: "memory")
__device__ __forceinline__ unsigned long long rt() { return __builtin_amdgcn_s_memrealtime(); }
__device__ __forceinline__ unsigned f2bf(float f) { unsigned u = __builtin_bit_cast(unsigned, f); return (u + 0x7fffu + ((u >> 16) & 1u)) >> 16; }
__device__ __forceinline__ unsigned pk2(float lo, float hi) { return f2bf(lo) | (f2bf(hi) << 16); }

#define XB_TMO      128
#define XB_XCNT(j)  (256  + 64 * (j))
#define XB_XSUB(j)  (1280 + 64 * (j))
#define XB_XGEN(j)  (2304 + 64 * (j))
#define XB_TOP      3328
#define XB_TOPGEN   3392
#define XCD_BAR_WORDS 3456
#define XB_SPIN_CAP (1u << 18)

__device__ __forceinline__ unsigned xb_ld(unsigned* p)              { return __hip_atomic_load(p, __ATOMIC_RELAXED, __HIP_MEMORY_SCOPE_AGENT); }
__device__ __forceinline__ unsigned xb_add(unsigned* p, unsigned v) { return __hip_atomic_fetch_add(p, v, __ATOMIC_RELAXED, __HIP_MEMORY_SCOPE_AGENT); }
__device__ __forceinline__ unsigned xb_xcc_id() { return (unsigned)__builtin_amdgcn_s_getreg((3 << 11) | 20) & 0xFu; }
#define XB_SPIN(cond, bar) do { unsigned _sp = 0; while (cond) { __builtin_amdgcn_s_sleep(1); \
    if ((++_sp & 255u) == 0u) { if (xb_ld(&(bar)[XB_TMO])) break; if (_sp > XB_SPIN_CAP) { atomicAdd(&(bar)[XB_TMO], 1u); break; } } } } while (0)

struct XcdBarrier {
    unsigned* bar; unsigned x; int wave;
    volatile LAS unsigned* st;
};

__device__ __forceinline__ XcdBarrier xcd_barrier_post(unsigned* bar, volatile LAS unsigned* st) {
    XcdBarrier b; b.bar = bar; b.x = xb_xcc_id(); b.st = st;
    if (threadIdx.x == 0) (void)xb_add(&bar[XB_XCNT(b.x)], 1u);
    return b;
}
__device__ __forceinline__ void xcd_barrier_complete(unsigned* bar, unsigned x, unsigned& nloc, unsigned& nx) {
    const unsigned G = gridDim.x * gridDim.y * gridDim.z;
    unsigned sum, cnt, mine, sp = 0u;
    for (;;) {
        sum = 0u; cnt = 0u; mine = 0u;
#pragma unroll
        for (unsigned j = 0; j < 16; ++j) { const unsigned c = xb_ld(&bar[XB_XCNT(j)]); sum += c; cnt += (c > 0u) ? 1u : 0u; mine = (j == x) ? c : mine; }
        if (sum == G) break;
        __builtin_amdgcn_s_sleep(1);
        if ((++sp & 255u) == 0u) { if (xb_ld(&bar[XB_TMO])) break; if (sp > XB_SPIN_CAP) { atomicAdd(&bar[XB_TMO], 1u); break; } }
    }
    nloc = mine > 0u ? mine : 1u; nx = cnt > 0u ? cnt : 1u;
}

__device__ __forceinline__ void xcd_barrier(const XcdBarrier& b) {
    asm volatile("s_waitcnt vmcnt(0)" ::: "memory");
    __syncthreads();
    if (b.wave == 0 && opaque_lane() == 0) {
        unsigned* bar = b.bar;
        __builtin_amdgcn_s_waitcnt(0);
        unsigned nloc = b.st[0], nx = b.st[1];
        if (nloc == 0u) { xcd_barrier_complete(bar, b.x, nloc, nx); b.st[0] = nloc; b.st[1] = nx; }
        const unsigned old = xb_add(&bar[XB_XSUB(b.x)], 1u);
        const unsigned gen = old / nloc;
        if (old + 1u == (gen + 1u) * nloc) {
            __builtin_amdgcn_fence(__ATOMIC_RELEASE, "agent");
            asm volatile("s_waitcnt vmcnt(0)" ::: "memory");
            const unsigned og = xb_add(&bar[XB_TOP], 1u);
            const unsigned tg = og / nx;
            if (og + 1u == (tg + 1u) * nx) xb_add(&bar[XB_TOPGEN], 1u);
            else XB_SPIN(xb_ld(&bar[XB_TOPGEN]) == tg, bar);
            __builtin_amdgcn_fence(__ATOMIC_ACQUIRE, "agent");
            xb_add(&bar[XB_XGEN(b.x)], 1u);
            asm volatile("s_waitcnt vmcnt(0)" ::: "memory");
        } else {
            XB_SPIN(xb_ld(&bar[XB_XGEN(b.x)]) == gen, bar);
            __builtin_amdgcn_fence(__ATOMIC_ACQUIRE, "agent");
            asm volatile("s_waitcnt vmcnt(0)" ::: "memory");
        }
    }
    __syncthreads();
}
constexpr int NWAVES = 8;
constexpr int RING_OFF = 0, RING_BYTES = 135168;
constexpr int LDSCTL_OFF = RING_BYTES, MISC_OFF = LDSCTL_OFF + 320;
constexpr int LDS_BYTES = 147456;
static_assert(MISC_OFF + 128 <= LDS_BYTES && attn_body::DSW_LDS_BYTES <= RING_BYTES && attn_body::ATTN_LDS_BYTES <= RING_BYTES, "LDS map");
constexpr int CW_TMO = 0, CW_CODE = 1;
constexpr int CW_BAR = 4096;
constexpr int N_PHASES = 9;
static_assert((CW_BAR + N_PHASES * XCD_BAR_WORDS) * 4 <= (int)CTL_ZERO_BYTES, "CTL words inside the memset region");

struct Frame {
    LAS unsigned char* lds; volatile LAS unsigned* MISC; gu32* ctl;
    int tid, lane, wave, vcu, G;
};

__device__ __forceinline__ void p0_transpose_item(const float* W, int K, int N, bf16* WT, int n0p, int n0l, int k0, LAS float* scr, int lane) {
#pragma unroll 8
    for (int i = 0; i < 32; ++i) { const int kk = 2 * i + (lane >> 5); scr[kk * 33 + (lane & 31)] = W[(size_t)(k0 + kk) * N + n0l + (lane & 31)]; }
    LDS_WAIT(); asm volatile("" ::: "memory");
    const int c = lane & 7;
#pragma unroll
    for (int j = 0; j < 4; ++j) { const int n = (lane >> 3) + 8 * j; const LAS float* s = scr + (8 * c) * 33 + n;
        v4u o; o.x = pk2(s[0 * 33], s[1 * 33]); o.y = pk2(s[2 * 33], s[3 * 33]); o.z = pk2(s[4 * 33], s[5 * 33]); o.w = pk2(s[6 * 33], s[7 * 33]);
        *(GAS v4u*)(WT + (size_t)(n0p + n) * K + k0 + 8 * c) = o; }
    LDS_WAIT(); asm volatile("" ::: "memory");
}
__device__ __forceinline__ void rms_row_to_bf16(int lane, const float* xrow, const float* g, bf16* orow) {
    const GAS f32x4* xr = (const GAS f32x4*)xrow + lane;
    f32x4 v[4]; float s = 0.f;
#pragma unroll
    for (int j = 0; j < 4; ++j) { v[j] = xr[64 * j]; s += (v[j].x * v[j].x + v[j].y * v[j].y) + (v[j].z * v[j].z + v[j].w * v[j].w); }
    const float r = rsqrtf(wave_sum(s) * (1.f / DM) + RMS_EPS);
    GAS unsigned long long* o8 = (GAS unsigned long long*)orow + lane;
#pragma unroll
    for (int j = 0; j < 4; ++j) { const f32x4 gg = ((const GAS f32x4*)g)[lane + 64 * j];
        o8[64 * j] = (unsigned long long)pk2(v[j].x * r * gg.x, v[j].y * r * gg.y) | ((unsigned long long)pk2(v[j].z * r * gg.z, v[j].w * r * gg.w) << 32); }
}
__device__ __forceinline__ float2 rope_entry(int pos, int i) {
    const double inv[8] = {1.0, 0.19392274474868576, 0.03760603093086393, 0.007292664737217109, 0.001414213562373095, 0.0002742481756762073, 5.318295896944988e-05, 1.031338537721246e-05};
    double iv = inv[0];
#pragma unroll
    for (int k = 1; k < 8; ++k) iv = (i == k) ? inv[k] : iv;
    const double a = (double)pos * iv * 0.63661977236758134308;
    const double q = __builtin_rint(a);
    const double th = (a - q) * 1.57079632679489661923, t2 = th * th;
    const double sn = th * (1.0 + t2 * (-1.0 / 6 + t2 * (1.0 / 120 + t2 * (-1.0 / 5040 + t2 * (1.0 / 362880 + t2 * (-1.0 / 39916800 + t2 * (1.0 / 6227020800.0)))))));
    const double cs = 1.0 + t2 * (-0.5 + t2 * (1.0 / 24 + t2 * (-1.0 / 720 + t2 * (1.0 / 40320 + t2 * (-1.0 / 3628800 + t2 * (1.0 / 479001600.0 + t2 * (-1.0 / 87178291200.0)))))));
    const int qi = ((int)q) & 3;
    double c, s;
    if (qi == 0) { c = cs; s = sn; } else if (qi == 1) { c = -sn; s = cs; } else if (qi == 2) { c = -cs; s = -sn; } else { c = sn; s = -cs; }
    return make_float2((float)c, (float)s);
}
__device__ __forceinline__ void p0_prologue(Frame& F, const Ptrs& P) {
    unsigned char* ws = P.ws;
    LAS float* scr = (LAS float*)(F.lds + RING_OFF + F.wave * 16384);
    const int gw = F.vcu * NWAVES + F.wave, NGW = F.G * NWAVES;
    constexpr int I1 = 16 * 128, IO = 16 * 32, I2 = 16 * 192, I3 = 32 * 32, NITEMS = I1 + IO + I2 + I3;
    for (int it = gw; it < NITEMS; it += NGW) {
        int r = it;
        if (r < I1) { const int kb = r >> 7, n0p = (r & 127) * 32, rho = n0p & 255, n0l = (n0p & ~255) + 64 * ((rho >> 5) & 3) + 32 * (rho >> 7);
            p0_transpose_item(P.att_w_in, DM, ATT_IN, (bf16*)(ws + WS_W1T), n0p, n0l, kb * 64, scr, F.lane); continue; } r -= I1;
        if (r < IO) { const int kb = r >> 5, n0p = (r & 31) * 32; p0_transpose_item(P.att_w_out, DM, DM, (bf16*)(ws + WS_WOT), n0p, n0p, kb * 64, scr, F.lane); continue; } r -= IO;
        if (r < I2) { const int kb = r / 192, n0p = (r % 192) * 32, pn = n0p >> 8, rho = n0p & 255;
            const int n0l = (pn < 16) ? ((rho < 128) ? 128 * pn + rho : 4096 + 128 * pn + (rho - 128)) : 2048 + 256 * (pn - 16) + rho;
            p0_transpose_item(P.sgu_w_in, DM, SGU_IN, (bf16*)(ws + WS_W2T), n0p, n0l, kb * 64, scr, F.lane); continue; } r -= I2;
        { const int kb = r >> 5, n0p = (r & 31) * 32; p0_transpose_item(P.sgu_w_out, SGU_W, DM, (bf16*)(ws + WS_W3T), n0p, n0p, kb * 64, scr, F.lane); }
    }
    const int gt = gw * 64 + F.lane, NGT = NGW * 64;
    for (int i = gt; i < SEQ * 8; i += NGT) ((float2*)(ws + WS_ROPE))[i] = rope_entry(i >> 3, i & 7);
    for (int i = gt; i < 8 * 128 * 128; i += NGT) { const int t = (i >> 7) & 127, s = i & 127; ((bf16*)(ws + WS_WSB))[i] = (bf16)((s <= t) ? f2bf(P.w_s[i]) : 0u); }
    if (gt < 64) { float* gd = (float*)(ws + WS_GAIN); gd[gt] = P.dsw_qg[gt]; gd[64 + gt] = P.dsw_kg[gt]; gd[128 + gt] = P.diff_qg[gt]; gd[192 + gt] = P.diff_kg[gt]; }
    for (int m = gw; m < SEQ; m += NGW) rms_row_to_bf16(F.lane, P.x + (size_t)m * DM, P.att_norm, (bf16*)(ws + WS_XN) + (size_t)m * DM);
}

__device__ __forceinline__ void merge_row(const Ptrs& P, int t, int lane, float lam) {
    unsigned char* ws = P.ws;
    bf16* G = (bf16*)(ws + WS_G) + (size_t)t * 1024 + lane * 16;
    const uint4 g0 = *(const uint4*)G, g1 = *(const uint4*)(G + 8);
    const unsigned gw[8] = {g0.x, g0.y, g0.z, g0.w, g1.x, g1.y, g1.z, g1.w};
    float y[16];
    if (lane < 32) {
        const int h = lane >> 2; const float* L = (const float*)(ws + WS_LSE);
        const float l0 = L[((size_t)0 * SEQ + t) * 8 + h], l1 = L[((size_t)1 * SEQ + t) * 8 + h], l2 = L[((size_t)2 * SEQ + t) * 8 + h];
        const float mx = fmaxf(l0, fmaxf(l1, l2)); float w0 = exp2f(l0 - mx), w1 = exp2f(l1 - mx), w2 = exp2f(l2 - mx); const float wi = 1.f / (w0 + w1 + w2); w0 *= wi; w1 *= wi; w2 *= wi;
        const bf16* O = (const bf16*)(ws + WS_OP) + (size_t)t * 512 + lane * 16;
        const float wt[3] = {w0, w1, w2};
#pragma unroll
        for (int i = 0; i < 16; ++i) y[i] = 0.f;
#pragma unroll
        for (int p = 0; p < 3; ++p) { const uint4 a = *(const uint4*)(O + (size_t)p * SEQ * 512), b = *(const uint4*)(O + (size_t)p * SEQ * 512 + 8);
            const unsigned ow[8] = {a.x, a.y, a.z, a.w, b.x, b.y, b.z, b.w};
#pragma unroll
            for (int i = 0; i < 8; ++i) { y[2 * i] += wt[p] * bf2f(ow[i] & 0xffffu); y[2 * i + 1] += wt[p] * bf2f(ow[i] >> 16); } }
    } else {
        const int cidx = (lane - 32) * 16;
        const bf16* A = (const bf16*)(ws + WS_DO0) + (size_t)t * 512 + cidx; const bf16* B = (const bf16*)(ws + WS_DO1) + (size_t)t * 512 + cidx;
        const uint4 a0 = *(const uint4*)A, a1 = *(const uint4*)(A + 8), b0 = *(const uint4*)B, b1 = *(const uint4*)(B + 8);
        const unsigned aw[8] = {a0.x, a0.y, a0.z, a0.w, a1.x, a1.y, a1.z, a1.w}, bw[8] = {b0.x, b0.y, b0.z, b0.w, b1.x, b1.y, b1.z, b1.w};
#pragma unroll
        for (int i = 0; i < 8; ++i) { y[2 * i] = bf2f(aw[i] & 0xffffu) - lam * bf2f(bw[i] & 0xffffu); y[2 * i + 1] = bf2f(aw[i] >> 16) - lam * bf2f(bw[i] >> 16); }
    }
    float ss = 0.f;
#pragma unroll
    for (int i = 0; i < 16; ++i) ss += y[i] * y[i];
    ss += __shfl_xor(ss, 1); ss += __shfl_xor(ss, 2); ss += __shfl_xor(ss, 4);
    if (lane >= 32) {
        const float r = rsqrtf(ss * (1.f / 128.f) + RMS_EPS) * (1.f - LAM_INIT);
        const float* sg = P.subln + ((lane - 32) & 7) * 16;
#pragma unroll
        for (int i = 0; i < 16; ++i) y[i] = y[i] * r * sg[i];
    }
    unsigned ow[8];
#pragma unroll
    for (int i = 0; i < 8; ++i) ow[i] = f2bf(y[2 * i] * bf2f(gw[i] & 0xffffu)) | (f2bf(y[2 * i + 1] * bf2f(gw[i] >> 16)) << 16);
    *(uint4*)G = make_uint4(ow[0], ow[1], ow[2], ow[3]); *(uint4*)(G + 8) = make_uint4(ow[4], ow[5], ow[6], ow[7]);
}
__device__ __forceinline__ float lam_value(const Ptrs& P, int lane) {
    const float a = wave_sum(P.lq1[lane] * P.lk1[lane]), b = wave_sum(P.lq2[lane] * P.lk2[lane]);
    return expf(a) - expf(b) + LAM_INIT;
}

typedef float f32x16 __attribute__((ext_vector_type(16)));
typedef short s16x4v __attribute__((ext_vector_type(4)));
__device__ __forceinline__ void sgu_phase(Frame& F, const Ptrs& P) {
    unsigned char* ws = P.ws;
    const int lane = F.lane, w = F.wave, r32 = lane & 31, hi = lane >> 5;
    const int n = F.vcu >> 1;
    typedef float f32x2s __attribute__((ext_vector_type(2)));
    LAS f32x2s* stt = (LAS f32x2s*)(F.lds + 131072);
    {
        const int row = 16 * w + (lane >> 2), part = lane & 3;
        const f32x4* sp = (const f32x4*)((const float2*)(ws + WS_STAT) + (size_t)(n * 128 + row) * 32 + part * 8);
        float s = 0.f, s2 = 0.f;
#pragma unroll
        for (int i = 0; i < 4; ++i) { const f32x4 v = sp[i]; s += v.x + v.z; s2 += v.y + v.w; }
        s += __shfl_xor(s, 1); s += __shfl_xor(s, 2); s2 += __shfl_xor(s2, 1); s2 += __shfl_xor(s2, 2);
        const float mu = s * (1.f / SGU_W), var = s2 * (1.f / SGU_W) - mu * mu;
        if (part == 0) stt[row] = (f32x2s){mu, rsqrtf(var + LN_EPS)};
    }
    __syncthreads();
    LAS unsigned char* wl = F.lds + w * 16384;
    const unsigned wl_addr = (unsigned)(uintptr_t)wl;
    const bf16* GV = (const bf16*)(ws + WS_GV); bf16* UG = (bf16*)(ws + WS_UG); const bf16* WSB = (const bf16*)(ws + WS_WSB);
    for (int gi = 0; gi < 4; ++gi) {
        const int g = 4 * (F.vcu & 1) + gi, c0 = g * 256 + 32 * w;
        {
            const int cc = (lane & 3) * 8;
            const f32x4 lg0 = *(const f32x4*)(P.ln_g + c0 + cc), lg1 = *(const f32x4*)(P.ln_g + c0 + cc + 4), lb0 = *(const f32x4*)(P.ln_b + c0 + cc), lb1 = *(const f32x4*)(P.ln_b + c0 + cc + 4);
#pragma unroll
            for (int it = 0; it < 8; ++it) {
                const int s = 16 * it + (lane >> 2); const uint4 raw = *(const uint4*)(GV + (size_t)(n * 128 + s) * SGU_W + c0 + cc);
                const f32x2s mr = stt[s];
                f32x4 a = {bf2f(raw.x & 0xffffu), bf2f(raw.x >> 16), bf2f(raw.y & 0xffffu), bf2f(raw.y >> 16)}, b = {bf2f(raw.z & 0xffffu), bf2f(raw.z >> 16), bf2f(raw.w & 0xffffu), bf2f(raw.w >> 16)};
                a = (a - mr.x) * mr.y * lg0 + lb0; b = (b - mr.x) * mr.y * lg1 + lb1;
                v4u o; o.x = pk2(a.x, a.y); o.y = pk2(a.z, a.w); o.z = pk2(b.x, b.y); o.w = pk2(b.z, b.w);
                *(LAS v4u*)(wl + s * 64 + cc * 2) = o;
            }
        }
        LDS_WAIT(); asm volatile("" ::: "memory");
        bf16x8 bfr[8];
        {
            const unsigned va = wl_addr + (unsigned)((8 * hi + ((lane & 15) >> 2)) * 64 + ((lane >> 4) & 1) * 32 + (lane & 3) * 8);
#pragma unroll
            for (int ks = 0; ks < 8; ++ks) { s16x4v lo, hh;
                asm volatile("ds_read_b64_tr_b16 %0,%1 offset:%c2" : "=&v"(lo) : "v"(va), "i"(ks * 1024) : "memory");
                asm volatile("ds_read_b64_tr_b16 %0,%1 offset:%c2" : "=&v"(hh) : "v"(va), "i"(ks * 1024 + 256) : "memory");
                asm volatile("s_waitcnt lgkmcnt(0)" : "+v"(lo), "+v"(hh) :: "memory");
                bfr[ks] = (bf16x8){lo[0], lo[1], lo[2], lo[3], hh[0], hh[1], hh[2], hh[3]}; }
        }
        __builtin_amdgcn_sched_barrier(0);
        f32x16 acc[4];
#pragma unroll
        for (int i = 0; i < 4; ++i) {
            acc[i] = f32x16{};
            const bf16* wrow = WSB + ((size_t)g * 128 + 32 * i + r32) * 128 + 8 * hi;
#pragma unroll
            for (int ks = 0; ks < 2 * i + 2; ++ks) { const bf16x8 af = *(const bf16x8*)(wrow + 16 * ks); acc[i] = __builtin_amdgcn_mfma_f32_32x32x16_bf16(af, bfr[ks], acc[i], 0, 0, 0); }
        }
#pragma unroll
        for (int i = 0; i < 4; ++i)
#pragma unroll
            for (int rr = 0; rr < 16; ++rr) { const int t = 32 * i + (rr & 3) + 8 * (rr >> 2) + 4 * hi; *(LAS float*)(wl + t * 128 + r32 * 4) = acc[i][rr] + P.b_s[g * 128 + t]; }
        LDS_WAIT(); asm volatile("" ::: "memory");
        {
            const int cc = (lane & 3) * 8;
#pragma unroll
            for (int it = 0; it < 8; ++it) {
                const int t = 16 * it + (lane >> 2); bf16* up = UG + (size_t)(n * 128 + t) * SGU_W + c0 + cc;
                const uint4 raw = *(const uint4*)up; const f32x4 s0 = *(LAS f32x4*)(wl + t * 128 + cc * 4), s1 = *(LAS f32x4*)(wl + t * 128 + cc * 4 + 16);
                v4u o; o.x = pk2(bf2f(raw.x & 0xffffu) * s0.x, bf2f(raw.x >> 16) * s0.y); o.y = pk2(bf2f(raw.y & 0xffffu) * s0.z, bf2f(raw.y >> 16) * s0.w);
                o.z = pk2(bf2f(raw.z & 0xffffu) * s1.x, bf2f(raw.z >> 16) * s1.y); o.w = pk2(bf2f(raw.w & 0xffffu) * s1.z, bf2f(raw.w >> 16) * s1.w);
                *(v4u*)up = o;
            }
        }
        LDS_WAIT(); asm volatile("" ::: "memory");
    }
}

struct Args { Ptrs p; int ph_lo, ph_hi, li, pad; };
__global__ void __launch_bounds__(NWAVES * 64, 2) mega_fwd(Args args) {
    extern __shared__ __attribute__((aligned(16))) unsigned char lds[];
    Frame F;
    F.lds = (LAS unsigned char*)lds;
    F.MISC = (volatile LAS unsigned*)(F.lds + MISC_OFF);
    F.wave = __builtin_amdgcn_readfirstlane((int)threadIdx.x >> 6); F.lane = opaque_lane(); F.tid = F.wave * 64 + F.lane;
    F.G = gridDim.x; { const int bx = blockIdx.x; F.vcu = (F.G % 8 == 0) ? (bx % 8) * (F.G / 8) + bx / 8 : bx; }
    const Ptrs& P = args.p;
    unsigned char* ws = P.ws;
    F.ctl = (gu32*)(ws + WS_CTL);
    for (int u = F.tid; u < (LDS_BYTES - LDSCTL_OFF) / 4; u += NWAVES * 64) ((LAS unsigned*)(F.lds + LDSCTL_OFF))[u] = 0u;
    __syncthreads();
    const int lo = args.ph_lo, hi = args.ph_hi;
    XcdBarrier bar; bar.bar = (unsigned*)(F.ctl + CW_BAR) + args.li * XCD_BAR_WORDS; bar.x = 0; bar.st = nullptr;
    if (hi - lo > 1) bar = xcd_barrier_post((unsigned*)(F.ctl + CW_BAR) + args.li * XCD_BAR_WORDS, F.MISC + 8);
    bar.wave = F.wave;
#ifndef PH_EN
#define PH_EN 0x1FF
#endif
#define IN(k) (((PH_EN >> (k)) & 1) && lo <= (k) && (k) < hi)
#define SEAM(k) do { if (IN(k) && IN((k) + 1)) xcd_barrier(bar); { F.lane = opaque_lane(); F.tid = F.wave * 64 + F.lane; } } while (0)

    if (IN(0)) { p0_prologue(F, P); }
    SEAM(0);
    if (IN(1)) {
        pg8::Gemm g{(const bf16*)(ws + WS_XN), (const bf16*)(ws + WS_W1T), SEQ, ATT_IN, DM}; pg8::StaticOrder S; S.init(SEQ, ATT_IN, F.G, (int)blockIdx.x);
        pg8::EpiProj1 E{ws};
        pg8::gemm_phase<pg8::EpiProj1, pg8::StaticOrder, PG8_ALIGN, PG8_SP2>(F.lds + RING_OFF, g, S, E, F.wave);
    }
    SEAM(1);
    if (IN(2)) {
        using abf = attn_body::bf16;
        const attn_body::AttnArgs A{(const abf*)(ws + WS_QD), (const abf*)(ws + WS_KD), (const abf*)(ws + WS_VD), (abf*)(ws + WS_DO0), (abf*)(ws + WS_DO1),
                                    (const abf*)(ws + WS_QA), (const abf*)(ws + WS_KA), (const abf*)(ws + WS_VA), (abf*)(ws + WS_OP), (float*)(ws + WS_LSE)};
        attn_body::attn_phase_all<8>((char*)lds + RING_OFF, A, F.vcu, F.wave);
    }
    SEAM(2);
    if (IN(3)) {
        const float lam = lam_value(P, F.lane);
        for (int t = F.vcu * NWAVES + F.wave; t < SEQ; t += F.G * NWAVES) merge_row(P, t, F.lane, lam);
    }
    SEAM(3);
    if (IN(4)) {
        pg8::Gemm g{(const bf16*)(ws + WS_G), (const bf16*)(ws + WS_WOT), SEQ, DM, DM}; pg8::StaticOrder S; S.init(SEQ, DM, F.G, (int)blockIdx.x);
        pg8::EpiRes E{P.x, P.out};
        pg8::gemm_phase<pg8::EpiRes, pg8::StaticOrder, false, PG8_SP2>(F.lds + RING_OFF, g, S, E, F.wave);
    }
    SEAM(4);
    if (IN(5)) {
        for (int m = F.vcu * NWAVES + F.wave; m < SEQ; m += F.G * NWAVES) rms_row_to_bf16(F.lane, P.out + (size_t)m * DM, P.sgu_norm, (bf16*)(ws + WS_XN) + (size_t)m * DM);
    }
    SEAM(5);
    if (IN(6)) {
        pg8::Gemm g{(const bf16*)(ws + WS_XN), (const bf16*)(ws + WS_W2T), SEQ, SGU_IN, DM}; pg8::StaticOrder S; S.init(SEQ, SGU_IN, F.G, (int)blockIdx.x);
        pg8::EpiProj2 E{ws};
        pg8::gemm_phase<pg8::EpiProj2, pg8::StaticOrder, PG8_ALIGN, PG8_SP2>(F.lds + RING_OFF, g, S, E, F.wave);
    }
    SEAM(6);
    if (IN(7)) { sgu_phase(F, P); }
    SEAM(7);
    if (IN(8)) {
        pg8::Gemm g{(const bf16*)(ws + WS_UG), (const bf16*)(ws + WS_W3T), SEQ, DM, SGU_W}; pg8::StaticOrder S; S.init(SEQ, DM, F.G, (int)blockIdx.x);
        pg8::EpiRes E{P.out, P.out};
        pg8::gemm_phase<pg8::EpiRes, pg8::StaticOrder, false, PG8_SP2>(F.lds + RING_OFF, g, S, E, F.wave);
    }
#undef IN
#undef SEAM
}
#if DEBUG_NAIVE
__global__ void k_rope(float2* tab) {
    const int idx = blockIdx.x * blockDim.x + threadIdx.x; if (idx >= SEQ * 8) return;
    const int pos = idx >> 3, i = idx & 7;
    const double inv[8] = {1.0, 0.19392274474868576, 0.03760603093086393, 0.007292664737217109, 0.001414213562373095, 0.0002742481756762073, 5.318295896944988e-05, 1.031338537721246e-05};
    double iv = inv[0];
#pragma unroll
    for (int k = 1; k < 8; ++k) iv = (i == k) ? inv[k] : iv;
    const double ang = (double)pos * iv;
    const double a = ang * 0.63661977236758134308;
    const double q = __builtin_rint(a);
    const double th = (a - q) * 1.57079632679489661923;
    const double t2 = th * th;
    double sn = th * (1.0 + t2 * (-1.0 / 6 + t2 * (1.0 / 120 + t2 * (-1.0 / 5040 + t2 * (1.0 / 362880 + t2 * (-1.0 / 39916800 + t2 * (1.0 / 6227020800.0)))))));
    double cs = 1.0 + t2 * (-0.5 + t2 * (1.0 / 24 + t2 * (-1.0 / 720 + t2 * (1.0 / 40320 + t2 * (-1.0 / 3628800 + t2 * (1.0 / 479001600.0 + t2 * (-1.0 / 87178291200.0)))))));
    const int qi = ((int)q) & 3;
    double c, s;
    if (qi == 0) { c = cs; s = sn; } else if (qi == 1) { c = -sn; s = cs; } else if (qi == 2) { c = -cs; s = -sn; } else { c = sn; s = -cs; }
    tab[idx] = make_float2((float)c, (float)s);
}

__global__ void __launch_bounds__(256) k_rmsnorm(const float* x, const float* g, bf16* out) {
    const int row = blockIdx.x * 4 + (threadIdx.x >> 6), lane = threadIdx.x & 63;
    const f32x4* xr = (const f32x4*)(x + (size_t)row * DM) + lane;
    f32x4 v[4]; float s = 0.f;
#pragma unroll
    for (int j = 0; j < 4; ++j) { v[j] = xr[64 * j]; s += (v[j].x * v[j].x + v[j].y * v[j].y) + (v[j].z * v[j].z + v[j].w * v[j].w); }
    const float r = rsqrtf(wave_sum(s) * (1.f / DM) + RMS_EPS);
    unsigned long long* o8 = (unsigned long long*)(out + (size_t)row * DM) + lane;
#pragma unroll
    for (int j = 0; j < 4; ++j) { const f32x4 gg = ((const f32x4*)g)[lane + 64 * j];
        const unsigned lo = f2bf(v[j].x * r * gg.x) | (f2bf(v[j].y * r * gg.y) << 16), hi = f2bf(v[j].z * r * gg.z) | (f2bf(v[j].w * r * gg.w) << 16);
        o8[64 * j] = (unsigned long long)lo | ((unsigned long long)hi << 32); }
}

template <int MODE> __global__ void __launch_bounds__(256) k_ngemm(const bf16* A, int lda, const float* B, int N, int K, Ptrs P) {
    __shared__ float As[16][68];
    __shared__ float Bs[16][68];
    __shared__ float Bs2[16][68];
    __shared__ float T[64][65];
    __shared__ float T2[64][65];
    __shared__ float rinv[64];
    constexpr bool DUAL = (MODE == 3);
    const int tid = threadIdx.x, tx = tid & 15, ty = tid >> 4;
    const int row0 = blockIdx.y * 64, grp = blockIdx.x;
    int col0 = grp * 64, col0b = 0;
    bool dual = false;
    if (MODE == 3) { if (grp < 32) { col0 = grp * 64; col0b = 4096 + grp * 64; dual = true; } else { col0 = 2048 + (grp - 32) * 64; } }
    float acc[4][4], acc2[4][4];
#pragma unroll
    for (int i = 0; i < 4; ++i)
#pragma unroll
        for (int j = 0; j < 4; ++j) { acc[i][j] = 0.f; acc2[i][j] = 0.f; }
    for (int k0 = 0; k0 < K; k0 += 16) {
        { const int r = tid >> 2, kk = (tid & 3) * 4; const uint2 a = *(const uint2*)(A + (size_t)(row0 + r) * lda + k0 + kk);
          As[kk + 0][r] = bf2f(a.x & 0xffffu); As[kk + 1][r] = bf2f(a.x >> 16); As[kk + 2][r] = bf2f(a.y & 0xffffu); As[kk + 3][r] = bf2f(a.y >> 16); }
        { const int kk = tid >> 4, c = (tid & 15) * 4; const f32x4 b = *(const f32x4*)(B + (size_t)(k0 + kk) * N + col0 + c);
          Bs[kk][c] = b.x; Bs[kk][c + 1] = b.y; Bs[kk][c + 2] = b.z; Bs[kk][c + 3] = b.w;
          if (DUAL && dual) { const f32x4 b2 = *(const f32x4*)(B + (size_t)(k0 + kk) * N + col0b + c); Bs2[kk][c] = b2.x; Bs2[kk][c + 1] = b2.y; Bs2[kk][c + 2] = b2.z; Bs2[kk][c + 3] = b2.w; } }
        __syncthreads();
#pragma unroll
        for (int k = 0; k < 16; ++k) {
            float a[4], b[4], b2[4];
#pragma unroll
            for (int i = 0; i < 4; ++i) { a[i] = As[k][ty * 4 + i]; b[i] = Bs[k][tx * 4 + i]; b2[i] = DUAL ? Bs2[k][tx * 4 + i] : 0.f; }
#pragma unroll
            for (int i = 0; i < 4; ++i)
#pragma unroll
                for (int j = 0; j < 4; ++j) { acc[i][j] += a[i] * b[j]; if (DUAL) acc2[i][j] += a[i] * b2[j]; }
        }
        __syncthreads();
    }
#pragma unroll
    for (int i = 0; i < 4; ++i)
#pragma unroll
        for (int j = 0; j < 4; ++j) { T[ty * 4 + i][tx * 4 + j] = acc[i][j]; if (DUAL) T2[ty * 4 + i][tx * 4 + j] = acc2[i][j]; }
    __syncthreads();
    unsigned char* ws = P.ws;
    if (MODE == 1) {
        const int type = grp >> 3, hd = grp & 7;
        const bool isq = (type == 0 || type == 4), isk = (type == 1 || type == 5), isg = (type == 3 || type == 7);
        const float* gain = (type == 0) ? P.dsw_qg : (type == 1) ? P.dsw_kg : (type == 4) ? P.diff_qg : P.diff_kg;
        if (isq || isk) {
            if (tid < 64) { float ss = 0.f; for (int j = 0; j < 64; ++j) ss += T[tid][j] * T[tid][j]; rinv[tid] = rsqrtf(ss * (1.f / 64.f) + RMS_EPS); }
            __syncthreads();
        }
        bf16* dst; int pitch, cb;
        if (type == 0) { dst = (bf16*)(ws + WS_QA); pitch = 512; cb = hd * 64; } else if (type == 1) { dst = (bf16*)(ws + WS_KA); pitch = 512; cb = hd * 64; }
        else if (type == 2) { dst = (bf16*)(ws + WS_VA); pitch = 512; cb = hd * 64; } else if (type == 3) { dst = (bf16*)(ws + WS_G); pitch = 1024; cb = hd * 64; }
        else if (type == 4) { dst = (bf16*)(ws + WS_QD); pitch = 512; cb = hd * 64; } else if (type == 5) { dst = (bf16*)(ws + WS_KD); pitch = 512; cb = hd * 64; }
        else if (type == 6) { dst = (bf16*)(ws + WS_VD); pitch = 512; cb = hd * 64; } else { dst = (bf16*)(ws + WS_G); pitch = 1024; cb = 512 + hd * 64; }
        const float2* tab = (const float2*)(ws + WS_ROPE);
        const int r = tid >> 2;
        for (int jj = 0; jj < 16; ++jj) {
            const int j = (tid & 3) * 16 + jj; float val = T[r][j];
            if (isq || isk) {
                const float ri = rinv[r];
                val = val * ri * gain[j];
                if (j < 16) { const int i = j & 7; const float2 cs = tab[(size_t)(row0 + r) * 8 + i];
                    const float x1 = T[r][i] * ri * gain[i], x2 = T[r][i + 8] * ri * gain[i + 8];
                    val = (j < 8) ? (x1 * cs.x - x2 * cs.y) : (x2 * cs.x + x1 * cs.y); }
                if (isq) val *= C2;
            } else if (isg) val = silu_f(val);
            dst[(size_t)(row0 + r) * pitch + cb + j] = (bf16)f2bf(val);
        }
    } else if (MODE == 2) {
        const int r = tid >> 2;
        for (int jj = 0; jj < 16; ++jj) { const int j = (tid & 3) * 16 + jj; const size_t o = (size_t)(row0 + r) * DM + col0 + j; P.out[o] = P.x[o] + T[r][j]; }
    } else if (MODE == 3) {
        const int r = tid >> 2;
        if (dual) {
            bf16* ug = (bf16*)(ws + WS_UG);
            for (int jj = 0; jj < 16; ++jj) { const int j = (tid & 3) * 16 + jj; ug[(size_t)(row0 + r) * SGU_W + col0 + j] = (bf16)f2bf(gelu_f(T[r][j]) * silu_f(T2[r][j])); }
        } else {
            bf16* gv = (bf16*)(ws + WS_GV);
            for (int jj = 0; jj < 16; ++jj) { const int j = (tid & 3) * 16 + jj; const float v = gelu_f(T[r][j]); T[r][j] = v; gv[(size_t)(row0 + r) * SGU_W + (col0 - 2048) + j] = (bf16)f2bf(v); }
            __syncthreads();
            if (tid < 64) { float s = 0.f, s2 = 0.f; for (int j = 0; j < 64; ++j) { const float v = T[tid][j]; s += v; s2 += v * v; }
                ((float2*)(ws + WS_STAT))[(size_t)(row0 + tid) * 32 + (grp - 32)] = make_float2(s, s2); }
        }
    } else {
        const int r = tid >> 2;
        for (int jj = 0; jj < 16; ++jj) { const int j = (tid & 3) * 16 + jj; const size_t o = (size_t)(row0 + r) * DM + col0 + j; P.out[o] = P.out[o] + T[r][j]; }
    }
}

__global__ void __launch_bounds__(256) k_ndsw(Ptrs P) {
    const int w = blockIdx.x * 4 + (threadIdx.x >> 6), lane = threadIdx.x & 63;
    const int p = w / (SEQ * 8), rem = w % (SEQ * 8), t = rem >> 3, h = rem & 7;
    const int dil = (p == 0) ? 1 : (p == 1) ? 4 : 16;
    const bf16* QA = (const bf16*)(P.ws + WS_QA); const bf16* KA = (const bf16*)(P.ws + WS_KA); const bf16* VA = (const bf16*)(P.ws + WS_VA);
    const float q = bf2f(QA[(size_t)t * 512 + h * 64 + lane]);
    float m = -INFINITY, l = 0.f, o = 0.f;
    for (int j = 0; j <= 128; ++j) {
        const int tk = t - j * dil; if (tk < 0) break;
        const float s = wave_sum(q * bf2f(KA[(size_t)tk * 512 + h * 64 + lane]));
        const float mn = fmaxf(m, s), a = exp2f(m - mn), pe = exp2f(s - mn);
        l = l * a + pe; o = o * a + pe * bf2f(VA[(size_t)tk * 512 + h * 64 + lane]); m = mn;
    }
    ((bf16*)(P.ws + WS_OP))[((size_t)p * SEQ + t) * 512 + h * 64 + lane] = (bf16)f2bf(o / l);
    if (lane == 0) ((float*)(P.ws + WS_LSE))[((size_t)p * SEQ + t) * 8 + h] = m + log2f(l);
}
__global__ void __launch_bounds__(256) k_ndiff(Ptrs P) {
    const int w = blockIdx.x * 4 + (threadIdx.x >> 6), lane = threadIdx.x & 63;
    const int t = SEQ - 1 - (w >> 3), vq = w & 7, h = vq >> 1, c = vq & 1;
    const bf16* QD = (const bf16*)(P.ws + WS_QD); const bf16* KD = (const bf16*)(P.ws + WS_KD); const bf16* VD = (const bf16*)(P.ws + WS_VD);
    const float q = bf2f(QD[(size_t)t * 512 + vq * 64 + lane]);
    float m = -INFINITY, l = 0.f, o0 = 0.f, o1 = 0.f;
    int tk = 0;
    for (; tk + 3 <= t; tk += 4) {
        float s[4];
#pragma unroll
        for (int u = 0; u < 4; ++u) s[u] = q * bf2f(KD[(size_t)(tk + u) * 512 + vq * 64 + lane]);
#pragma unroll
        for (int o = 1; o < 64; o <<= 1) {
#pragma unroll
            for (int u = 0; u < 4; ++u) s[u] += __shfl_xor(s[u], o); }
        const float mn = fmaxf(fmaxf(m, fmaxf(s[0], s[1])), fmaxf(s[2], s[3])), a = exp2f(m - mn);
        l *= a; o0 *= a; o1 *= a; m = mn;
#pragma unroll
        for (int u = 0; u < 4; ++u) { const float pe = exp2f(s[u] - mn); l += pe;
            o0 += pe * bf2f(VD[(size_t)(tk + u) * 512 + h * 128 + lane]); o1 += pe * bf2f(VD[(size_t)(tk + u) * 512 + h * 128 + 64 + lane]); }
    }
    for (; tk <= t; ++tk) {
        const float s = wave_sum(q * bf2f(KD[(size_t)tk * 512 + vq * 64 + lane]));
        const float mn = fmaxf(m, s), a = exp2f(m - mn), pe = exp2f(s - mn);
        l = l * a + pe; o0 = o0 * a + pe * bf2f(VD[(size_t)tk * 512 + h * 128 + lane]); o1 = o1 * a + pe * bf2f(VD[(size_t)tk * 512 + h * 128 + 64 + lane]); m = mn;
    }
    bf16* O = (bf16*)(P.ws + (c ? WS_DO1 : WS_DO0));
    O[(size_t)t * 512 + h * 128 + lane] = (bf16)f2bf(o0 / l); O[(size_t)t * 512 + h * 128 + 64 + lane] = (bf16)f2bf(o1 / l);
}

__global__ void __launch_bounds__(256) k_merge(Ptrs P) {
    const int t = blockIdx.x * 4 + (threadIdx.x >> 6), lane = threadIdx.x & 63;
    const float lam = lam_value(P, lane);
    merge_row(P, t, lane, lam);
}

__global__ void k_nstats(Ptrs P) {
    const int t = blockIdx.x * blockDim.x + threadIdx.x; if (t >= SEQ) return;
    const float2* st = (const float2*)(P.ws + WS_STAT) + (size_t)t * 32; float s = 0.f, s2 = 0.f;
    for (int i = 0; i < 32; ++i) { s += st[i].x; s2 += st[i].y; }
    const float mu = s * (1.f / SGU_W), var = s2 * (1.f / SGU_W) - mu * mu;
    ((float2*)(P.ws + WS_MUR))[t] = make_float2(mu, rsqrtf(var + LN_EPS));
}
__global__ void __launch_bounds__(256) k_nsgu(Ptrs P) {
    const int n = blockIdx.x >> 3, g = blockIdx.x & 7, c = g * 256 + threadIdx.x;
    const bf16* GV = (const bf16*)(P.ws + WS_GV); bf16* UG = (bf16*)(P.ws + WS_UG); const float2* mur = (const float2*)(P.ws + WS_MUR);
    const float lg = P.ln_g[c], lb = P.ln_b[c];
    for (int t = 0; t < 128; ++t) {
        const float* wrow = P.w_s + ((size_t)g * 128 + t) * 128; float acc = 0.f;
        for (int s = 0; s <= t; ++s) { const float2 mr = mur[n * 128 + s]; const float vn = (bf2f(GV[(size_t)(n * 128 + s) * SGU_W + c]) - mr.x) * mr.y * lg + lb; acc += wrow[s] * vn; }
        acc += P.b_s[g * 128 + t];
        const size_t o = (size_t)(n * 128 + t) * SGU_W + c;
        UG[o] = (bf16)f2bf(bf2f(UG[o]) * acc);
    }
}

#endif
#ifndef FAST_MASK
#define FAST_MASK 0x1FF
#endif
extern "C" void kernel_launch(void* const* d_in, const int* in_sizes, int n_in, void* d_out, int out_size, void* d_ws, size_t ws_size, hipStream_t stream) {
    static int grid = 0;
    if (grid == 0) {
        if (n_in != 20 || in_sizes[0] != SEQ * DM || out_size != SEQ * DM || ws_size < WS_END) { fprintf(stderr, "kernel_launch: unexpected shapes (n_in %d out %d ws %zu); nothing launched\n", n_in, out_size, ws_size); grid = -1; return; }
        int dev = 0, cus = 0, per_cu = 0;
        if (hipGetDevice(&dev) != hipSuccess || hipDeviceGetAttribute(&cus, hipDeviceAttributeMultiprocessorCount, dev) != hipSuccess) { grid = -1; return; }
        if (hipFuncSetAttribute((const void*)mega_fwd, hipFuncAttributeMaxDynamicSharedMemorySize, LDS_BYTES) != hipSuccess) { fprintf(stderr, "kernel_launch: hipFuncSetAttribute failed\n"); grid = -1; return; }
        if (hipOccupancyMaxActiveBlocksPerMultiprocessor(&per_cu, (const void*)mega_fwd, NWAVES * 64, LDS_BYTES) != hipSuccess || per_cu < 1) fprintf(stderr, "kernel_launch: occupancy query reports %d blocks per CU\n", per_cu);
        (void)hipGetLastError();
        grid = cus;
        if (grid != 256) { fprintf(stderr, "kernel_launch: this kernel needs a 256-CU device (got %d)\n", grid); grid = -1; return; }
    }
    if (grid < 0) return;
    if (hipMemsetAsync((char*)d_ws + WS_CTL, 0, CTL_ZERO_BYTES, stream) != hipSuccess) return;
    Args a{};
    { const float** pp = (const float**)&a.p; for (int i = 0; i < 20; ++i) pp[i] = (const float*)d_in[i]; }
    a.p.out = (float*)d_out; a.p.ws = (unsigned char*)d_ws;
    const unsigned mask = FAST_MASK;
    int li = 0;
#if DEBUG_NAIVE
    const Ptrs P = a.p; unsigned char* ws = P.ws;
    if (mask && !(mask & 1u)) { a.ph_lo = 0; a.ph_hi = 1; a.li = li++; hipLaunchKernelGGL(mega_fwd, dim3(grid), dim3(NWAVES * 64), LDS_BYTES, stream, a); }
#endif
    for (int k = 0; k < N_PHASES;) {
        if (mask & (1u << k)) {
            int e = k; while (e < N_PHASES && (mask & (1u << e))) ++e;
            a.ph_lo = k; a.ph_hi = e; a.li = li++;
            hipLaunchKernelGGL(mega_fwd, dim3(grid), dim3(NWAVES * 64), LDS_BYTES, stream, a);
            k = e; continue;
        }
#if DEBUG_NAIVE
        switch (k) {
            case 0: k_rope<<<SEQ * 8 / 256, 256, 0, stream>>>((float2*)(ws + WS_ROPE)); k_rmsnorm<<<SEQ / 4, 256, 0, stream>>>(P.x, P.att_norm, (bf16*)(ws + WS_XN)); break;
            case 1: k_ngemm<1><<<dim3(64, SEQ / 64), 256, 0, stream>>>((const bf16*)(ws + WS_XN), DM, P.att_w_in, ATT_IN, DM, P); break;
            case 2: k_ndsw<<<3 * SEQ * 8 / 4, 256, 0, stream>>>(P); k_ndiff<<<SEQ * 8 / 4, 256, 0, stream>>>(P); break;
            case 3: k_merge<<<SEQ / 4, 256, 0, stream>>>(P); break;
            case 4: k_ngemm<2><<<dim3(16, SEQ / 64), 256, 0, stream>>>((const bf16*)(ws + WS_G), DM, P.att_w_out, DM, DM, P); break;
            case 5: k_rmsnorm<<<SEQ / 4, 256, 0, stream>>>(P.out, P.sgu_norm, (bf16*)(ws + WS_XN)); break;
            case 6: k_ngemm<3><<<dim3(64, SEQ / 64), 256, 0, stream>>>((const bf16*)(ws + WS_XN), DM, P.sgu_w_in, SGU_IN, DM, P); break;
            case 7: k_nstats<<<SEQ / 256, 256, 0, stream>>>(P); k_nsgu<<<128 * 8, 256, 0, stream>>>(P); break;
            case 8: k_ngemm<4><<<dim3(16, SEQ / 64), 256, 0, stream>>>((const bf16*)(ws + WS_UG), SGU_W, P.sgu_w_out, DM, SGU_W, P); break;
        }
#endif
        ++k;
    }
}
```

```cpp
#include <hip/hip_runtime.h>
#include <hip/hip_bf16.h>
#include <cstdint>
#include <cstdio>
#include <cmath>

constexpr int SEQ = 16384, DM = 1024;
constexpr int ATT_IN = 4096, SGU_W = 2048, SGU_IN = 6144;
constexpr float RMS_EPS = 1e-6f, LN_EPS = 1e-5f;
constexpr float C2 = 0.18033688011112042f;
constexpr float LAM_INIT = 0.2f;

typedef unsigned short bf16;
typedef float f32x4 __attribute__((ext_vector_type(4)));

constexpr size_t MiB = 1u << 20;
constexpr size_t WS_CTL = 0, CTL_ZERO_BYTES = 1 * MiB;
constexpr size_t WS_ROPE = 1 * MiB;
constexpr size_t WS_W1T = 2 * MiB, WS_WOT = 10 * MiB, WS_W2T = 12 * MiB, WS_W3T = 24 * MiB;
constexpr size_t WS_STAT = 28 * MiB;
constexpr size_t WS_XN = 32 * MiB;
constexpr size_t WS_DO0 = 32 * MiB, WS_DO1 = 48 * MiB;
constexpr size_t WS_QA = 64 * MiB, WS_KA = 80 * MiB, WS_VA = 96 * MiB, WS_QD = 112 * MiB, WS_KD = 128 * MiB, WS_VD = 144 * MiB;
constexpr size_t WS_G = 160 * MiB;
constexpr size_t WS_OP = 192 * MiB;
constexpr size_t WS_LSE = 240 * MiB;
constexpr size_t WS_MUR = 242 * MiB;
constexpr size_t WS_WSB = 243 * MiB;
constexpr size_t WS_GAIN = 243 * MiB + 262144;
constexpr size_t WS_UG = 64 * MiB;
constexpr size_t WS_GV = 128 * MiB;
constexpr size_t WS_END = 256 * MiB;

__device__ __forceinline__ float bf2f(unsigned h) { return __builtin_bit_cast(float, h << 16); }
__device__ __forceinline__ float wave_sum(float v) {
#pragma unroll
    for (int o = 1; o < 64; o <<= 1) v += __shfl_xor(v, o);
    return v;
}
__device__ __forceinline__ float silu_f(float v) { return v / (1.f + __expf(-v)); }
__device__ __forceinline__ float gelu_f(float v) { return 0.5f * v * (1.f + erff(v * 0.70710678118654752f)); }

__device__ __forceinline__ int opaque_lane() { unsigned m = ~0u; asm volatile("" : "+s"(m)); return (int)__builtin_amdgcn_mbcnt_hi(m, __builtin_amdgcn_mbcnt_lo(m, 0u)); }

struct Ptrs {
    const float* x; const float* att_norm; const float* att_w_in; const float* dsw_qg; const float* dsw_kg; const float* diff_qg; const float* diff_kg;
    const float* lq1; const float* lk1; const float* lq2; const float* lk2; const float* subln; const float* att_w_out;
    const float* sgu_norm; const float* sgu_w_in; const float* ln_g; const float* ln_b; const float* w_s; const float* b_s; const float* sgu_w_out;
    float* out; unsigned char* ws;
};
#define FAST_MASK 0x1FF
#define DEBUG_NAIVE 0

namespace pg8 {
#define PG8_LAS __attribute__((address_space(3)))
typedef unsigned short bf16_t;
typedef short bf16x8 __attribute__((ext_vector_type(8)));
typedef float f32x4 __attribute__((ext_vector_type(4)));
typedef unsigned u32x4 __attribute__((ext_vector_type(4)));
constexpr int BM = 256, BK = 64, HALF = 128, HTB = HALF * BK * 2  , STAGE_BYTES = 8 * HTB, NXCD = 8, WGM = 8;

__host__ __device__ __forceinline__ int lds_byte(int r, int c) { const int st = (r >> 4) * 2 + (c >> 5), rr = r & 15, cc = c & 31, ob = rr * 64 + cc * 2; return st * 1024 + (ob ^ (((ob >> 9) & 1) << 5)); }
__host__ __device__ __forceinline__ void stage_rc(int b, int& R, int& C) { const int st = b / 1024, sb = b % 1024, swz = sb ^ (((sb >> 9) & 1) << 5); R = (st >> 1) * 16 + swz / 64; C = (st & 1) * 32 + (swz % 64) / 2; }
__host__ __device__ __forceinline__ int perm32(int rho) { const int n = rho >> 4, i = rho & 15; return 8 * (i >> 2) + 4 * n + (i & 3); }

struct Unit { int pm, pn; };
struct Gemm { const bf16_t* A; const bf16_t* Bt; int M, N, K; };

struct StaticOrder {
    int nM, nN, nwg, G, c;
    __host__ __device__ void init(int M, int N, int G_, int c_) { nM = M / BM; nN = N / BM; nwg = nM * nN; G = G_; c = c_; }
    __host__ __device__ bool next(int i, Unit& u) const {
        const long L = (long)i * G + c; if (L >= nwg) return false;
        int wgid = (int)L; { const int q = nwg / NXCD, r = nwg % NXCD, xcd = wgid % NXCD, off = wgid / NXCD; wgid = (xcd < r ? xcd * (q + 1) : r * (q + 1) + (xcd - r) * q) + off; }
        const int nig = WGM * nN, gid = wgid / nig, fm = gid * WGM, gsz = (nM - fm) < WGM ? (nM - fm) : WGM;
        u.pm = fm + ((wgid % nig) % gsz); u.pn = (wgid % nig) / gsz; return true;
    }
    __device__ __forceinline__ void a_ready(const Unit&) const {}
    __device__ __forceinline__ void done(const Unit&) const {}
};

__device__ __forceinline__ unsigned cvt_pk_bf16(float lo, float hi) { unsigned r; asm volatile("v_cvt_pk_bf16_f32 %0, %1, %2" : "=v"(r) : "v"(lo), "v"(hi)); return r; }
typedef float f32x2 __attribute__((ext_vector_type(2)));
__device__ __forceinline__ f32x2 gelu_pk(f32x2 v) {
    const f32x2 av = __builtin_elementwise_abs(v), d = av * 0.2316418882f + 1.0f;
    f32x2 t; t.x = __builtin_amdgcn_rcpf(d.x); t.y = __builtin_amdgcn_rcpf(d.y);
    f32x2 q = t * 0.5307027145f + (-0.7265760135f); q = q * t + 0.7107068705f; q = q * t + (-0.142248368f); q = q * t + 0.127414796f; q = q * t;
    const f32x2 s = (v * v) * (-0.72134752044f);
    f32x2 e; e.x = __builtin_amdgcn_exp2f(s.x); e.y = __builtin_amdgcn_exp2f(s.y);
    const f32x2 m = v * (q * e), r = v - m;
    f32x2 o; o.x = v.x < 0.f ? m.x : r.x; o.y = v.y < 0.f ? m.y : r.y; return o;
}
typedef float f32x2e __attribute__((ext_vector_type(2)));
__device__ __forceinline__ f32x4 silu4(f32x4 v) { f32x4 o; o.x = v.x / (1.f + __expf(-v.x)); o.y = v.y / (1.f + __expf(-v.y)); o.z = v.z / (1.f + __expf(-v.z)); o.w = v.w / (1.f + __expf(-v.w)); return o; }
__device__ __forceinline__ f32x4 gelu4(f32x4 v) { const f32x2 a = gelu_pk((f32x2){v.x, v.y}), b = gelu_pk((f32x2){v.z, v.w}); return (f32x4){a.x, a.y, b.x, b.y}; }
__device__ __forceinline__ u32x4 pack8(f32x4 a, f32x4 b) { u32x4 w; w.x = cvt_pk_bf16(a.x, a.y); w.y = cvt_pk_bf16(a.z, a.w); w.z = cvt_pk_bf16(b.x, b.y); w.w = cvt_pk_bf16(b.z, b.w); return w; }

struct EpiProj1 {
    static constexpr bool PERM = true, AFTER_DRAIN = false;
    unsigned char* ws;
    __device__ __forceinline__ void operator()(const f32x4 (&acc)[2][2][4][2], const Unit& u, int wr, int wc, int fr, int fq) const {
        const int type = u.pn >> 1;
        const int row0 = u.pm * BM + wr * 64 + fr;
        const int hcol = (u.pn & 1) * 256 + wc * 64 + 8 * fq;
        const bool isg = (type & 3) == 3;
        const int slot = type - (type >> 2);
        const size_t boff = isg ? (WS_G + (size_t)(type >> 2) * 1024) : (WS_QA + (size_t)slot * (16 * MiB));
        const int pitch = isg ? 1024 : 512;
        bf16_t* dst = (bf16_t*)(ws + boff) + hcol;
        if ((type & 2) == 0) {
            const float* gp = (const float*)(ws + WS_GAIN) + ((type & 1) + 2 * (type >> 2)) * 64;
            const float qs = (type & 1) ? 1.f : C2;
            f32x4 gn[2][2];
#pragma unroll
            for (int bj = 0; bj < 2; ++bj)
#pragma unroll
                for (int n = 0; n < 2; ++n) gn[bj][n] = *(const f32x4*)(gp + 32 * bj + 8 * fq + 4 * n);
            const float2* tab = (const float2*)(ws + WS_ROPE);
#pragma unroll
            for (int ai = 0; ai < 2; ++ai)
#pragma unroll
                for (int m = 0; m < 4; ++m) {
                    const int row = row0 + ai * HALF + m * 16;
                    f32x4 v[2][2]; float ss = 0.f;
#pragma unroll
                    for (int bj = 0; bj < 2; ++bj)
#pragma unroll
                        for (int n = 0; n < 2; ++n) { v[bj][n] = acc[ai][bj][m][n]; const f32x4 q = v[bj][n] * v[bj][n]; ss += (q.x + q.y) + (q.z + q.w); }
                    ss += __shfl_xor(ss, 16); ss += __shfl_xor(ss, 32);
                    const float ri = rsqrtf(ss * (1.f / 64.f) + RMS_EPS) * qs;
#pragma unroll
                    for (int bj = 0; bj < 2; ++bj)
#pragma unroll
                        for (int n = 0; n < 2; ++n) v[bj][n] = v[bj][n] * ri * gn[bj][n];
                    f32x4 ot[2];
#pragma unroll
                    for (int n = 0; n < 2; ++n) { ot[n].x = __shfl_xor(v[0][n].x, 16); ot[n].y = __shfl_xor(v[0][n].y, 16); ot[n].z = __shfl_xor(v[0][n].z, 16); ot[n].w = __shfl_xor(v[0][n].w, 16); }
                    if (fq < 2) {
                        const f32x4* tp = (const f32x4*)(tab + (size_t)row * 8);
                        const float sg = (fq == 0) ? -1.f : 1.f;
#pragma unroll
                        for (int n = 0; n < 2; ++n) { const f32x4 t0 = tp[2 * n], t1 = tp[2 * n + 1];
                            v[0][n].x = v[0][n].x * t0.x + sg * ot[n].x * t0.y; v[0][n].y = v[0][n].y * t0.z + sg * ot[n].y * t0.w;
                            v[0][n].z = v[0][n].z * t1.x + sg * ot[n].z * t1.y; v[0][n].w = v[0][n].w * t1.z + sg * ot[n].w * t1.w; }
                    }
                    bf16_t* rowp = dst + (size_t)row * pitch;
                    *(u32x4*)(rowp) = pack8(v[0][0], v[0][1]); *(u32x4*)(rowp + 32) = pack8(v[1][0], v[1][1]);
                }
        } else {
            const bool gate = (type & 1);
#pragma unroll
            for (int ai = 0; ai < 2; ++ai)
#pragma unroll
                for (int m = 0; m < 4; ++m) {
                    bf16_t* rowp = dst + (size_t)(row0 + ai * HALF + m * 16) * pitch;
#pragma unroll
                    for (int bj = 0; bj < 2; ++bj) { f32x4 a = acc[ai][bj][m][0], b = acc[ai][bj][m][1]; if (gate) { a = silu4(a); b = silu4(b); }
                        *(u32x4*)(rowp + 32 * bj) = pack8(a, b); }
                }
        }
    }
};
struct EpiRes {
    static constexpr bool PERM = false, AFTER_DRAIN = false;
    const float* base; float* out;
    __device__ __forceinline__ void operator()(const f32x4 (&acc)[2][2][4][2], const Unit& u, int wr, int wc, int fr, int fq) const {
        const int row0 = u.pm * BM + wr * 64 + fr, col0 = u.pn * BM + wc * 32 + 4 * fq;
#pragma unroll
        for (int ai = 0; ai < 2; ++ai)
#pragma unroll
            for (int m = 0; m < 4; ++m) { const size_t off = (size_t)(row0 + ai * HALF + m * 16) * DM + col0;
#pragma unroll
                for (int bj = 0; bj < 2; ++bj)
#pragma unroll
                    for (int n = 0; n < 2; ++n) { const f32x4 b = *(const f32x4*)(base + off + bj * HALF + n * 16); *(f32x4*)(out + off + bj * HALF + n * 16) = b + acc[ai][bj][m][n]; } }
    }
};
struct EpiProj2 {
    static constexpr bool PERM = true, AFTER_DRAIN = false;
    unsigned char* ws;
    __device__ __forceinline__ void operator()(const f32x4 (&acc)[2][2][4][2], const Unit& u, int wr, int wc, int fr, int fq) const {
        const int row0 = u.pm * BM + wr * 64 + fr;
        if (u.pn < 16) {
            bf16_t* dst = (bf16_t*)(ws + WS_UG) + u.pn * 128 + wc * 32 + 8 * fq;
#pragma unroll
            for (int ai = 0; ai < 2; ++ai)
#pragma unroll
                for (int m = 0; m < 4; ++m) {
                    const f32x4 a = gelu4(acc[ai][0][m][0]) * silu4(acc[ai][1][m][0]), b = gelu4(acc[ai][0][m][1]) * silu4(acc[ai][1][m][1]);
                    *(u32x4*)(dst + (size_t)(row0 + ai * HALF + m * 16) * SGU_W) = pack8(a, b);
                }
        } else {
            const int t = u.pn - 16;
            bf16_t* dst = (bf16_t*)(ws + WS_GV) + t * 256 + wc * 32 + 8 * fq;
            float2* st = (float2*)(ws + WS_STAT) + t * 4 + wc;
#pragma unroll
            for (int ai = 0; ai < 2; ++ai)
#pragma unroll
                for (int m = 0; m < 4; ++m) {
                    const int row = row0 + ai * HALF + m * 16; float s = 0.f, s2 = 0.f;
#pragma unroll
                    for (int bj = 0; bj < 2; ++bj) { const f32x4 a = gelu4(acc[ai][bj][m][0]), b = gelu4(acc[ai][bj][m][1]);
                        s += ((a.x + a.y) + (a.z + a.w)) + ((b.x + b.y) + (b.z + b.w));
                        s2 += ((a.x * a.x + a.y * a.y) + (a.z * a.z + a.w * a.w)) + ((b.x * b.x + b.y * b.y) + (b.z * b.z + b.w * b.w));
                        *(u32x4*)(dst + (size_t)row * SGU_W + bj * HALF) = pack8(a, b); }
                    s += __shfl_xor(s, 16); s += __shfl_xor(s, 32); s2 += __shfl_xor(s2, 16); s2 += __shfl_xor(s2, 32);
                    if (fq == 0) st[(size_t)row * 32] = make_float2(s, s2);
                }
        }
    }
};
template <class Epi, class Sched, bool ALIGN_EPI = false, bool SP2 = false>
__device__ __forceinline__ void gemm_phase(PG8_LAS unsigned char* lds, const Gemm g, const Sched& S, const Epi& E, const int wave_) {
    const int tid = wave_ * 64 + opaque_lane(), wid = wave_    , lane = tid & 63, wr = wid >> 2, wc = wid & 3, fr = lane & 15, fq = lane >> 4;
    const int K = g.K, nt = K / BK;
    unsigned voffA[2], voffB[2];
#pragma unroll
    for (int i = 0; i < 2; ++i) { int R, C; stage_rc(tid * 16 + i * 8192, R, C); const int Rb = Epi::PERM ? ((R & ~31) + perm32(R & 31)) : R;
        voffA[i] = (unsigned)(R * K + C) * 2u; voffB[i] = (unsigned)(Rb * K + C) * 2u; }
    const size_t kstep = (size_t)(BK * 2);
    const size_t hstep = (size_t)HALF * K * 2;
    const size_t tstep = 2 * hstep;
    const unsigned ldsw = (unsigned)wid * 1024u;
    const int aoff = lds_byte(wr * 64 + fr, fq * 8), boff = lds_byte(wc * 32 + fr, fq * 8);
#define PG8_SA(b, h) (((b) * 2 + (h)) * HTB)
#define PG8_SB(b, h) ((4 + (b) * 2 + (h)) * HTB)
#define PG8_STAGE(bufoff, gbase, voff) do { _Pragma("unroll") for (int _i = 0; _i < 2; ++_i) \
        __builtin_amdgcn_global_load_lds((const unsigned*)((const char*)(gbase) + (voff)[_i]), (PG8_LAS unsigned*)(lds + (bufoff) + ldsw + _i * 8192), 16, 0, 0); } while (0)
#define PG8_LDA(dst, b, h) do { _Pragma("unroll") for (int m = 0; m < 4; ++m) _Pragma("unroll") for (int k = 0; k < 2; ++k) dst[m][k] = *(const PG8_LAS bf16x8*)(lds + PG8_SA(b, h) + aoff + m * 2048 + k * 1024); } while (0)
#define PG8_LDB(dst, b, h) do { _Pragma("unroll") for (int n = 0; n < 2; ++n) _Pragma("unroll") for (int k = 0; k < 2; ++k) dst[n][k] = *(const PG8_LAS bf16x8*)(lds + PG8_SB(b, h) + boff + n * 2048 + k * 1024); } while (0)
#define PG8_MMA(ai, bj, At, Bt) do { __builtin_amdgcn_s_setprio(1); _Pragma("unroll") for (int m = 0; m < 4; ++m) _Pragma("unroll") for (int n = 0; n < 2; ++n) _Pragma("unroll") for (int k = 0; k < 2; ++k) \
        acc[ai][bj][m][n] = __builtin_amdgcn_mfma_f32_16x16x32_bf16(Bt[n][k], At[m][k], acc[ai][bj][m][n], 0, 0, 0); __builtin_amdgcn_s_setprio(0); } while (0)
#define PG8_WAIT_V(n) asm volatile("s_waitcnt vmcnt(" #n ")" ::: "memory")
#define PG8_WAIT_L(n) asm volatile("s_waitcnt lgkmcnt(" #n ")" ::: "memory")
#define PG8_BAR __builtin_amdgcn_s_barrier()
#define PG8_SCHED __builtin_amdgcn_sched_barrier(0)
    Unit cur, nxt; int ui = 0;
    if (!S.next(0, cur)) return;
    f32x4 acc[2][2][4][2];
#pragma unroll
    for (int a = 0; a < 2; ++a)
#pragma unroll
        for (int b = 0; b < 2; ++b)
#pragma unroll
            for (int m = 0; m < 4; ++m)
#pragma unroll
                for (int n = 0; n < 2; ++n) acc[a][b][m][n] = (f32x4){0.f, 0.f, 0.f, 0.f};
    bf16x8 At[4][2], B0[2][2], B1[2][2];
    const char* cA = (const char*)g.A + (size_t)cur.pm * tstep; const char* cB = (const char*)g.Bt + (size_t)cur.pn * tstep;
    S.a_ready(cur);
    if constexpr (SP2) {
        PG8_STAGE(PG8_SB(0, 0), cB, voffB); PG8_STAGE(PG8_SB(0, 1), cB + hstep, voffB); PG8_STAGE(PG8_SA(0, 0), cA, voffA); PG8_STAGE(PG8_SA(0, 1), cA + hstep, voffA);
        if (wr == 1) PG8_BAR;
        PG8_WAIT_V(2); PG8_BAR;
        PG8_STAGE(PG8_SB(1, 0), cB + kstep, voffB); PG8_STAGE(PG8_SA(1, 0), cA + kstep, voffA); PG8_STAGE(PG8_SB(1, 1), cB + hstep + kstep, voffB);
        PG8_WAIT_V(6); PG8_BAR;
    } else {
        PG8_STAGE(PG8_SB(0, 0), cB, voffB); PG8_STAGE(PG8_SA(0, 0), cA, voffA); PG8_STAGE(PG8_SB(0, 1), cB + hstep, voffB); PG8_STAGE(PG8_SA(0, 1), cA + hstep, voffA);
        if (wr == 1) PG8_BAR;
        PG8_WAIT_V(4); PG8_BAR;
        PG8_STAGE(PG8_SB(1, 0), cB + kstep, voffB); PG8_STAGE(PG8_SA(1, 0), cA + kstep, voffA); PG8_STAGE(PG8_SB(1, 1), cB + hstep + kstep, voffB);
        PG8_WAIT_V(6); PG8_BAR;
    }
    for (;;) {
        const bool has_next = S.next(ui + 1, nxt);
        const char* nA = has_next ? (const char*)g.A + (size_t)nxt.pm * tstep : cA; const char* nB = has_next ? (const char*)g.Bt + (size_t)nxt.pn * tstep : cB;
        for (int t = 0; t < nt; t += 2) {
            const bool last = (t == nt - 2);
            const char* a1 = cA + (size_t)(t + 1) * kstep;
            const char* a2 = last ? nA : cA + (size_t)(t + 2) * kstep; const char* b2 = last ? nB : cB + (size_t)(t + 2) * kstep;
            const char* a3 = a2 + kstep; const char* b3 = b2 + kstep;
            if (last && has_next) S.a_ready(nxt);
            if constexpr (SP2) {
            PG8_LDB(B0, 0, 0); PG8_LDB(B1, 0, 1); PG8_SCHED; PG8_LDA(At, 0, 0); PG8_STAGE(PG8_SA(1, 1), a1 + hstep, voffA);
            PG8_WAIT_V(8); PG8_WAIT_L(0); PG8_BAR; PG8_MMA(0, 0, At, B0); PG8_MMA(0, 1, At, B1); PG8_BAR; PG8_SCHED;
            PG8_LDA(At, 0, 1); PG8_STAGE(PG8_SB(0, 0), b2, voffB); PG8_STAGE(PG8_SB(0, 1), b2 + hstep, voffB); PG8_STAGE(PG8_SA(0, 0), a2, voffA);
            PG8_WAIT_V(8); PG8_WAIT_L(0); PG8_BAR; PG8_MMA(1, 0, At, B0); PG8_MMA(1, 1, At, B1); PG8_BAR; PG8_SCHED;
            PG8_LDB(B0, 1, 0); PG8_LDB(B1, 1, 1); PG8_SCHED; PG8_LDA(At, 1, 0); PG8_STAGE(PG8_SA(0, 1), a2 + hstep, voffA);
            PG8_WAIT_V(8); PG8_WAIT_L(0); PG8_BAR; PG8_MMA(0, 0, At, B0); PG8_MMA(0, 1, At, B1); PG8_BAR; PG8_SCHED;
            PG8_LDA(At, 1, 1); PG8_STAGE(PG8_SB(1, 0), b3, voffB); PG8_STAGE(PG8_SB(1, 1), b3 + hstep, voffB); PG8_STAGE(PG8_SA(1, 0), a3, voffA);
            PG8_WAIT_V(8); PG8_WAIT_L(0); PG8_BAR; PG8_MMA(1, 0, At, B0); PG8_MMA(1, 1, At, B1); PG8_BAR; PG8_SCHED;
            } else {
            PG8_LDB(B0, 0, 0); PG8_SCHED; PG8_LDA(At, 0, 0); PG8_STAGE(PG8_SA(1, 1), a1 + hstep, voffA);
            PG8_WAIT_L(8); PG8_BAR; PG8_WAIT_L(0); PG8_MMA(0, 0, At, B0); PG8_BAR; PG8_SCHED;
            PG8_LDB(B1, 0, 1); PG8_STAGE(PG8_SB(0, 0), b2, voffB);
            PG8_BAR; PG8_WAIT_L(0); PG8_MMA(0, 1, At, B1); PG8_BAR;
            PG8_LDA(At, 0, 1); PG8_STAGE(PG8_SA(0, 0), a2, voffA);
            PG8_BAR; PG8_WAIT_L(0); PG8_MMA(1, 0, At, B0); PG8_BAR; PG8_SCHED;
            PG8_STAGE(PG8_SB(0, 1), b2 + hstep, voffB);
            PG8_WAIT_V(6); PG8_BAR; PG8_MMA(1, 1, At, B1); PG8_BAR;
            PG8_LDB(B0, 1, 0); PG8_SCHED; PG8_LDA(At, 1, 0); PG8_STAGE(PG8_SA(0, 1), a2 + hstep, voffA);
            PG8_WAIT_L(8); PG8_BAR; PG8_WAIT_L(0); PG8_MMA(0, 0, At, B0); PG8_BAR; PG8_SCHED;
            PG8_LDB(B1, 1, 1); PG8_STAGE(PG8_SB(1, 0), b3, voffB);
            PG8_BAR; PG8_WAIT_L(0); PG8_MMA(0, 1, At, B1); PG8_BAR;
            PG8_LDA(At, 1, 1); PG8_STAGE(PG8_SA(1, 0), a3, voffA);
            PG8_BAR; PG8_WAIT_L(0); PG8_MMA(1, 0, At, B0); PG8_BAR; PG8_SCHED;
            PG8_STAGE(PG8_SB(1, 1), b3 + hstep, voffB);
            PG8_WAIT_V(6); PG8_BAR; PG8_MMA(1, 1, At, B1); PG8_BAR;
            }
        }
        if constexpr (ALIGN_EPI) { if (wr == 0) PG8_BAR; }
        if constexpr (!Epi::AFTER_DRAIN) { E(acc, cur, wr, wc, fr, fq); S.done(cur); }
        if (!has_next) break;
#pragma unroll
        for (int a = 0; a < 2; ++a)
#pragma unroll
            for (int b = 0; b < 2; ++b)
#pragma unroll
                for (int m = 0; m < 4; ++m)
#pragma unroll
                    for (int n = 0; n < 2; ++n) acc[a][b][m][n] = (f32x4){0.f, 0.f, 0.f, 0.f};
        cur = nxt; cA = nA; cB = nB; ++ui;
        if constexpr (ALIGN_EPI) { if (wr == 1) PG8_BAR; }
    }
    PG8_WAIT_V(0);
    if constexpr (!ALIGN_EPI) { if (wr == 0) PG8_BAR; }
    PG8_BAR;
    if constexpr (Epi::AFTER_DRAIN) { E.fused(acc, cur, wr, wc, fr, fq, lds, wid, lane); S.done(cur); }
#undef PG8_SA
#undef PG8_SB
#undef PG8_STAGE
#undef PG8_LDA
#undef PG8_LDB
#undef PG8_MMA
#undef PG8_WAIT_V
#undef PG8_WAIT_L
#undef PG8_BAR
#undef PG8_SCHED
}
}

#ifndef PG8_SP2
#define PG8_SP2 true
#endif
#ifndef PG8_ALIGN
#define PG8_ALIGN true
#endif
#include <hip/hip_bf16.h>
#include <cmath>
namespace attn_body {
using bf16=__hip_bfloat16;
using bf16x8=__attribute__((ext_vector_type(8)))short;
using s16x4=__attribute__((ext_vector_type(4)))short;
using f32x16=__attribute__((ext_vector_type(16)))float;
using u32x4=__attribute__((ext_vector_type(4)))unsigned;
constexpr int SEQ=16384,D=64,DM=512;
constexpr int NW=8,QBLK=32,QB=QBLK*NW,KVBLK=64,NQB=SEQ/QB;
constexpr int ATTN_PITCH=DM, ATTN_UNIT_ROWS=QB;
__device__ __forceinline__ int crow(int r,int hi){return (r&3)+8*(r>>2)+4*hi;}
#define SBAR() __builtin_amdgcn_sched_barrier(0)
__device__ __forceinline__ void cmask(f32x16&p0,f32x16&p1,int jb,int qrel,int hi){
  const float NEG=-INFINITY; int kb=64*jb+4*hi;
  #pragma unroll
  for(int r=0;r<16;++r){int kv=kb+(r&3)+8*(r>>2); if(kv>qrel)p0[r]=NEG; if(kv+32>qrel)p1[r]=NEG;}
}

constexpr int NSLOT=3, SLOTB=8192;
constexpr int LDS_K=0, LDS_V=NSLOT*SLOTB, LDS_WS=2*NSLOT*SLOTB, LDS_OST=LDS_WS+NW*64*4, LDS_BYTES=LDS_OST+NW*4096;
constexpr float C2=0.125f*1.4426950408889634f;
__device__ __forceinline__ void glds16(const void*gsrc,unsigned lds_dst){unsigned keep;
  asm volatile("s_mov_b32 %0, m0\n\ts_mov_b32 m0, %2\n\ts_nop 0\n\tglobal_load_lds_dwordx4 %1, off\n\ts_mov_b32 m0, %0":"=&s"(keep):"v"(gsrc),"s"(lds_dst):"memory");}
__device__ __forceinline__ float max3f(float a,float b,float c){float r;asm("v_max3_f32 %0, %1, %2, %3":"=v"(r):"v"(a),"v"(b),"v"(c));return r;}
__device__ __forceinline__ float max2f(float a,float b){float r;asm("v_max_f32_e32 %0, %1, %2":"=v"(r):"v"(a),"v"(b));return r;}
__device__ __forceinline__ float fadd_s(float a,float b){float r;asm("v_add_f32_e32 %0, %1, %2":"=v"(r):"v"(a),"v"(b));return r;}
__device__ __forceinline__ float fsub_s(float a,float b){float r;asm("v_sub_f32_e32 %0, %1, %2":"=v"(r):"v"(a),"v"(b));return r;}
typedef float f32x2_t __attribute__((ext_vector_type(2))); typedef __bf16 bf16x2_t __attribute__((ext_vector_type(2)));
__device__ __forceinline__ unsigned cvtpk_s(float lo,float hi){f32x2_t v={lo,hi};bf16x2_t b=__builtin_convertvector(v,bf16x2_t);return __builtin_bit_cast(unsigned,b);}
#define WAIT_BAR(N) asm volatile("s_waitcnt vmcnt(" #N ") lgkmcnt(0)\n\ts_barrier":::"memory")

__device__ __forceinline__ void qkt(f32x16&p0,f32x16&p1,const char*Kslot,const bf16x8*qr,const f32x16&negm,int r32,int hi){
  const char*kb=Kslot+hi*1024+r32*16;
  #pragma unroll
  for(int d0=0;d0<4;++d0){
    const bf16x8 b0=*reinterpret_cast<const bf16x8*>(kb+d0*2048);
    const bf16x8 b1=*reinterpret_cast<const bf16x8*>(kb+d0*2048+512);
    if(d0==0){p0=__builtin_amdgcn_mfma_f32_32x32x16_bf16(b0,qr[0],negm,0,0,0);p1=__builtin_amdgcn_mfma_f32_32x32x16_bf16(b1,qr[0],negm,0,0,0);}
    else{p0=__builtin_amdgcn_mfma_f32_32x32x16_bf16(b0,qr[d0],p0,0,0,0);p1=__builtin_amdgcn_mfma_f32_32x32x16_bf16(b1,qr[d0],p1,0,0,0);}}
}
typedef __attribute__((address_space(3))) const char* lds_cptr;
typedef short v4i16_t __attribute__((ext_vector_type(4)));
__device__ __forceinline__ void kload8(bf16x8*kf,lds_cptr kp){
  kf[0]=*(const __attribute__((address_space(3))) bf16x8*)(kp);      kf[1]=*(const __attribute__((address_space(3))) bf16x8*)(kp+512);
  kf[2]=*(const __attribute__((address_space(3))) bf16x8*)(kp+2048); kf[3]=*(const __attribute__((address_space(3))) bf16x8*)(kp+2560);
  kf[4]=*(const __attribute__((address_space(3))) bf16x8*)(kp+4096); kf[5]=*(const __attribute__((address_space(3))) bf16x8*)(kp+4608);
  kf[6]=*(const __attribute__((address_space(3))) bf16x8*)(kp+6144); kf[7]=*(const __attribute__((address_space(3))) bf16x8*)(kp+6656);
}
__device__ __forceinline__ void kload2(bf16x8*kf,lds_cptr kp,int j){ kf[2*j]=*(const __attribute__((address_space(3))) bf16x8*)(kp+j*2048); kf[2*j+1]=*(const __attribute__((address_space(3))) bf16x8*)(kp+j*2048+512); }
__device__ __forceinline__ s16x4 vtr(lds_cptr p){ return __builtin_bit_cast(s16x4,__builtin_amdgcn_ds_read_tr16_b64_v4i16((__attribute__((address_space(3))) v4i16_t*)p)); }
__device__ __forceinline__ float rowmax(const f32x16&p0,const f32x16&p1){
  float a=max3f(p0[0],p0[1],p1[0]),b=max3f(p0[2],p0[3],p1[1]);a=max3f(a,p1[2],p1[3]);
  #pragma unroll
  for(int r=4;r<16;r+=4){a=max3f(a,p0[r],p0[r+1]);b=max3f(b,p0[r+2],p0[r+3]);a=max3f(a,p1[r],p1[r+1]);b=max3f(b,p1[r+2],p1[r+3]);}
  const float m=max2f(a,b);
  auto rr=__builtin_amdgcn_permlane32_swap(__float_as_uint(m),__float_as_uint(m),false,false);
  return max2f(__uint_as_float(rr[0]),__uint_as_float(rr[1]));
}
__device__ __forceinline__ void pv(f32x16*o,int vb,bf16x8 pa0,bf16x8 pa1,bf16x8 pa2,bf16x8 pa3){
  #pragma unroll
  for(int d0=0;d0<2;++d0){s16x4 lo[4],hi[4];
    #pragma unroll
    for(int ks=0;ks<4;++ks){
      asm volatile("ds_read_b64_tr_b16 %0,%1 offset:%c2":"=&v"(lo[ks]):"v"(vb),"i"(d0*4096+ks*1024):"memory");
      asm volatile("ds_read_b64_tr_b16 %0,%1 offset:%c2":"=&v"(hi[ks]):"v"(vb),"i"(d0*4096+ks*1024+512):"memory");}
    asm volatile("s_waitcnt lgkmcnt(0)":::"memory");SBAR();
    #define PK(k) (bf16x8){lo[k][0],lo[k][1],lo[k][2],lo[k][3],hi[k][0],hi[k][1],hi[k][2],hi[k][3]}
    o[d0]=__builtin_amdgcn_mfma_f32_32x32x16_bf16(pa0,PK(0),o[d0],0,0,0);
    o[d0]=__builtin_amdgcn_mfma_f32_32x32x16_bf16(pa1,PK(1),o[d0],0,0,0);
    o[d0]=__builtin_amdgcn_mfma_f32_32x32x16_bf16(pa2,PK(2),o[d0],0,0,0);
    o[d0]=__builtin_amdgcn_mfma_f32_32x32x16_bf16(pa3,PK(3),o[d0],0,0,0);
    #undef PK
  }
}

#ifndef ATTN_STORE16
#define ATTN_STORE16(p,v) (*(u32x4*)(p)=(v))
#endif
template<int THRL> __device__ __forceinline__ void attn_unit(int qb,const bf16*Qh,const bf16*__restrict__ Kh,const bf16*__restrict__ Vh,bf16*Oh,char*shm,const int wid){
  const int lane=opaque_lane(),tid=wid*64+lane,r32=lane&31,hi=lane>>5;
  const int q0=qb*QB;
  const bf16*Qw=Qh+(long)(q0+wid*QBLK)*DM;
  const unsigned lds0=(unsigned)(uintptr_t)shm;
  float*wsf=(float*)(shm+LDS_WS)+wid*64;
  const bf16*ksrc=Kh+(long)lane*DM+wid*8;
  const bf16*vsrc=Vh+(long)(16*(wid&3)+(lane>>2))*DM+(wid>>2)*32+(lane&3)*8;
  const unsigned kdst=lds0+LDS_K+wid*1024, vdst=lds0+LDS_V+wid*1024;
  #define DMA_K(t,slot) glds16(ksrc+(long)(t)*KVBLK*DM,(unsigned)__builtin_amdgcn_readfirstlane(kdst+(slot)))
  #define DMA_V(t,slot) glds16(vsrc+(long)(t)*KVBLK*DM,(unsigned)__builtin_amdgcn_readfirstlane(vdst+(slot)))
  const int vb0=(int)(lds0+LDS_V)+((lane>>4)&1)*32+(lane&3)*8+(4*hi+((lane&15)>>2))*64;
  const char*Kbase=shm+LDS_K; bf16x8 kf[8];
  const lds_cptr shm3=(lds_cptr)shm; const lds_cptr kp0=shm3+LDS_K+hi*1024+r32*16; const lds_cptr vp0=shm3+LDS_V+((lane>>4)&1)*32+(lane&3)*8+(4*hi+((lane&15)>>2))*64;
  const int NT=(q0+QB)/KVBLK;
  DMA_K(0,0);DMA_V(0,0);DMA_K(1,SLOTB);
  bf16x8 qr[4];
  #pragma unroll
  for(int d0=0;d0<4;++d0)qr[d0]=*reinterpret_cast<const bf16x8*>(&Qw[(long)r32*DM+d0*16+hi*8]);
  float mhat=0.f,l_reg=0.f; float zz_=0.f; asm volatile("":"+v"(zz_));
  f32x16 o[2]; f32x16 negm;
  #pragma unroll
  for(int r=0;r<16;++r){o[0][r]=zz_;o[1][r]=zz_;negm[r]=zz_;}
  asm volatile("":"+v"(negm));
  const int qrel=wid*QBLK+r32;
  #define CMASK(P0,P1,t) do{int jb_=(t)-(NT-4); if(jb_>=0)cmask(P0,P1,jb_,qrel,hi);}while(0)
  bool resc=false;
  #define START(P0,P1) do{ const float rm=rowmax(P0,P1); resc=false; \
    { const float dl=rm; mhat=fadd_s(mhat,dl); \
      _Pragma("unroll") for(int r=0;r<16;++r){P0[r]=fsub_s(P0[r],dl);P1[r]=fsub_s(P1[r],dl);} \
      _Pragma("unroll") for(int r=0;r<16;++r)negm[r]=-mhat; asm volatile("":"+v"(negm)); } \
    _Pragma("unroll") for(int r=0;r<16;++r)P0[r]=__builtin_amdgcn_exp2f(P0[r]); }while(0)
  #define RESC() do{ if(resc){ asm volatile("s_waitcnt lgkmcnt(0)":::"memory"); \
      _Pragma("unroll") for(int d_=0;d_<2;++d_) _Pragma("unroll") for(int r=0;r<16;++r)o[d_][r]*=wsf[crow(r,hi)]; } }while(0)
  f32x16 pA0,pA1,pB0,pB1;
  int sl_prev=0,sl_cur=0,sl_next=SLOTB;
  #define ROT() do{sl_prev=sl_cur;sl_cur=sl_next;sl_next=(sl_next==(NSLOT-1)*SLOTB)?0:sl_next+SLOTB;}while(0)
  DMA_K(2,2*SLOTB);
  WAIT_BAR(3);
  qkt(pA0,pA1,Kbase,qr,negm,r32,hi);asm volatile("s_nop 15\n\ts_nop 7":"+v"(pA0),"+v"(pA1));CMASK(pA0,pA1,0);
  START(pA0,pA1);
  _Pragma("unroll") for(int r=0;r<16;++r)pA1[r]=__builtin_amdgcn_exp2f(pA1[r]);
  WAIT_BAR(0);
  DMA_K(3,0);DMA_V(1,SLOTB);
  ROT();
  kload8(kf,kp0+sl_cur);
  WAIT_BAR(2);
  s16x4 vlo[8],vhi[8]; u32x4 pw0,pw1,pw2,pw3;
  #define PKW(P,B) cvtpk_s(P[B],P[B+1])
  #define PAF(k) __builtin_bit_cast(bf16x8,pw##k)
  #define VFR(i) (bf16x8){vlo[i][0],vlo[i][1],vlo[i][2],vlo[i][3],vhi[i][0],vhi[i][1],vhi[i][2],vhi[i][3]}
  #define PIN(x) asm volatile("":"+v"(x))
  #define MX3(a,b,c) __builtin_fmaxf(__builtin_fmaxf((a),(b)),(c))
  #define GAPA(MF,A0,A1,A2,A3,W0,W1,PW) do{ MF; sacc+=A0; sacc+=A1; sacc+=A2; sacc+=A3; PIN(sacc); W0; W1; PIN(PW); SBAR(); }while(0)
  #define EX(v) __builtin_amdgcn_exp2f(v)
  #define GAPB(MF,X,B) do{ MF; X[B]=EX(X[B]); X[B+1]=EX(X[B+1]); X[B+2]=EX(X[B+2]); X[B+3]=EX(X[B+3]); PIN(X); SBAR(); }while(0)
  #define VRD(i) do{ vlo[i]=vtr(vp_+(((i)>>2)*4096+((i)&3)*1024)); vhi[i]=vtr(vp_+(((i)>>2)*4096+((i)&3)*1024+512)); }while(0)
  #define KRD(G,j) do{ if(G){ kload2(kf,kp0+sl_next,j); SBAR(); } }while(0)
  #define STEP(C0,C1,P0,P1,t,GK,GV,GL) do{ SBAR(); \
    const lds_cptr vp_=vp0+sl_prev; \
    VRD(0); SBAR(); float sacc=(P0[0]+P0[1]); \
    GAPA(C0=__builtin_amdgcn_mfma_f32_32x32x16_bf16(kf[0],qr[0],negm,0,0,0), P0[2],P0[3],P0[4],P0[5],     pw0[0]=PKW(P0,0), pw0[1]=PKW(P0,2), pw0); \
    VRD(4); SBAR(); GAPA(C1=__builtin_amdgcn_mfma_f32_32x32x16_bf16(kf[1],qr[0],negm,0,0,0), P0[6],P0[7],P0[8],P0[9],     pw0[2]=PKW(P0,4), pw0[3]=PKW(P0,6), pw0); \
    VRD(1); SBAR(); GAPA(C0=__builtin_amdgcn_mfma_f32_32x32x16_bf16(kf[2],qr[1],C0,0,0,0),   P0[10],P0[11],P0[12],P0[13], pw1[0]=PKW(P0,8), pw1[1]=PKW(P0,10), pw1); \
    VRD(5); SBAR(); GAPA(C1=__builtin_amdgcn_mfma_f32_32x32x16_bf16(kf[3],qr[1],C1,0,0,0),   P0[14],P0[15],P1[0],P1[1],   pw1[2]=PKW(P0,12),pw1[3]=PKW(P0,14), pw1); \
    VRD(2); SBAR(); GAPA(C0=__builtin_amdgcn_mfma_f32_32x32x16_bf16(kf[4],qr[2],C0,0,0,0),   P1[2],P1[3],P1[4],P1[5],     pw2[0]=PKW(P1,0), pw2[1]=PKW(P1,2), pw2); \
    VRD(6); SBAR(); GAPA(C1=__builtin_amdgcn_mfma_f32_32x32x16_bf16(kf[5],qr[2],C1,0,0,0),   P1[6],P1[7],P1[8],P1[9],     pw2[2]=PKW(P1,4), pw2[3]=PKW(P1,6), pw2); \
    VRD(3); SBAR(); GAPA(C0=__builtin_amdgcn_mfma_f32_32x32x16_bf16(kf[6],qr[3],C0,0,0,0),   P1[10],P1[11],P1[12],P1[13], pw3[0]=PKW(P1,8), pw3[1]=PKW(P1,10), pw3); \
    VRD(7); SBAR(); GAPA(C1=__builtin_amdgcn_mfma_f32_32x32x16_bf16(kf[7],qr[3],C1,0,0,0),   P1[14],P1[15],0.f,0.f,       pw3[2]=PKW(P1,12),pw3[3]=PKW(P1,14), pw3); \
    l_reg+=sacc; \
    if(GK){DMA_K((t)+3,sl_cur);} if(GV){DMA_V((t)+1,sl_next);} \
    CMASK(C0,C1,t); \
    { float a=MX3(C0[0],C0[1],C1[0]),b=MX3(C0[2],C0[3],C1[1]); a=MX3(a,C1[2],C1[3]); \
      _Pragma("unroll") for(int r=4;r<16;r+=4){a=MX3(a,C0[r],C0[r+1]);b=MX3(b,C0[r+2],C0[r+3]);a=MX3(a,C1[r],C1[r+1]);b=MX3(b,C1[r+2],C1[r+3]);} \
      float rm=__builtin_fmaxf(a,b); { auto rr=__builtin_amdgcn_permlane32_swap(__float_as_uint(rm),__float_as_uint(rm),false,false); rm=__builtin_fmaxf(__uint_as_float(rr[0]),__uint_as_float(rr[1])); } \
      resc=false; \
      if(__builtin_expect(__any(rm>(float)THRL),0)){ const float dl=__builtin_fmaxf(rm,0.f); mhat+=dl; \
        _Pragma("unroll") for(int r=0;r<16;++r){C0[r]-=dl;C1[r]-=dl;} \
        _Pragma("unroll") for(int r=0;r<16;++r)negm[r]=-mhat; asm volatile("":"+v"(negm)); \
        const float f=__builtin_amdgcn_exp2f(-dl); l_reg*=f; if(hi==0)wsf[r32]=f; resc=true; } } \
    SBAR(); \
    GAPB(o[0]=__builtin_amdgcn_mfma_f32_32x32x16_bf16(PAF(0),VFR(0),o[0],0,0,0), C0,0); \
    GAPB(o[1]=__builtin_amdgcn_mfma_f32_32x32x16_bf16(PAF(0),VFR(4),o[1],0,0,0), C0,4); \
    KRD(GL,0); GAPB(o[0]=__builtin_amdgcn_mfma_f32_32x32x16_bf16(PAF(1),VFR(1),o[0],0,0,0), C0,8); \
    KRD(GL,1); GAPB(o[1]=__builtin_amdgcn_mfma_f32_32x32x16_bf16(PAF(1),VFR(5),o[1],0,0,0), C0,12); \
    KRD(GL,2); GAPB(o[0]=__builtin_amdgcn_mfma_f32_32x32x16_bf16(PAF(2),VFR(2),o[0],0,0,0), C1,0); \
    KRD(GL,3); GAPB(o[1]=__builtin_amdgcn_mfma_f32_32x32x16_bf16(PAF(2),VFR(6),o[1],0,0,0), C1,4); \
    GAPB(o[0]=__builtin_amdgcn_mfma_f32_32x32x16_bf16(PAF(3),VFR(3),o[0],0,0,0), C1,8); \
    GAPB(o[1]=__builtin_amdgcn_mfma_f32_32x32x16_bf16(PAF(3),VFR(7),o[1],0,0,0), C1,12); \
    }while(0)
  int t=1;
  #undef CMASK
  #define CMASK(P0,P1,t) do{}while(0)
  for(;t+5<NT;t+=2){
    STEP(pB0,pB1,pA0,pA1,t,true,true,true);     WAIT_BAR(2); RESC(); ROT();
    STEP(pA0,pA1,pB0,pB1,t+1,true,true,true);   WAIT_BAR(2); RESC(); ROT();
  }
  #undef CMASK
  #define CMASK(P0,P1,t) do{int jb_=(t)-(NT-4); if(jb_>=0)cmask(P0,P1,jb_,qrel,hi);}while(0)
  #define ENDW(tt) do{ if((tt)+3<NT){WAIT_BAR(2);} else if((tt)+2<NT){WAIT_BAR(1);} else {WAIT_BAR(0);} }while(0)
  for(;t+1<NT;t+=2){
    STEP(pB0,pB1,pA0,pA1,t,(t+3<NT),(t+1<NT),(t+1<NT));       ENDW(t);   RESC(); ROT();
    STEP(pA0,pA1,pB0,pB1,t+1,(t+4<NT),(t+2<NT),(t+2<NT));     ENDW(t+1); RESC(); ROT();
  }
  STEP(pB0,pB1,pA0,pA1,NT-1,false,false,false); RESC();
  { float sacc=pB0[0]+pB0[1]; _Pragma("unroll") for(int r=2;r<16;++r)sacc+=pB0[r]; _Pragma("unroll") for(int r=0;r<16;++r)sacc+=pB1[r]; l_reg+=sacc;
    pw0=(u32x4){PKW(pB0,0),PKW(pB0,2),PKW(pB0,4),PKW(pB0,6)};pw1=(u32x4){PKW(pB0,8),PKW(pB0,10),PKW(pB0,12),PKW(pB0,14)};pw2=(u32x4){PKW(pB1,0),PKW(pB1,2),PKW(pB1,4),PKW(pB1,6)};pw3=(u32x4){PKW(pB1,8),PKW(pB1,10),PKW(pB1,12),PKW(pB1,14)};
    SBAR(); pv(o,vb0+sl_cur,PAF(0),PAF(1),PAF(2),PAF(3)); }
  #undef PKW
  #undef PAF
  #undef VFR
  #undef PIN
  #undef MX3
  #undef GAPA
  #undef GAPB
  #undef EX
  #undef VRD
  #undef KRD
  #undef STEP
  #undef ENDW
  {auto rr=__builtin_amdgcn_permlane32_swap(__float_as_uint(l_reg),__float_as_uint(l_reg),false,false);l_reg=__uint_as_float(rr[0])+__uint_as_float(rr[1]);}
  if(hi==0)wsf[32+r32]=l_reg;asm volatile("s_waitcnt lgkmcnt(0)":::"memory");
  float rli[16];
  #pragma unroll
  for(int r=0;r<16;++r)rli[r]=__builtin_amdgcn_rcpf(wsf[32+crow(r,hi)]);
  bf16*Ow=Oh+(long)(q0+wid*QBLK)*DM;
  { bf16*stg=(bf16*)(shm+LDS_OST)+wid*2048;
    #pragma unroll
    for(int r=0;r<16;++r){const int orow=crow(r,hi);
      #pragma unroll
      for(int d0=0;d0<2;++d0)stg[orow*64+d0*32+r32]=__float2bfloat16(o[d0][r]*rli[r]);}
    asm volatile("s_waitcnt lgkmcnt(0)":::"memory");
    #pragma unroll
    for(int i=0;i<4;++i){const int row=i*8+(lane>>3),ch=lane&7; const u32x4 v=*(const u32x4*)(stg+row*64+ch*8); ATTN_STORE16(Ow+(long)row*DM+ch*8,v);} }
  asm volatile("s_waitcnt lgkmcnt(0)\n\ts_barrier":::"memory");
  #undef DMA_K
  #undef DMA_V
  #undef CMASK
  #undef START
  #undef RESC
  #undef ROT
}
constexpr int ATTN_LDS_BYTES=LDS_BYTES;
constexpr int W_K=0, W_V=3*SLOTB, W_WS=W_V+3*2*SLOTB, W_OST=0, W_LDS_BYTES=W_WS+NW*64*4;
__device__ __forceinline__ void pv4(f32x16*o,int vb,bf16x8 pa0,bf16x8 pa1,bf16x8 pa2,bf16x8 pa3){
  #pragma unroll
  for(int d0=0;d0<4;++d0){s16x4 lo[4],hi[4];
    #pragma unroll
    for(int ks=0;ks<4;++ks){
      asm volatile("ds_read_b64_tr_b16 %0,%1 offset:%c2":"=&v"(lo[ks]):"v"(vb),"i"(d0*4096+ks*1024):"memory");
      asm volatile("ds_read_b64_tr_b16 %0,%1 offset:%c2":"=&v"(hi[ks]):"v"(vb),"i"(d0*4096+ks*1024+512):"memory");}
    asm volatile("s_waitcnt lgkmcnt(0)":::"memory");SBAR();
    #define PK(k) (bf16x8){lo[k][0],lo[k][1],lo[k][2],lo[k][3],hi[k][0],hi[k][1],hi[k][2],hi[k][3]}
    o[d0]=__builtin_amdgcn_mfma_f32_32x32x16_bf16(pa0,PK(0),o[d0],0,0,0);
    o[d0]=__builtin_amdgcn_mfma_f32_32x32x16_bf16(pa1,PK(1),o[d0],0,0,0);
    o[d0]=__builtin_amdgcn_mfma_f32_32x32x16_bf16(pa2,PK(2),o[d0],0,0,0);
    o[d0]=__builtin_amdgcn_mfma_f32_32x32x16_bf16(pa3,PK(3),o[d0],0,0,0);
    #undef PK
  }
}
template<int THRL> __device__ __forceinline__ void attn_unit128(int qb,const bf16*Qh,const bf16*__restrict__ Kh,const bf16*__restrict__ Vh,bf16*Oh,char*shm,const int wid){
  const int lane=opaque_lane(),tid=wid*64+lane,r32=lane&31,hi=lane>>5;
  const int q0=qb*QB;
  const bf16*Qw=Qh+(long)(q0+wid*QBLK)*DM;
  const unsigned lds0=(unsigned)(uintptr_t)shm;
  float*wsf=(float*)(shm+W_WS)+wid*64;
  const bf16*ksrc=Kh+(long)lane*DM+wid*8;
  const bf16*vsrc=Vh+(long)(16*(wid&3)+(lane>>2))*DM+(wid>>2)*32+(lane&3)*8;
  const unsigned kdst=lds0+W_K+wid*1024, vdst=lds0+W_V+wid*1024;
  #define DMA_K(t,slot) glds16(ksrc+(long)(t)*KVBLK*DM,(unsigned)__builtin_amdgcn_readfirstlane(kdst+(slot)))
  #define DMA_V(t,slot) do{ glds16(vsrc+(long)(t)*KVBLK*DM,(unsigned)__builtin_amdgcn_readfirstlane(vdst+2*(slot))); glds16(vsrc+64+(long)(t)*KVBLK*DM,(unsigned)__builtin_amdgcn_readfirstlane(vdst+8192+2*(slot))); }while(0)
  const int vb0=(int)(lds0+W_V)+((lane>>4)&1)*32+(lane&3)*8+(4*hi+((lane&15)>>2))*64;
  const char*Kbase=shm+W_K; bf16x8 kf[8];
  const lds_cptr shm3=(lds_cptr)shm; const lds_cptr kp0=shm3+W_K+hi*1024+r32*16; const lds_cptr vp0=shm3+W_V+((lane>>4)&1)*32+(lane&3)*8+(4*hi+((lane&15)>>2))*64;
  const int NT=(q0+QB)/KVBLK;
  DMA_K(0,0);DMA_V(0,0);DMA_K(1,SLOTB);
  bf16x8 qr[4];
  #pragma unroll
  for(int d0=0;d0<4;++d0)qr[d0]=*reinterpret_cast<const bf16x8*>(&Qw[(long)r32*DM+d0*16+hi*8]);
  float mhat=0.f,l_reg=0.f; float zz_=0.f; asm volatile("":"+v"(zz_));
  f32x16 o[4]; const f32x16 zero16=f32x16{};
  #pragma unroll
  for(int r=0;r<16;++r){o[0][r]=zz_;o[1][r]=zz_;o[2][r]=zz_;o[3][r]=zz_;}
  const int qrel=wid*QBLK+r32;
  #define CMASK(P0,P1,t) do{int jb_=(t)-(NT-4); if(jb_>=0)cmask(P0,P1,jb_,qrel,hi);}while(0)
  bool resc=false;
  #define START(P0,P1) do{ const float rm=rowmax(P0,P1); resc=false; \
    { const float dl=rm; mhat=fadd_s(mhat,dl); \
      _Pragma("unroll") for(int r=0;r<16;++r){P0[r]=fsub_s(P0[r],dl);P1[r]=fsub_s(P1[r],dl);} \
      } \
    _Pragma("unroll") for(int r=0;r<16;++r)P0[r]=__builtin_amdgcn_exp2f(P0[r]); }while(0)
  #define RESC() do{ if(resc){ asm volatile("s_waitcnt lgkmcnt(0)":::"memory"); \
      _Pragma("unroll") for(int d_=0;d_<4;++d_) _Pragma("unroll") for(int r=0;r<16;++r)o[d_][r]*=wsf[crow(r,hi)]; } }while(0)
  int sl_prev=0,sl_cur=0,sl_next=SLOTB;
  #define ROT() do{sl_prev=sl_cur;sl_cur=sl_next;sl_next=(sl_next==(NSLOT-1)*SLOTB)?0:sl_next+SLOTB;}while(0)
  DMA_K(2,2*SLOTB);
  WAIT_BAR(4);
  f32x16 C0,C1; u32x4 pw0,pw1,pw2,pw3;
  #define PKW(P,B) cvtpk_s(P[B],P[B+1])
  qkt(C0,C1,Kbase,qr,zero16,r32,hi);asm volatile("s_nop 15\n\ts_nop 7":"+v"(C0),"+v"(C1));CMASK(C0,C1,0);
  START(C0,C1);
  _Pragma("unroll") for(int r=0;r<16;++r)C1[r]=__builtin_amdgcn_exp2f(C1[r]);
  { float sacc=C0[0]+C0[1]; _Pragma("unroll") for(int r=2;r<16;++r)sacc+=C0[r]; _Pragma("unroll") for(int r=0;r<16;++r)sacc+=C1[r]; l_reg+=sacc;
    pw0=(u32x4){PKW(C0,0),PKW(C0,2),PKW(C0,4),PKW(C0,6)};pw1=(u32x4){PKW(C0,8),PKW(C0,10),PKW(C0,12),PKW(C0,14)};pw2=(u32x4){PKW(C1,0),PKW(C1,2),PKW(C1,4),PKW(C1,6)};pw3=(u32x4){PKW(C1,8),PKW(C1,10),PKW(C1,12),PKW(C1,14)}; }
  WAIT_BAR(0);
  DMA_K(3,0);DMA_V(1,SLOTB);
  ROT();
  kload8(kf,kp0+sl_cur);
  WAIT_BAR(3);
  s16x4 vlo[16],vhi[16];
  #define PAF(k) __builtin_bit_cast(bf16x8,pw##k)
  #define VFR(i) (bf16x8){vlo[i][0],vlo[i][1],vlo[i][2],vlo[i][3],vhi[i][0],vhi[i][1],vhi[i][2],vhi[i][3]}
  #define PIN(x) asm volatile("":"+v"(x))
  #define MX3(a,b,c) __builtin_fmaxf(__builtin_fmaxf((a),(b)),(c))
  #define EX(v) __builtin_amdgcn_exp2f(v)
  #define GAPB(MF,X,B,PN,I) do{ MF; X[B]=EX(X[B]); X[B+1]=EX(X[B+1]); sacc+=X[B]; sacc+=X[B+1]; PN[I]=PKW(X,B); PIN(sacc); PIN(PN); SBAR(); }while(0)
  #define VRD(i) do{ vlo[i]=vtr(vp_+(((i)>>2)*4096+((i)&3)*1024)); vhi[i]=vtr(vp_+(((i)>>2)*4096+((i)&3)*1024+512)); }while(0)
  #define KRD(G,j) do{ if(G){ kload2(kf,kp0+sl_next,j); SBAR(); } }while(0)
  #define QK(C,kk,qq,CI) do{ C=__builtin_amdgcn_mfma_f32_32x32x16_bf16(kf[kk],qr[qq],CI,0,0,0); SBAR(); }while(0)
  #define STEP(t,GK,GV,GL) do{ SBAR(); \
    const lds_cptr vp_=vp0+2*sl_prev; \
    VRD(0); SBAR(); QK(C0,0,0,zero16); QK(C1,1,0,zero16); \
    VRD(4); SBAR(); QK(C0,2,1,C0); QK(C1,3,1,C1); \
    VRD(8); SBAR(); QK(C0,4,2,C0); QK(C1,5,2,C1); \
    VRD(12); SBAR(); QK(C0,6,3,C0); QK(C1,7,3,C1); \
    if(GK){DMA_K((t)+3,sl_cur);} if(GV){DMA_V((t)+1,sl_next);} \
    _Pragma("unroll") for(int r=0;r<16;++r){C0[r]-=mhat;C1[r]-=mhat;} \
    CMASK(C0,C1,t); \
    { float a=MX3(C0[0],C0[1],C1[0]),b=MX3(C0[2],C0[3],C1[1]); a=MX3(a,C1[2],C1[3]); \
      _Pragma("unroll") for(int r=4;r<16;r+=4){a=MX3(a,C0[r],C0[r+1]);b=MX3(b,C0[r+2],C0[r+3]);a=MX3(a,C1[r],C1[r+1]);b=MX3(b,C1[r+2],C1[r+3]);} \
      float rm=__builtin_fmaxf(a,b); { auto rr=__builtin_amdgcn_permlane32_swap(__float_as_uint(rm),__float_as_uint(rm),false,false); rm=__builtin_fmaxf(__uint_as_float(rr[0]),__uint_as_float(rr[1])); } \
      resc=false; \
      if(__builtin_expect(__any(rm>(float)THRL),0)){ const float dl=__builtin_fmaxf(rm,0.f); mhat+=dl; \
        _Pragma("unroll") for(int r=0;r<16;++r){C0[r]-=dl;C1[r]-=dl;} \
        const float f=__builtin_amdgcn_exp2f(-dl); l_reg*=f; if(hi==0)wsf[r32]=f; resc=true; } } \
    SBAR(); float sacc=0.f; \
    VRD(1); SBAR(); o[0]=__builtin_amdgcn_mfma_f32_32x32x16_bf16(PAF(0),VFR(0),o[0],0,0,0); SBAR(); \
    VRD(5); SBAR(); o[1]=__builtin_amdgcn_mfma_f32_32x32x16_bf16(PAF(0),VFR(4),o[1],0,0,0); SBAR(); \
    VRD(9); SBAR(); o[2]=__builtin_amdgcn_mfma_f32_32x32x16_bf16(PAF(0),VFR(8),o[2],0,0,0); SBAR(); \
    VRD(13); SBAR(); o[3]=__builtin_amdgcn_mfma_f32_32x32x16_bf16(PAF(0),VFR(12),o[3],0,0,0); SBAR(); \
    VRD(2); SBAR(); GAPB(o[0]=__builtin_amdgcn_mfma_f32_32x32x16_bf16(PAF(1),VFR(1),o[0],0,0,0), C0,0,pw0,0); \
    VRD(6); SBAR(); GAPB(o[1]=__builtin_amdgcn_mfma_f32_32x32x16_bf16(PAF(1),VFR(5),o[1],0,0,0), C0,2,pw0,1); \
    VRD(10); SBAR(); GAPB(o[2]=__builtin_amdgcn_mfma_f32_32x32x16_bf16(PAF(1),VFR(9),o[2],0,0,0), C0,4,pw0,2); \
    VRD(14); SBAR(); GAPB(o[3]=__builtin_amdgcn_mfma_f32_32x32x16_bf16(PAF(1),VFR(13),o[3],0,0,0), C0,6,pw0,3); \
    VRD(3); SBAR(); KRD(GL,0); GAPB(o[0]=__builtin_amdgcn_mfma_f32_32x32x16_bf16(PAF(2),VFR(2),o[0],0,0,0), C0,8,pw1,0); \
    VRD(7); SBAR(); KRD(GL,1); GAPB(o[1]=__builtin_amdgcn_mfma_f32_32x32x16_bf16(PAF(2),VFR(6),o[1],0,0,0), C0,10,pw1,1); \
    VRD(11); SBAR(); KRD(GL,2); GAPB(o[2]=__builtin_amdgcn_mfma_f32_32x32x16_bf16(PAF(2),VFR(10),o[2],0,0,0), C0,12,pw1,2); \
    VRD(15); SBAR(); KRD(GL,3); GAPB(o[3]=__builtin_amdgcn_mfma_f32_32x32x16_bf16(PAF(2),VFR(14),o[3],0,0,0), C0,14,pw1,3); \
    GAPB(o[0]=__builtin_amdgcn_mfma_f32_32x32x16_bf16(PAF(3),VFR(3),o[0],0,0,0), C1,0,pw2,0); \
    GAPB(o[1]=__builtin_amdgcn_mfma_f32_32x32x16_bf16(PAF(3),VFR(7),o[1],0,0,0), C1,2,pw2,1); \
    GAPB(o[2]=__builtin_amdgcn_mfma_f32_32x32x16_bf16(PAF(3),VFR(11),o[2],0,0,0), C1,4,pw2,2); \
    GAPB(o[3]=__builtin_amdgcn_mfma_f32_32x32x16_bf16(PAF(3),VFR(15),o[3],0,0,0), C1,6,pw2,3); \
    GAPB((void)0, C1,8,pw3,0); \
    GAPB((void)0, C1,10,pw3,1); \
    GAPB((void)0, C1,12,pw3,2); \
    GAPB((void)0, C1,14,pw3,3); \
    l_reg+=sacc; \
    }while(0)
  int t=1;
  #undef CMASK
  #define CMASK(P0,P1,t) do{}while(0)
  for(;t+4<NT;++t){ STEP(t,true,true,true); WAIT_BAR(3); RESC(); ROT(); }
  #undef CMASK
  #define CMASK(P0,P1,t) do{int jb_=(t)-(NT-4); if(jb_>=0)cmask(P0,P1,jb_,qrel,hi);}while(0)
  #define ENDW(tt) do{ if((tt)+3<NT){WAIT_BAR(3);} else if((tt)+2<NT){WAIT_BAR(2);} else {WAIT_BAR(0);} }while(0)
  for(;t+1<NT;++t){ STEP(t,(t+3<NT),(t+1<NT),(t+1<NT)); ENDW(t); RESC(); ROT(); }
  STEP(NT-1,false,false,false); RESC();
  SBAR(); pv4(o,vb0+2*sl_cur,PAF(0),PAF(1),PAF(2),PAF(3));
  #undef PKW
  #undef PAF
  #undef VFR
  #undef PIN
  #undef MX3
  #undef GAPB
  #undef EX
  #undef VRD
  #undef KRD
  #undef QK
  #undef STEP
  #undef ENDW
  {auto rr=__builtin_amdgcn_permlane32_swap(__float_as_uint(l_reg),__float_as_uint(l_reg),false,false);l_reg=__uint_as_float(rr[0])+__uint_as_float(rr[1]);}
  if(hi==0)wsf[32+r32]=l_reg;asm volatile("s_waitcnt lgkmcnt(0)":::"memory");
  float rli[16];
  #pragma unroll
  for(int r=0;r<16;++r)rli[r]=__builtin_amdgcn_rcpf(wsf[32+crow(r,hi)]);
  bf16*Ow=Oh+(long)(q0+wid*QBLK)*DM;
  asm volatile("s_waitcnt lgkmcnt(0)\n\ts_barrier":::"memory");
  { bf16*stg=(bf16*)(shm+W_OST)+wid*4096;
    #pragma unroll
    for(int r=0;r<16;++r){const int orow=crow(r,hi);
      #pragma unroll
      for(int d0=0;d0<4;++d0)stg[orow*128+d0*32+r32]=__float2bfloat16(o[d0][r]*rli[r]);}
    asm volatile("s_waitcnt lgkmcnt(0)":::"memory");
    #pragma unroll
    for(int i=0;i<8;++i){const int row=i*4+(lane>>4),ch=lane&15; const u32x4 v=*(const u32x4*)(stg+row*128+ch*8); ATTN_STORE16(Ow+(long)row*DM+ch*8,v);} }
  asm volatile("s_waitcnt lgkmcnt(0)\n\ts_barrier":::"memory");
  #undef DMA_K
  #undef DMA_V
  #undef CMASK
  #undef START
  #undef RESC
  #undef ROT
}
constexpr int DSW_K=0, DSW_V=6*SLOTB, DSW_WS=12*SLOTB, DSW_OST=DSW_WS+NW*64*4, DSW_LDS_BYTES=DSW_OST+NW*4096;
__device__ __forceinline__ void dsw_unit(int dil,int r,int blk,const bf16*Qh,const bf16*__restrict__ Kh,const bf16*__restrict__ Vh,bf16*Oh,float*lse,char*shm,const int wid){
  const int lane=opaque_lane(),r32=lane&31,hi=lane>>5;
  const int L=256*blk;
  const unsigned lds0=(unsigned)(uintptr_t)shm;
  float*wsf=(float*)(shm+DSW_WS)+wid*64;
  #pragma unroll
  for(int tau=0;tau<6;++tau){
    int lk=L-128+64*tau+lane; lk=lk<0?0:lk;
    glds16(Kh+((long)lk*dil+r)*DM+wid*8,(unsigned)__builtin_amdgcn_readfirstlane(lds0+DSW_K+tau*SLOTB+wid*1024));
    int lv=L-128+64*tau+16*(wid&3)+(lane>>2); lv=lv<0?0:lv;
    glds16(Vh+((long)lv*dil+r)*DM+(wid>>2)*32+(lane&3)*8,(unsigned)__builtin_amdgcn_readfirstlane(lds0+DSW_V+tau*SLOTB+wid*1024));
  }
  const long tq=(long)(L+wid*QBLK+r32)*dil+r;
  bf16x8 qr[4];
  #pragma unroll
  for(int d0=0;d0<4;++d0)qr[d0]=*reinterpret_cast<const bf16x8*>(&Qh[tq*DM+d0*16+hi*8]);
  WAIT_BAR(0);
  const int tau0=wid>>1;
  const f32x16 zero=f32x16{};
  f32x16 s00,s01,s10,s11,s20,s21;
  qkt(s00,s01,shm+DSW_K+(tau0+0)*SLOTB,qr,zero,r32,hi);
  qkt(s10,s11,shm+DSW_K+(tau0+1)*SLOTB,qr,zero,r32,hi);
  qkt(s20,s21,shm+DSW_K+(tau0+2)*SLOTB,qr,zero,r32,hi);
  const int lq=wid*QBLK+r32;
  #define DSW_MASK(P0,P1,jj) do{ const int kb_=-128+64*(tau0+(jj))+4*hi; _Pragma("unroll") for(int rr=0;rr<16;++rr){ const int lk_=kb_+(rr&3)+8*(rr>>2); \
      const bool ok0=(L+lk_>=0)&&(lk_<=lq)&&(lq-lk_<=128); const bool ok1=(L+lk_+32>=0)&&(lk_+32<=lq)&&(lq-lk_-32<=128); \
      P0[rr]=ok0?P0[rr]:-INFINITY; P1[rr]=ok1?P1[rr]:-INFINITY; } }while(0)
  DSW_MASK(s00,s01,0); DSW_MASK(s10,s11,1); DSW_MASK(s20,s21,2);
  #undef DSW_MASK
  float mx=-INFINITY;
  #pragma unroll
  for(int rr=0;rr<16;++rr){ mx=__builtin_fmaxf(mx,__builtin_fmaxf(__builtin_fmaxf(s00[rr],s01[rr]),__builtin_fmaxf(__builtin_fmaxf(s10[rr],s11[rr]),__builtin_fmaxf(s20[rr],s21[rr])))); }
  { auto pr=__builtin_amdgcn_permlane32_swap(__float_as_uint(mx),__float_as_uint(mx),false,false); mx=__builtin_fmaxf(__uint_as_float(pr[0]),__uint_as_float(pr[1])); }
  float l=0.f;
  #define DSW_EXP(P) do{ _Pragma("unroll") for(int rr=0;rr<16;++rr){ P[rr]=__builtin_amdgcn_exp2f(P[rr]-mx); l+=P[rr]; } }while(0)
  DSW_EXP(s00); DSW_EXP(s01); DSW_EXP(s10); DSW_EXP(s11); DSW_EXP(s20); DSW_EXP(s21);
  #undef DSW_EXP
  { auto pr=__builtin_amdgcn_permlane32_swap(__float_as_uint(l),__float_as_uint(l),false,false); l=__uint_as_float(pr[0])+__uint_as_float(pr[1]); }
  f32x16 o[2]; o[0]=f32x16{}; o[1]=f32x16{};
  const int vb0=(int)(lds0+DSW_V)+((lane>>4)&1)*32+(lane&3)*8+(4*hi+((lane&15)>>2))*64;
  #define DSW_PV(P0,P1,jj) do{ u32x4 w0,w1,w2,w3; \
      w0=(u32x4){cvtpk_s(P0[0],P0[1]),cvtpk_s(P0[2],P0[3]),cvtpk_s(P0[4],P0[5]),cvtpk_s(P0[6],P0[7])}; w1=(u32x4){cvtpk_s(P0[8],P0[9]),cvtpk_s(P0[10],P0[11]),cvtpk_s(P0[12],P0[13]),cvtpk_s(P0[14],P0[15])}; \
      w2=(u32x4){cvtpk_s(P1[0],P1[1]),cvtpk_s(P1[2],P1[3]),cvtpk_s(P1[4],P1[5]),cvtpk_s(P1[6],P1[7])}; w3=(u32x4){cvtpk_s(P1[8],P1[9]),cvtpk_s(P1[10],P1[11]),cvtpk_s(P1[12],P1[13]),cvtpk_s(P1[14],P1[15])}; \
      SBAR(); pv(o,vb0+(tau0+(jj))*SLOTB,__builtin_bit_cast(bf16x8,w0),__builtin_bit_cast(bf16x8,w1),__builtin_bit_cast(bf16x8,w2),__builtin_bit_cast(bf16x8,w3)); }while(0)
  DSW_PV(s00,s01,0); DSW_PV(s10,s11,1); DSW_PV(s20,s21,2);
  #undef DSW_PV
  if(hi==0){ wsf[32+r32]=l; lse[tq*8]=mx+__builtin_log2f(l); }
  asm volatile("s_waitcnt lgkmcnt(0)":::"memory");
  float rli[16];
  #pragma unroll
  for(int rr=0;rr<16;++rr)rli[rr]=__builtin_amdgcn_rcpf(wsf[32+crow(rr,hi)]);
  { bf16*stg=(bf16*)(shm+DSW_OST)+wid*2048;
    #pragma unroll
    for(int rr=0;rr<16;++rr){const int orow=crow(rr,hi);
      #pragma unroll
      for(int d0=0;d0<2;++d0)stg[orow*64+d0*32+r32]=__float2bfloat16(o[d0][rr]*rli[rr]);}
    asm volatile("s_waitcnt lgkmcnt(0)":::"memory");
    #pragma unroll
    for(int i=0;i<4;++i){const int row=i*8+(lane>>3),ch=lane&7; const u32x4 v=*(const u32x4*)(stg+row*64+ch*8);
      *(u32x4*)(Oh+((long)(L+wid*QBLK+row)*dil+r)*DM+ch*8)=v;} }
  asm volatile("s_waitcnt lgkmcnt(0)\n\ts_barrier":::"memory");
}
#ifndef NREP_DIFF
#define NREP_DIFF 1
#endif
#ifndef NREP_DSW
#define NREP_DSW 1
#endif
#ifndef ATT_VSPLIT
#define ATT_VSPLIT 0
#endif
struct AttnArgs { const bf16*QD; const bf16*KD; const bf16*VD; bf16*DO0; bf16*DO1; const bf16*QA; const bf16*KA; const bf16*VA; bf16*OP; float*LSE; };
template<int THRL=8> __device__ __forceinline__ void attn_phase_all(char*lds,const AttnArgs&A,int vcu,const int wid){
#ifndef NO_DIFF
#if ATT_VSPLIT
  { const int vh=vcu>>4,s=vcu&15,h=vh>>2,c=(vh>>1)&1,half=vh&1;
    const bf16*Qh=A.QD+(2*h+c)*64; const bf16*Kh=A.KD+(2*h+c)*64; const bf16*Vh=A.VD+h*128+half*64; bf16*Oh=(c?A.DO1:A.DO0)+h*128+half*64;
    for(int rep_=0;rep_<NREP_DIFF;++rep_) for(int i=0;i<4;++i){ const int qb=(i==0)?63-s:(i==1)?32+s:(i==2)?31-s:s; attn_unit<THRL>(qb,Qh,Kh,Vh,Oh,lds,wid); } }
#else
  { const int hc=vcu>>5,s=vcu&31,h=hc>>1,c=hc&1;
    const bf16*Qh=A.QD+hc*64; const bf16*Kh=A.KD+hc*64; const bf16*Vh=A.VD+h*128; bf16*Oh=(c?A.DO1:A.DO0)+h*128;
    for(int rep_=0;rep_<NREP_DIFF;++rep_) for(int i=0;i<2;++i){ const int qb=(i==0)?63-s:s; attn_unit128<THRL>(qb,Qh,Kh,Vh,Oh,lds,wid); } }
#endif
#endif
#ifndef NO_DSW
  for(int rep_=0;rep_<NREP_DSW;++rep_) for(int i=0;i<6;++i){ const int u=vcu+256*i; const int p=u>>9,h=(u>>6)&7,idx=u&63; const int dil=(p==0)?1:(p==1)?4:16; const int nblk=64/dil; const int r=idx/nblk,blk=idx-r*nblk;
    dsw_unit(dil,r,blk,A.QA+h*64,A.KA+h*64,A.VA+h*64,A.OP+(size_t)p*SEQ*DM+h*64,A.LSE+(size_t)p*SEQ*8+h,lds,wid); }
#endif
}
#undef SBAR
#undef WAIT_BAR
}
#define GAS __attribute__((address_space(1)))
#define LAS __attribute__((address_space(3)))
typedef unsigned short bf16;
typedef unsigned v4u __attribute__((ext_vector_type(4)));
typedef float f32x4 __attribute__((ext_vector_type(4)));
typedef short bf16x8 __attribute__((ext_vector_type(8)));
typedef GAS unsigned gu32;
typedef GAS unsigned long long gu64;
#define RLX_AGENT __ATOMIC_RELAXED, __HIP_MEMORY_SCOPE_AGENT
#define LDS_WAIT() asm volatile("s_waitcnt lgkmcnt(0)" ::: "memory")
#define VM_WAIT() asm volatile("s_waitcnt vmcnt(0)" ::: "memory")
__device__ __forceinline__ unsigned long long rt() { return __builtin_amdgcn_s_memrealtime(); }
__device__ __forceinline__ unsigned f2bf(float f) { unsigned u = __builtin_bit_cast(unsigned, f); return (u + 0x7fffu + ((u >> 16) & 1u)) >> 16; }
__device__ __forceinline__ unsigned pk2(float lo, float hi) { return f2bf(lo) | (f2bf(hi) << 16); }

#define XB_TMO      128
#define XB_XCNT(j)  (256  + 64 * (j))
#define XB_XSUB(j)  (1280 + 64 * (j))
#define XB_XGEN(j)  (2304 + 64 * (j))
#define XB_TOP      3328
#define XB_TOPGEN   3392
#define XCD_BAR_WORDS 3456
#define XB_SPIN_CAP (1u << 18)

__device__ __forceinline__ unsigned xb_ld(unsigned* p)              { return __hip_atomic_load(p, __ATOMIC_RELAXED, __HIP_MEMORY_SCOPE_AGENT); }
__device__ __forceinline__ unsigned xb_add(unsigned* p, unsigned v) { return __hip_atomic_fetch_add(p, v, __ATOMIC_RELAXED, __HIP_MEMORY_SCOPE_AGENT); }
__device__ __forceinline__ unsigned xb_xcc_id() { return (unsigned)__builtin_amdgcn_s_getreg((3 << 11) | 20) & 0xFu; }
#define XB_SPIN(cond, bar) do { unsigned _sp = 0; while (cond) { __builtin_amdgcn_s_sleep(1); \
    if ((++_sp & 255u) == 0u) { if (xb_ld(&(bar)[XB_TMO])) break; if (_sp > XB_SPIN_CAP) { atomicAdd(&(bar)[XB_TMO], 1u); break; } } } } while (0)

struct XcdBarrier {
    unsigned* bar; unsigned x; int wave;
    volatile LAS unsigned* st;
};

__device__ __forceinline__ XcdBarrier xcd_barrier_post(unsigned* bar, volatile LAS unsigned* st) {
    XcdBarrier b; b.bar = bar; b.x = xb_xcc_id(); b.st = st;
    if (threadIdx.x == 0) (void)xb_add(&bar[XB_XCNT(b.x)], 1u);
    return b;
}
__device__ __forceinline__ void xcd_barrier_complete(unsigned* bar, unsigned x, unsigned& nloc, unsigned& nx) {
    const unsigned G = gridDim.x * gridDim.y * gridDim.z;
    unsigned sum, cnt, mine, sp = 0u;
    for (;;) {
        sum = 0u; cnt = 0u; mine = 0u;
#pragma unroll
        for (unsigned j = 0; j < 16; ++j) { const unsigned c = xb_ld(&bar[XB_XCNT(j)]); sum += c; cnt += (c > 0u) ? 1u : 0u; mine = (j == x) ? c : mine; }
        if (sum == G) break;
        __builtin_amdgcn_s_sleep(1);
        if ((++sp & 255u) == 0u) { if (xb_ld(&bar[XB_TMO])) break; if (sp > XB_SPIN_CAP) { atomicAdd(&bar[XB_TMO], 1u); break; } }
    }
    nloc = mine > 0u ? mine : 1u; nx = cnt > 0u ? cnt : 1u;
}

__device__ __forceinline__ void xcd_barrier(const XcdBarrier& b) {
    asm volatile("s_waitcnt vmcnt(0)" ::: "memory");
    __syncthreads();
    if (b.wave == 0 && opaque_lane() == 0) {
        unsigned* bar = b.bar;
        __builtin_amdgcn_s_waitcnt(0);
        unsigned nloc = b.st[0], nx = b.st[1];
        if (nloc == 0u) { xcd_barrier_complete(bar, b.x, nloc, nx); b.st[0] = nloc; b.st[1] = nx; }
        const unsigned old = xb_add(&bar[XB_XSUB(b.x)], 1u);
        const unsigned gen = old / nloc;
        if (old + 1u == (gen + 1u) * nloc) {
            __builtin_amdgcn_fence(__ATOMIC_RELEASE, "agent");
            asm volatile("s_waitcnt vmcnt(0)" ::: "memory");
            const unsigned og = xb_add(&bar[XB_TOP], 1u);
            const unsigned tg = og / nx;
            if (og + 1u == (tg + 1u) * nx) xb_add(&bar[XB_TOPGEN], 1u);
            else XB_SPIN(xb_ld(&bar[XB_TOPGEN]) == tg, bar);
            __builtin_amdgcn_fence(__ATOMIC_ACQUIRE, "agent");
            xb_add(&bar[XB_XGEN(b.x)], 1u);
            asm volatile("s_waitcnt vmcnt(0)" ::: "memory");
        } else {
            XB_SPIN(xb_ld(&bar[XB_XGEN(b.x)]) == gen, bar);
            __builtin_amdgcn_fence(__ATOMIC_ACQUIRE, "agent");
            asm volatile("s_waitcnt vmcnt(0)" ::: "memory");
        }
    }
    __syncthreads();
}
constexpr int NWAVES = 8;
constexpr int RING_OFF = 0, RING_BYTES = 135168;
constexpr int LDSCTL_OFF = RING_BYTES, MISC_OFF = LDSCTL_OFF + 320;
constexpr int LDS_BYTES = 147456;
static_assert(MISC_OFF + 128 <= LDS_BYTES && attn_body::DSW_LDS_BYTES <= RING_BYTES && attn_body::ATTN_LDS_BYTES <= RING_BYTES, "LDS map");
constexpr int CW_TMO = 0, CW_CODE = 1;
constexpr int CW_BAR = 4096;
constexpr int N_PHASES = 9;
static_assert((CW_BAR + N_PHASES * XCD_BAR_WORDS) * 4 <= (int)CTL_ZERO_BYTES, "CTL words inside the memset region");

struct Frame {
    LAS unsigned char* lds; volatile LAS unsigned* MISC; gu32* ctl;
    int tid, lane, wave, vcu, G;
};

__device__ __forceinline__ void p0_transpose_item(const float* W, int K, int N, bf16* WT, int n0p, int n0l, int k0, LAS float* scr, int lane) {
#pragma unroll 8
    for (int i = 0; i < 32; ++i) { const int kk = 2 * i + (lane >> 5); scr[kk * 33 + (lane & 31)] = W[(size_t)(k0 + kk) * N + n0l + (lane & 31)]; }
    LDS_WAIT(); asm volatile("" ::: "memory");
    const int c = lane & 7;
#pragma unroll
    for (int j = 0; j < 4; ++j) { const int n = (lane >> 3) + 8 * j; const LAS float* s = scr + (8 * c) * 33 + n;
        v4u o; o.x = pk2(s[0 * 33], s[1 * 33]); o.y = pk2(s[2 * 33], s[3 * 33]); o.z = pk2(s[4 * 33], s[5 * 33]); o.w = pk2(s[6 * 33], s[7 * 33]);
        *(GAS v4u*)(WT + (size_t)(n0p + n) * K + k0 + 8 * c) = o; }
    LDS_WAIT(); asm volatile("" ::: "memory");
}
__device__ __forceinline__ void rms_row_to_bf16(int lane, const float* xrow, const float* g, bf16* orow) {
    const GAS f32x4* xr = (const GAS f32x4*)xrow + lane;
    f32x4 v[4]; float s = 0.f;
#pragma unroll
    for (int j = 0; j < 4; ++j) { v[j] = xr[64 * j]; s += (v[j].x * v[j].x + v[j].y * v[j].y) + (v[j].z * v[j].z + v[j].w * v[j].w); }
    const float r = rsqrtf(wave_sum(s) * (1.f / DM) + RMS_EPS);
    GAS unsigned long long* o8 = (GAS unsigned long long*)orow + lane;
#pragma unroll
    for (int j = 0; j < 4; ++j) { const f32x4 gg = ((const GAS f32x4*)g)[lane + 64 * j];
        o8[64 * j] = (unsigned long long)pk2(v[j].x * r * gg.x, v[j].y * r * gg.y) | ((unsigned long long)pk2(v[j].z * r * gg.z, v[j].w * r * gg.w) << 32); }
}
__device__ __forceinline__ float2 rope_entry(int pos, int i) {
    const double inv[8] = {1.0, 0.19392274474868576, 0.03760603093086393, 0.007292664737217109, 0.001414213562373095, 0.0002742481756762073, 5.318295896944988e-05, 1.031338537721246e-05};
    double iv = inv[0];
#pragma unroll
    for (int k = 1; k < 8; ++k) iv = (i == k) ? inv[k] : iv;
    const double a = (double)pos * iv * 0.63661977236758134308;
    const double q = __builtin_rint(a);
    const double th = (a - q) * 1.57079632679489661923, t2 = th * th;
    const double sn = th * (1.0 + t2 * (-1.0 / 6 + t2 * (1.0 / 120 + t2 * (-1.0 / 5040 + t2 * (1.0 / 362880 + t2 * (-1.0 / 39916800 + t2 * (1.0 / 6227020800.0)))))));
    const double cs = 1.0 + t2 * (-0.5 + t2 * (1.0 / 24 + t2 * (-1.0 / 720 + t2 * (1.0 / 40320 + t2 * (-1.0 / 3628800 + t2 * (1.0 / 479001600.0 + t2 * (-1.0 / 87178291200.0)))))));
    const int qi = ((int)q) & 3;
    double c, s;
    if (qi == 0) { c = cs; s = sn; } else if (qi == 1) { c = -sn; s = cs; } else if (qi == 2) { c = -cs; s = -sn; } else { c = sn; s = -cs; }
    return make_float2((float)c, (float)s);
}
__device__ __forceinline__ void p0_prologue(Frame& F, const Ptrs& P) {
    unsigned char* ws = P.ws;
    LAS float* scr = (LAS float*)(F.lds + RING_OFF + F.wave * 16384);
    const int gw = F.vcu * NWAVES + F.wave, NGW = F.G * NWAVES;
    constexpr int I1 = 16 * 128, IO = 16 * 32, I2 = 16 * 192, I3 = 32 * 32, NITEMS = I1 + IO + I2 + I3;
    for (int it = gw; it < NITEMS; it += NGW) {
        int r = it;
        if (r < I1) { const int kb = r >> 7, n0p = (r & 127) * 32, rho = n0p & 255, n0l = (n0p & ~255) + 64 * ((rho >> 5) & 3) + 32 * (rho >> 7);
            p0_transpose_item(P.att_w_in, DM, ATT_IN, (bf16*)(ws + WS_W1T), n0p, n0l, kb * 64, scr, F.lane); continue; } r -= I1;
        if (r < IO) { const int kb = r >> 5, n0p = (r & 31) * 32; p0_transpose_item(P.att_w_out, DM, DM, (bf16*)(ws + WS_WOT), n0p, n0p, kb * 64, scr, F.lane); continue; } r -= IO;
        if (r < I2) { const int kb = r / 192, n0p = (r % 192) * 32, pn = n0p >> 8, rho = n0p & 255;
            const int n0l = (pn < 16) ? ((rho < 128) ? 128 * pn + rho : 4096 + 128 * pn + (rho - 128)) : 2048 + 256 * (pn - 16) + rho;
            p0_transpose_item(P.sgu_w_in, DM, SGU_IN, (bf16*)(ws + WS_W2T), n0p, n0l, kb * 64, scr, F.lane); continue; } r -= I2;
        { const int kb = r >> 5, n0p = (r & 31) * 32; p0_transpose_item(P.sgu_w_out, SGU_W, DM, (bf16*)(ws + WS_W3T), n0p, n0p, kb * 64, scr, F.lane); }
    }
    const int gt = gw * 64 + F.lane, NGT = NGW * 64;
    for (int i = gt; i < SEQ * 8; i += NGT) ((float2*)(ws + WS_ROPE))[i] = rope_entry(i >> 3, i & 7);
    for (int i = gt; i < 8 * 128 * 128; i += NGT) { const int t = (i >> 7) & 127, s = i & 127; ((bf16*)(ws + WS_WSB))[i] = (bf16)((s <= t) ? f2bf(P.w_s[i]) : 0u); }
    if (gt < 64) { float* gd = (float*)(ws + WS_GAIN); gd[gt] = P.dsw_qg[gt]; gd[64 + gt] = P.dsw_kg[gt]; gd[128 + gt] = P.diff_qg[gt]; gd[192 + gt] = P.diff_kg[gt]; }
    for (int m = gw; m < SEQ; m += NGW) rms_row_to_bf16(F.lane, P.x + (size_t)m * DM, P.att_norm, (bf16*)(ws + WS_XN) + (size_t)m * DM);
}

__device__ __forceinline__ void merge_row(const Ptrs& P, int t, int lane, float lam, bf16* yout) {
    unsigned char* ws = P.ws;
    bf16* G = (bf16*)(ws + WS_G) + (size_t)t * 1024 + lane * 16;
    const uint4 g0 = *(const uint4*)G, g1 = *(const uint4*)(G + 8);
    const unsigned gw[8] = {g0.x, g0.y, g0.z, g0.w, g1.x, g1.y, g1.z, g1.w};
    float y[16];
    if (lane < 32) {
        const int h = lane >> 2; const float* L = (const float*)(ws + WS_LSE);
        const float l0 = L[((size_t)0 * SEQ + t) * 8 + h], l1 = L[((size_t)1 * SEQ + t) * 8 + h], l2 = L[((size_t)2 * SEQ + t) * 8 + h];
        const float mx = fmaxf(l0, fmaxf(l1, l2)); float w0 = exp2f(l0 - mx), w1 = exp2f(l1 - mx), w2 = exp2f(l2 - mx); const float wi = 1.f / (w0 + w1 + w2); w0 *= wi; w1 *= wi; w2 *= wi;
        const bf16* O = (const bf16*)(ws + WS_OP) + (size_t)t * 512 + lane * 16;
        const float wt[3] = {w0, w1, w2};
#pragma unroll
        for (int i = 0; i < 16; ++i) y[i] = 0.f;
#pragma unroll
        for (int p = 0; p < 3; ++p) { const uint4 a = *(const uint4*)(O + (size_t)p * SEQ * 512), b = *(const uint4*)(O + (size_t)p * SEQ * 512 + 8);
            const unsigned ow[8] = {a.x, a.y, a.z, a.w, b.x, b.y, b.z, b.w};
#pragma unroll
            for (int i = 0; i < 8; ++i) { y[2 * i] += wt[p] * bf2f(ow[i] & 0xffffu); y[2 * i + 1] += wt[p] * bf2f(ow[i] >> 16); } }
    } else {
        const int cidx = (lane - 32) * 16;
        const bf16* A = (const bf16*)(ws + WS_DO0) + (size_t)t * 512 + cidx; const bf16* B = (const bf16*)(ws + WS_DO1) + (size_t)t * 512 + cidx;
        const uint4 a0 = *(const uint4*)A, a1 = *(const uint4*)(A + 8), b0 = *(const uint4*)B, b1 = *(const uint4*)(B + 8);
        const unsigned aw[8] = {a0.x, a0.y, a0.z, a0.w, a1.x, a1.y, a1.z, a1.w}, bw[8] = {b0.x, b0.y, b0.z, b0.w, b1.x, b1.y, b1.z, b1.w};
#pragma unroll
        for (int i = 0; i < 8; ++i) { y[2 * i] = bf2f(aw[i] & 0xffffu) - lam * bf2f(bw[i] & 0xffffu); y[2 * i + 1] = bf2f(aw[i] >> 16) - lam * bf2f(bw[i] >> 16); }
    }
    float ss = 0.f;
#pragma unroll
    for (int i = 0; i < 16; ++i) ss += y[i] * y[i];
    ss += __shfl_xor(ss, 1); ss += __shfl_xor(ss, 2); ss += __shfl_xor(ss, 4);
    if (lane >= 32) {
        const float r = rsqrtf(ss * (1.f / 128.f) + RMS_EPS) * (1.f - LAM_INIT);
        const float* sg = P.subln + ((lane - 32) & 7) * 16;
#pragma unroll
        for (int i = 0; i < 16; ++i) y[i] = y[i] * r * sg[i];
    }
    unsigned ow[8];
#pragma unroll
    for (int i = 0; i < 8; ++i) ow[i] = f2bf(y[2 * i] * bf2f(gw[i] & 0xffffu)) | (f2bf(y[2 * i + 1] * bf2f(gw[i] >> 16)) << 16);
    bf16* Y = yout + (size_t)t * 1024 + lane * 16;
    *(uint4*)Y = make_uint4(ow[0], ow[1], ow[2], ow[3]); *(uint4*)(Y + 8) = make_uint4(ow[4], ow[5], ow[6], ow[7]);
}
__device__ __forceinline__ float lam_value(const Ptrs& P, int lane) {
    const float a = wave_sum(P.lq1[lane] * P.lk1[lane]), b = wave_sum(P.lq2[lane] * P.lk2[lane]);
    return expf(a) - expf(b) + LAM_INIT;
}

typedef float f32x16 __attribute__((ext_vector_type(16)));
typedef short s16x4v __attribute__((ext_vector_type(4)));
__device__ __forceinline__ void sgu_phase(Frame& F, const Ptrs& P, const bool dummy) {
    unsigned char* ws = P.ws;
    const int lane = F.lane, w = F.wave, r32 = lane & 31, hi = lane >> 5;
    const int n = F.vcu >> 1;
    typedef float f32x2s __attribute__((ext_vector_type(2)));
    LAS f32x2s* stt = (LAS f32x2s*)(F.lds + 131072);
    {
        const int row = 16 * w + (lane >> 2), part = lane & 3;
        const f32x4* sp = (const f32x4*)((const float2*)(ws + WS_STAT) + (size_t)(n * 128 + row) * 32 + part * 8);
        float s = 0.f, s2 = 0.f;
#pragma unroll
        for (int i = 0; i < 4; ++i) { const f32x4 v = sp[i]; s += v.x + v.z; s2 += v.y + v.w; }
        s += __shfl_xor(s, 1); s += __shfl_xor(s, 2); s2 += __shfl_xor(s2, 1); s2 += __shfl_xor(s2, 2);
        const float mu = s * (1.f / SGU_W), var = s2 * (1.f / SGU_W) - mu * mu;
        if (part == 0) stt[row] = (f32x2s){mu, rsqrtf(var + LN_EPS)};
    }
    __syncthreads();
    LAS unsigned char* wl = F.lds + w * 16384;
    const unsigned wl_addr = (unsigned)(uintptr_t)wl;
    const bf16* GV = (const bf16*)(ws + WS_GV); bf16* UG = (bf16*)(ws + WS_UG); const bf16* WSB = (const bf16*)(ws + WS_WSB);
    for (int gi = 0; gi < 4; ++gi) {
        const int g = 4 * (F.vcu & 1) + gi, c0 = g * 256 + 32 * w;
        {
            const int cc = (lane & 3) * 8;
            const f32x4 lg0 = *(const f32x4*)(P.ln_g + c0 + cc), lg1 = *(const f32x4*)(P.ln_g + c0 + cc + 4), lb0 = *(const f32x4*)(P.ln_b + c0 + cc), lb1 = *(const f32x4*)(P.ln_b + c0 + cc + 4);
#pragma unroll
            for (int it = 0; it < 8; ++it) {
                const int s = 16 * it + (lane >> 2); const uint4 raw = *(const uint4*)(GV + (size_t)(n * 128 + s) * SGU_W + c0 + cc);
                const f32x2s mr = stt[s];
                f32x4 a = {bf2f(raw.x & 0xffffu), bf2f(raw.x >> 16), bf2f(raw.y & 0xffffu), bf2f(raw.y >> 16)}, b = {bf2f(raw.z & 0xffffu), bf2f(raw.z >> 16), bf2f(raw.w & 0xffffu), bf2f(raw.w >> 16)};
                a = (a - mr.x) * mr.y * lg0 + lb0; b = (b - mr.x) * mr.y * lg1 + lb1;
                v4u o; o.x = pk2(a.x, a.y); o.y = pk2(a.z, a.w); o.z = pk2(b.x, b.y); o.w = pk2(b.z, b.w);
                *(LAS v4u*)(wl + s * 64 + cc * 2) = o;
            }
        }
        LDS_WAIT(); asm volatile("" ::: "memory");
        bf16x8 bfr[8];
        {
            const unsigned va = wl_addr + (unsigned)((8 * hi + ((lane & 15) >> 2)) * 64 + ((lane >> 4) & 1) * 32 + (lane & 3) * 8);
#pragma unroll
            for (int ks = 0; ks < 8; ++ks) { s16x4v lo, hh;
                asm volatile("ds_read_b64_tr_b16 %0,%1 offset:%c2" : "=&v"(lo) : "v"(va), "i"(ks * 1024) : "memory");
                asm volatile("ds_read_b64_tr_b16 %0,%1 offset:%c2" : "=&v"(hh) : "v"(va), "i"(ks * 1024 + 256) : "memory");
                asm volatile("s_waitcnt lgkmcnt(0)" : "+v"(lo), "+v"(hh) :: "memory");
                bfr[ks] = (bf16x8){lo[0], lo[1], lo[2], lo[3], hh[0], hh[1], hh[2], hh[3]}; }
        }
        __builtin_amdgcn_sched_barrier(0);
        f32x16 acc[4];
#pragma unroll
        for (int i = 0; i < 4; ++i) {
            acc[i] = f32x16{};
            const bf16* wrow = WSB + ((size_t)g * 128 + 32 * i + r32) * 128 + 8 * hi;
#pragma unroll
            for (int ks = 0; ks < 2 * i + 2; ++ks) { const bf16x8 af = *(const bf16x8*)(wrow + 16 * ks); acc[i] = __builtin_amdgcn_mfma_f32_32x32x16_bf16(af, bfr[ks], acc[i], 0, 0, 0); }
        }
#pragma unroll
        for (int i = 0; i < 4; ++i)
#pragma unroll
            for (int rr = 0; rr < 16; ++rr) { const int t = 32 * i + (rr & 3) + 8 * (rr >> 2) + 4 * hi; *(LAS float*)(wl + t * 128 + r32 * 4) = acc[i][rr] + P.b_s[g * 128 + t]; }
        LDS_WAIT(); asm volatile("" ::: "memory");
        {
            const int cc = (lane & 3) * 8;
#pragma unroll
            for (int it = 0; it < 8; ++it) {
                const int t = 16 * it + (lane >> 2); bf16* up = UG + (size_t)(n * 128 + t) * SGU_W + c0 + cc;
                const uint4 raw = *(const uint4*)up; const f32x4 s0 = *(LAS f32x4*)(wl + t * 128 + cc * 4), s1 = *(LAS f32x4*)(wl + t * 128 + cc * 4 + 16);
                v4u o; o.x = pk2(bf2f(raw.x & 0xffffu) * s0.x, bf2f(raw.x >> 16) * s0.y); o.y = pk2(bf2f(raw.y & 0xffffu) * s0.z, bf2f(raw.y >> 16) * s0.w);
                o.z = pk2(bf2f(raw.z & 0xffffu) * s1.x, bf2f(raw.z >> 16) * s1.y); o.w = pk2(bf2f(raw.w & 0xffffu) * s1.z, bf2f(raw.w >> 16) * s1.w);
                *(v4u*)(dummy ? (bf16*)(ws + WS_OP) + (size_t)((n * 128 + t) & 8191) * SGU_W + c0 + cc : up) = o;
            }
        }
        LDS_WAIT(); asm volatile("" ::: "memory");
    }
}

struct Args { Ptrs p; int ph_lo, ph_hi, li, pad; };
__global__ void __launch_bounds__(NWAVES * 64, 2) mega_fwd(Args args) {
    extern __shared__ __attribute__((aligned(16))) unsigned char lds[];
    Frame F;
    F.lds = (LAS unsigned char*)lds;
    F.MISC = (volatile LAS unsigned*)(F.lds + MISC_OFF);
    F.wave = __builtin_amdgcn_readfirstlane((int)threadIdx.x >> 6); F.lane = opaque_lane(); F.tid = F.wave * 64 + F.lane;
    F.G = gridDim.x; { const int bx = blockIdx.x; F.vcu = (F.G % 8 == 0) ? (bx % 8) * (F.G / 8) + bx / 8 : bx; }
    const Ptrs& P = args.p;
    unsigned char* ws = P.ws;
    F.ctl = (gu32*)(ws + WS_CTL);
    for (int u = F.tid; u < (LDS_BYTES - LDSCTL_OFF) / 4; u += NWAVES * 64) ((LAS unsigned*)(F.lds + LDSCTL_OFF))[u] = 0u;
    __syncthreads();
    const int lo = args.ph_lo, hi = args.ph_hi;
    XcdBarrier bar; bar.bar = (unsigned*)(F.ctl + CW_BAR) + args.li * XCD_BAR_WORDS; bar.x = 0; bar.st = nullptr;
    if (hi - lo > 1) bar = xcd_barrier_post((unsigned*)(F.ctl + CW_BAR) + args.li * XCD_BAR_WORDS, F.MISC + 8);
    bar.wave = F.wave;
#ifndef PH_EN
#define PH_EN 0x1FF
#endif
#define IN(k) (((PH_EN >> (k)) & 1) && lo <= (k) && (k) < hi)
#ifndef REPEAT_PHASE
#define REPEAT_PHASE -1
#endif
#define REP(k) for (int rep_ = 0; rep_ < ((REPEAT_PHASE == (k)) ? 2 : 1); ++rep_, (rep_ < ((REPEAT_PHASE == (k)) ? 2 : 1) ? xcd_barrier(bar) : (void)0))
#define SEAM(k) do { if (IN(k) && IN((k) + 1)) xcd_barrier(bar); { F.lane = opaque_lane(); F.tid = F.wave * 64 + F.lane; } } while (0)

    if (IN(0)) REP(0) { p0_prologue(F, P); }
    SEAM(0);
    if (IN(1)) REP(1) {
        pg8::Gemm g{(const bf16*)(ws + WS_XN), (const bf16*)(ws + WS_W1T), SEQ, ATT_IN, DM}; pg8::StaticOrder S; S.init(SEQ, ATT_IN, F.G, (int)blockIdx.x);
        pg8::EpiProj1 E{ws};
        pg8::gemm_phase<pg8::EpiProj1, pg8::StaticOrder, PG8_ALIGN, PG8_SP2>(F.lds + RING_OFF, g, S, E, F.wave);
    }
    SEAM(1);
    if (IN(2)) REP(2) {
        using abf = attn_body::bf16;
        const attn_body::AttnArgs A{(const abf*)(ws + WS_QD), (const abf*)(ws + WS_KD), (const abf*)(ws + WS_VD), (abf*)(ws + WS_DO0), (abf*)(ws + WS_DO1),
                                    (const abf*)(ws + WS_QA), (const abf*)(ws + WS_KA), (const abf*)(ws + WS_VA), (abf*)(ws + WS_OP), (float*)(ws + WS_LSE)};
        attn_body::attn_phase_all<8>((char*)lds + RING_OFF, A, F.vcu, F.wave);
    }
    SEAM(2);
    if (IN(3)) REP(3) {
        const float lam = lam_value(P, F.lane);
        for (int t = F.vcu * NWAVES + F.wave; t < SEQ; t += F.G * NWAVES) merge_row(P, t, F.lane, lam, (bf16*)(ws + ((REPEAT_PHASE == 3 && rep_ == 0) ? WS_QA : WS_G)));
    }
    SEAM(3);
    if (IN(4)) REP(4) {
        pg8::Gemm g{(const bf16*)(ws + WS_G), (const bf16*)(ws + WS_WOT), SEQ, DM, DM}; pg8::StaticOrder S; S.init(SEQ, DM, F.G, (int)blockIdx.x);
        pg8::EpiRes E{P.x, P.out};
        pg8::gemm_phase<pg8::EpiRes, pg8::StaticOrder, false, PG8_SP2>(F.lds + RING_OFF, g, S, E, F.wave);
    }
    SEAM(4);
    if (IN(5)) REP(5) {
        for (int m = F.vcu * NWAVES + F.wave; m < SEQ; m += F.G * NWAVES) rms_row_to_bf16(F.lane, P.out + (size_t)m * DM, P.sgu_norm, (bf16*)(ws + WS_XN) + (size_t)m * DM);
    }
    SEAM(5);
    if (IN(6)) REP(6) {
        pg8::Gemm g{(const bf16*)(ws + WS_XN), (const bf16*)(ws + WS_W2T), SEQ, SGU_IN, DM}; pg8::StaticOrder S; S.init(SEQ, SGU_IN, F.G, (int)blockIdx.x);
        pg8::EpiProj2 E{ws};
        pg8::gemm_phase<pg8::EpiProj2, pg8::StaticOrder, PG8_ALIGN, PG8_SP2>(F.lds + RING_OFF, g, S, E, F.wave);
    }
    SEAM(6);
    if (IN(7)) REP(7) { sgu_phase(F, P, REPEAT_PHASE == 7 && rep_ == 0); }
    SEAM(7);
    if (IN(8)) REP(8) {
        pg8::Gemm g{(const bf16*)(ws + WS_UG), (const bf16*)(ws + WS_W3T), SEQ, DM, SGU_W}; pg8::StaticOrder S; S.init(SEQ, DM, F.G, (int)blockIdx.x);
        pg8::EpiRes E{P.out, P.out};
        pg8::gemm_phase<pg8::EpiRes, pg8::StaticOrder, false, PG8_SP2>(F.lds + RING_OFF, g, S, E, F.wave);
    }
#undef IN
#undef SEAM
}
#if DEBUG_NAIVE
__global__ void k_rope(float2* tab) {
    const int idx = blockIdx.x * blockDim.x + threadIdx.x; if (idx >= SEQ * 8) return;
    const int pos = idx >> 3, i = idx & 7;
    const double inv[8] = {1.0, 0.19392274474868576, 0.03760603093086393, 0.007292664737217109, 0.001414213562373095, 0.0002742481756762073, 5.318295896944988e-05, 1.031338537721246e-05};
    double iv = inv[0];
#pragma unroll
    for (int k = 1; k < 8; ++k) iv = (i == k) ? inv[k] : iv;
    const double ang = (double)pos * iv;
    const double a = ang * 0.63661977236758134308;
    const double q = __builtin_rint(a);
    const double th = (a - q) * 1.57079632679489661923;
    const double t2 = th * th;
    double sn = th * (1.0 + t2 * (-1.0 / 6 + t2 * (1.0 / 120 + t2 * (-1.0 / 5040 + t2 * (1.0 / 362880 + t2 * (-1.0 / 39916800 + t2 * (1.0 / 6227020800.0)))))));
    double cs = 1.0 + t2 * (-0.5 + t2 * (1.0 / 24 + t2 * (-1.0 / 720 + t2 * (1.0 / 40320 + t2 * (-1.0 / 3628800 + t2 * (1.0 / 479001600.0 + t2 * (-1.0 / 87178291200.0)))))));
    const int qi = ((int)q) & 3;
    double c, s;
    if (qi == 0) { c = cs; s = sn; } else if (qi == 1) { c = -sn; s = cs; } else if (qi == 2) { c = -cs; s = -sn; } else { c = sn; s = -cs; }
    tab[idx] = make_float2((float)c, (float)s);
}

__global__ void __launch_bounds__(256) k_rmsnorm(const float* x, const float* g, bf16* out) {
    const int row = blockIdx.x * 4 + (threadIdx.x >> 6), lane = threadIdx.x & 63;
    const f32x4* xr = (const f32x4*)(x + (size_t)row * DM) + lane;
    f32x4 v[4]; float s = 0.f;
#pragma unroll
    for (int j = 0; j < 4; ++j) { v[j] = xr[64 * j]; s += (v[j].x * v[j].x + v[j].y * v[j].y) + (v[j].z * v[j].z + v[j].w * v[j].w); }
    const float r = rsqrtf(wave_sum(s) * (1.f / DM) + RMS_EPS);
    unsigned long long* o8 = (unsigned long long*)(out + (size_t)row * DM) + lane;
#pragma unroll
    for (int j = 0; j < 4; ++j) { const f32x4 gg = ((const f32x4*)g)[lane + 64 * j];
        const unsigned lo = f2bf(v[j].x * r * gg.x) | (f2bf(v[j].y * r * gg.y) << 16), hi = f2bf(v[j].z * r * gg.z) | (f2bf(v[j].w * r * gg.w) << 16);
        o8[64 * j] = (unsigned long long)lo | ((unsigned long long)hi << 32); }
}

template <int MODE> __global__ void __launch_bounds__(256) k_ngemm(const bf16* A, int lda, const float* B, int N, int K, Ptrs P) {
    __shared__ float As[16][68];
    __shared__ float Bs[16][68];
    __shared__ float Bs2[16][68];
    __shared__ float T[64][65];
    __shared__ float T2[64][65];
    __shared__ float rinv[64];
    constexpr bool DUAL = (MODE == 3);
    const int tid = threadIdx.x, tx = tid & 15, ty = tid >> 4;
    const int row0 = blockIdx.y * 64, grp = blockIdx.x;
    int col0 = grp * 64, col0b = 0;
    bool dual = false;
    if (MODE == 3) { if (grp < 32) { col0 = grp * 64; col0b = 4096 + grp * 64; dual = true; } else { col0 = 2048 + (grp - 32) * 64; } }
    float acc[4][4], acc2[4][4];
#pragma unroll
    for (int i = 0; i < 4; ++i)
#pragma unroll
        for (int j = 0; j < 4; ++j) { acc[i][j] = 0.f; acc2[i][j] = 0.f; }
    for (int k0 = 0; k0 < K; k0 += 16) {
        { const int r = tid >> 2, kk = (tid & 3) * 4; const uint2 a = *(const uint2*)(A + (size_t)(row0 + r) * lda + k0 + kk);
          As[kk + 0][r] = bf2f(a.x & 0xffffu); As[kk + 1][r] = bf2f(a.x >> 16); As[kk + 2][r] = bf2f(a.y & 0xffffu); As[kk + 3][r] = bf2f(a.y >> 16); }
        { const int kk = tid >> 4, c = (tid & 15) * 4; const f32x4 b = *(const f32x4*)(B + (size_t)(k0 + kk) * N + col0 + c);
          Bs[kk][c] = b.x; Bs[kk][c + 1] = b.y; Bs[kk][c + 2] = b.z; Bs[kk][c + 3] = b.w;
          if (DUAL && dual) { const f32x4 b2 = *(const f32x4*)(B + (size_t)(k0 + kk) * N + col0b + c); Bs2[kk][c] = b2.x; Bs2[kk][c + 1] = b2.y; Bs2[kk][c + 2] = b2.z; Bs2[kk][c + 3] = b2.w; } }
        __syncthreads();
#pragma unroll
        for (int k = 0; k < 16; ++k) {
            float a[4], b[4], b2[4];
#pragma unroll
            for (int i = 0; i < 4; ++i) { a[i] = As[k][ty * 4 + i]; b[i] = Bs[k][tx * 4 + i]; b2[i] = DUAL ? Bs2[k][tx * 4 + i] : 0.f; }
#pragma unroll
            for (int i = 0; i < 4; ++i)
#pragma unroll
                for (int j = 0; j < 4; ++j) { acc[i][j] += a[i] * b[j]; if (DUAL) acc2[i][j] += a[i] * b2[j]; }
        }
        __syncthreads();
    }
#pragma unroll
    for (int i = 0; i < 4; ++i)
#pragma unroll
        for (int j = 0; j < 4; ++j) { T[ty * 4 + i][tx * 4 + j] = acc[i][j]; if (DUAL) T2[ty * 4 + i][tx * 4 + j] = acc2[i][j]; }
    __syncthreads();
    unsigned char* ws = P.ws;
    if (MODE == 1) {
        const int type = grp >> 3, hd = grp & 7;
        const bool isq = (type == 0 || type == 4), isk = (type == 1 || type == 5), isg = (type == 3 || type == 7);
        const float* gain = (type == 0) ? P.dsw_qg : (type == 1) ? P.dsw_kg : (type == 4) ? P.diff_qg : P.diff_kg;
        if (isq || isk) {
            if (tid < 64) { float ss = 0.f; for (int j = 0; j < 64; ++j) ss += T[tid][j] * T[tid][j]; rinv[tid] = rsqrtf(ss * (1.f / 64.f) + RMS_EPS); }
            __syncthreads();
        }
        bf16* dst; int pitch, cb;
        if (type == 0) { dst = (bf16*)(ws + WS_QA); pitch = 512; cb = hd * 64; } else if (type == 1) { dst = (bf16*)(ws + WS_KA); pitch = 512; cb = hd * 64; }
        else if (type == 2) { dst = (bf16*)(ws + WS_VA); pitch = 512; cb = hd * 64; } else if (type == 3) { dst = (bf16*)(ws + WS_G); pitch = 1024; cb = hd * 64; }
        else if (type == 4) { dst = (bf16*)(ws + WS_QD); pitch = 512; cb = hd * 64; } else if (type == 5) { dst = (bf16*)(ws + WS_KD); pitch = 512; cb = hd * 64; }
        else if (type == 6) { dst = (bf16*)(ws + WS_VD); pitch = 512; cb = hd * 64; } else { dst = (bf16*)(ws + WS_G); pitch = 1024; cb = 512 + hd * 64; }
        const float2* tab = (const float2*)(ws + WS_ROPE);
        const int r = tid >> 2;
        for (int jj = 0; jj < 16; ++jj) {
            const int j = (tid & 3) * 16 + jj; float val = T[r][j];
            if (isq || isk) {
                const float ri = rinv[r];
                val = val * ri * gain[j];
                if (j < 16) { const int i = j & 7; const float2 cs = tab[(size_t)(row0 + r) * 8 + i];
                    const float x1 = T[r][i] * ri * gain[i], x2 = T[r][i + 8] * ri * gain[i + 8];
                    val = (j < 8) ? (x1 * cs.x - x2 * cs.y) : (x2 * cs.x + x1 * cs.y); }
                if (isq) val *= C2;
            } else if (isg) val = silu_f(val);
            dst[(size_t)(row0 + r) * pitch + cb + j] = (bf16)f2bf(val);
        }
    } else if (MODE == 2) {
        const int r = tid >> 2;
        for (int jj = 0; jj < 16; ++jj) { const int j = (tid & 3) * 16 + jj; const size_t o = (size_t)(row0 + r) * DM + col0 + j; P.out[o] = P.x[o] + T[r][j]; }
    } else if (MODE == 3) {
        const int r = tid >> 2;
        if (dual) {
            bf16* ug = (bf16*)(ws + WS_UG);
            for (int jj = 0; jj < 16; ++jj) { const int j = (tid & 3) * 16 + jj; ug[(size_t)(row0 + r) * SGU_W + col0 + j] = (bf16)f2bf(gelu_f(T[r][j]) * silu_f(T2[r][j])); }
        } else {
            bf16* gv = (bf16*)(ws + WS_GV);
            for (int jj = 0; jj < 16; ++jj) { const int j = (tid & 3) * 16 + jj; const float v = gelu_f(T[r][j]); T[r][j] = v; gv[(size_t)(row0 + r) * SGU_W + (col0 - 2048) + j] = (bf16)f2bf(v); }
            __syncthreads();
            if (tid < 64) { float s = 0.f, s2 = 0.f; for (int j = 0; j < 64; ++j) { const float v = T[tid][j]; s += v; s2 += v * v; }
                ((float2*)(ws + WS_STAT))[(size_t)(row0 + tid) * 32 + (grp - 32)] = make_float2(s, s2); }
        }
    } else {
        const int r = tid >> 2;
        for (int jj = 0; jj < 16; ++jj) { const int j = (tid & 3) * 16 + jj; const size_t o = (size_t)(row0 + r) * DM + col0 + j; P.out[o] = P.out[o] + T[r][j]; }
    }
}

__global__ void __launch_bounds__(256) k_ndsw(Ptrs P) {
    const int w = blockIdx.x * 4 + (threadIdx.x >> 6), lane = threadIdx.x & 63;
    const int p = w / (SEQ * 8), rem = w % (SEQ * 8), t = rem >> 3, h = rem & 7;
    const int dil = (p == 0) ? 1 : (p == 1) ? 4 : 16;
    const bf16* QA = (const bf16*)(P.ws + WS_QA); const bf16* KA = (const bf16*)(P.ws + WS_KA); const bf16* VA = (const bf16*)(P.ws + WS_VA);
    const float q = bf2f(QA[(size_t)t * 512 + h * 64 + lane]);
    float m = -INFINITY, l = 0.f, o = 0.f;
    for (int j = 0; j <= 128; ++j) {
        const int tk = t - j * dil; if (tk < 0) break;
        const float s = wave_sum(q * bf2f(KA[(size_t)tk * 512 + h * 64 + lane]));
        const float mn = fmaxf(m, s), a = exp2f(m - mn), pe = exp2f(s - mn);
        l = l * a + pe; o = o * a + pe * bf2f(VA[(size_t)tk * 512 + h * 64 + lane]); m = mn;
    }
    ((bf16*)(P.ws + WS_OP))[((size_t)p * SEQ + t) * 512 + h * 64 + lane] = (bf16)f2bf(o / l);
    if (lane == 0) ((float*)(P.ws + WS_LSE))[((size_t)p * SEQ + t) * 8 + h] = m + log2f(l);
}
__global__ void __launch_bounds__(256) k_ndiff(Ptrs P) {
    const int w = blockIdx.x * 4 + (threadIdx.x >> 6), lane = threadIdx.x & 63;
    const int t = SEQ - 1 - (w >> 3), vq = w & 7, h = vq >> 1, c = vq & 1;
    const bf16* QD = (const bf16*)(P.ws + WS_QD); const bf16* KD = (const bf16*)(P.ws + WS_KD); const bf16* VD = (const bf16*)(P.ws + WS_VD);
    const float q = bf2f(QD[(size_t)t * 512 + vq * 64 + lane]);
    float m = -INFINITY, l = 0.f, o0 = 0.f, o1 = 0.f;
    int tk = 0;
    for (; tk + 3 <= t; tk += 4) {
        float s[4];
#pragma unroll
        for (int u = 0; u < 4; ++u) s[u] = q * bf2f(KD[(size_t)(tk + u) * 512 + vq * 64 + lane]);
#pragma unroll
        for (int o = 1; o < 64; o <<= 1) {
#pragma unroll
            for (int u = 0; u < 4; ++u) s[u] += __shfl_xor(s[u], o); }
        const float mn = fmaxf(fmaxf(m, fmaxf(s[0], s[1])), fmaxf(s[2], s[3])), a = exp2f(m - mn);
        l *= a; o0 *= a; o1 *= a; m = mn;
#pragma unroll
        for (int u = 0; u < 4; ++u) { const float pe = exp2f(s[u] - mn); l += pe;
            o0 += pe * bf2f(VD[(size_t)(tk + u) * 512 + h * 128 + lane]); o1 += pe * bf2f(VD[(size_t)(tk + u) * 512 + h * 128 + 64 + lane]); }
    }
    for (; tk <= t; ++tk) {
        const float s = wave_sum(q * bf2f(KD[(size_t)tk * 512 + vq * 64 + lane]));
        const float mn = fmaxf(m, s), a = exp2f(m - mn), pe = exp2f(s - mn);
        l = l * a + pe; o0 = o0 * a + pe * bf2f(VD[(size_t)tk * 512 + h * 128 + lane]); o1 = o1 * a + pe * bf2f(VD[(size_t)tk * 512 + h * 128 + 64 + lane]); m = mn;
    }
    bf16* O = (bf16*)(P.ws + (c ? WS_DO1 : WS_DO0));
    O[(size_t)t * 512 + h * 128 + lane] = (bf16)f2bf(o0 / l); O[(size_t)t * 512 + h * 128 + 64 + lane] = (bf16)f2bf(o1 / l);
}

__global__ void __launch_bounds__(256) k_merge(Ptrs P) {
    const int t = blockIdx.x * 4 + (threadIdx.x >> 6), lane = threadIdx.x & 63;
    const float lam = lam_value(P, lane);
    merge_row(P, t, lane, lam, (bf16*)(P.ws + WS_G));
}

__global__ void k_nstats(Ptrs P) {
    const int t = blockIdx.x * blockDim.x + threadIdx.x; if (t >= SEQ) return;
    const float2* st = (const float2*)(P.ws + WS_STAT) + (size_t)t * 32; float s = 0.f, s2 = 0.f;
    for (int i = 0; i < 32; ++i) { s += st[i].x; s2 += st[i].y; }
    const float mu = s * (1.f / SGU_W), var = s2 * (1.f / SGU_W) - mu * mu;
    ((float2*)(P.ws + WS_MUR))[t] = make_float2(mu, rsqrtf(var + LN_EPS));
}
__global__ void __launch_bounds__(256) k_nsgu(Ptrs P) {
    const int n = blockIdx.x >> 3, g = blockIdx.x & 7, c = g * 256 + threadIdx.x;
    const bf16* GV = (const bf16*)(P.ws + WS_GV); bf16* UG = (bf16*)(P.ws + WS_UG); const float2* mur = (const float2*)(P.ws + WS_MUR);
    const float lg = P.ln_g[c], lb = P.ln_b[c];
    for (int t = 0; t < 128; ++t) {
        const float* wrow = P.w_s + ((size_t)g * 128 + t) * 128; float acc = 0.f;
        for (int s = 0; s <= t; ++s) { const float2 mr = mur[n * 128 + s]; const float vn = (bf2f(GV[(size_t)(n * 128 + s) * SGU_W + c]) - mr.x) * mr.y * lg + lb; acc += wrow[s] * vn; }
        acc += P.b_s[g * 128 + t];
        const size_t o = (size_t)(n * 128 + t) * SGU_W + c;
        UG[o] = (bf16)f2bf(bf2f(UG[o]) * acc);
    }
}

#endif
#ifndef FAST_MASK
#define FAST_MASK 0x1FF
#endif
extern "C" void kernel_launch(void* const* d_in, const int* in_sizes, int n_in, void* d_out, int out_size, void* d_ws, size_t ws_size, hipStream_t stream) {
    static int grid = 0;
    if (grid == 0) {
        if (n_in != 20 || in_sizes[0] != SEQ * DM || out_size != SEQ * DM || ws_size < WS_END) { fprintf(stderr, "kernel_launch: unexpected shapes (n_in %d out %d ws %zu); nothing launched\n", n_in, out_size, ws_size); grid = -1; return; }
        int dev = 0, cus = 0, per_cu = 0;
        if (hipGetDevice(&dev) != hipSuccess || hipDeviceGetAttribute(&cus, hipDeviceAttributeMultiprocessorCount, dev) != hipSuccess) { grid = -1; return; }
        if (hipFuncSetAttribute((const void*)mega_fwd, hipFuncAttributeMaxDynamicSharedMemorySize, LDS_BYTES) != hipSuccess) { fprintf(stderr, "kernel_launch: hipFuncSetAttribute failed\n"); grid = -1; return; }
        if (hipOccupancyMaxActiveBlocksPerMultiprocessor(&per_cu, (const void*)mega_fwd, NWAVES * 64, LDS_BYTES) != hipSuccess || per_cu < 1) fprintf(stderr, "kernel_launch: occupancy query reports %d blocks per CU\n", per_cu);
        (void)hipGetLastError();
        grid = cus;
        if (grid != 256) { fprintf(stderr, "kernel_launch: this kernel needs a 256-CU device (got %d)\n", grid); grid = -1; return; }
    }
    if (grid < 0) return;
    if (hipMemsetAsync((char*)d_ws + WS_CTL, 0, CTL_ZERO_BYTES, stream) != hipSuccess) return;
    Args a{};
    { const float** pp = (const float**)&a.p; for (int i = 0; i < 20; ++i) pp[i] = (const float*)d_in[i]; }
    a.p.out = (float*)d_out; a.p.ws = (unsigned char*)d_ws;
    const unsigned mask = FAST_MASK;
    int li = 0;
#if DEBUG_NAIVE
    const Ptrs P = a.p; unsigned char* ws = P.ws;
    if (mask && !(mask & 1u)) { a.ph_lo = 0; a.ph_hi = 1; a.li = li++; hipLaunchKernelGGL(mega_fwd, dim3(grid), dim3(NWAVES * 64), LDS_BYTES, stream, a); }
#endif
    for (int k = 0; k < N_PHASES;) {
        if (mask & (1u << k)) {
            int e = k; while (e < N_PHASES && (mask & (1u << e))) ++e;
            a.ph_lo = k; a.ph_hi = e; a.li = li++;
            hipLaunchKernelGGL(mega_fwd, dim3(grid), dim3(NWAVES * 64), LDS_BYTES, stream, a);
            k = e; continue;
        }
#if DEBUG_NAIVE
        switch (k) {
            case 0: k_rope<<<SEQ * 8 / 256, 256, 0, stream>>>((float2*)(ws + WS_ROPE)); k_rmsnorm<<<SEQ / 4, 256, 0, stream>>>(P.x, P.att_norm, (bf16*)(ws + WS_XN)); break;
            case 1: k_ngemm<1><<<dim3(64, SEQ / 64), 256, 0, stream>>>((const bf16*)(ws + WS_XN), DM, P.att_w_in, ATT_IN, DM, P); break;
            case 2: k_ndsw<<<3 * SEQ * 8 / 4, 256, 0, stream>>>(P); k_ndiff<<<SEQ * 8 / 4, 256, 0, stream>>>(P); break;
            case 3: k_merge<<<SEQ / 4, 256, 0, stream>>>(P); break;
            case 4: k_ngemm<2><<<dim3(16, SEQ / 64), 256, 0, stream>>>((const bf16*)(ws + WS_G), DM, P.att_w_out, DM, DM, P); break;
            case 5: k_rmsnorm<<<SEQ / 4, 256, 0, stream>>>(P.out, P.sgu_norm, (bf16*)(ws + WS_XN)); break;
            case 6: k_ngemm<3><<<dim3(64, SEQ / 64), 256, 0, stream>>>((const bf16*)(ws + WS_XN), DM, P.sgu_w_in, SGU_IN, DM, P); break;
            case 7: k_nstats<<<SEQ / 256, 256, 0, stream>>>(P); k_nsgu<<<128 * 8, 256, 0, stream>>>(P); break;
            case 8: k_ngemm<4><<<dim3(16, SEQ / 64), 256, 0, stream>>>((const bf16*)(ws + WS_UG), SGU_W, P.sgu_w_out, DM, SGU_W, P); break;
        }
#endif
        ++k;
    }
}
```

```cpp
#include <hip/hip_runtime.h>
#include <hip/hip_bf16.h>
#include <cstdint>
#include <cstdio>
#include <cmath>

constexpr int SEQ = 16384, DM = 1024;
constexpr int ATT_IN = 4096, SGU_W = 2048, SGU_IN = 6144;
constexpr float RMS_EPS = 1e-6f, LN_EPS = 1e-5f;
constexpr float C2 = 0.18033688011112042f;
constexpr float LAM_INIT = 0.2f;

typedef unsigned short bf16;
typedef float f32x4 __attribute__((ext_vector_type(4)));

constexpr size_t MiB = 1u << 20;
constexpr size_t WS_CTL = 0, CTL_ZERO_BYTES = 1 * MiB;
constexpr size_t WS_ROPE = 1 * MiB;
constexpr size_t WS_W1T = 2 * MiB, WS_WOT = 10 * MiB, WS_W2T = 12 * MiB, WS_W3T = 24 * MiB;
constexpr size_t WS_STAT = 28 * MiB;
constexpr size_t WS_XN = 32 * MiB;
constexpr size_t WS_DO0 = 32 * MiB, WS_DO1 = 48 * MiB;
constexpr size_t WS_QA = 64 * MiB, WS_KA = 80 * MiB, WS_VA = 96 * MiB, WS_QD = 112 * MiB, WS_KD = 128 * MiB, WS_VD = 144 * MiB;
constexpr size_t WS_G = 160 * MiB;
constexpr size_t WS_OP = 192 * MiB;
constexpr size_t WS_LSE = 240 * MiB;
constexpr size_t WS_MUR = 242 * MiB;
constexpr size_t WS_WSB = 243 * MiB;
constexpr size_t WS_GAIN = 243 * MiB + 262144;
constexpr size_t WS_UG = 64 * MiB;
constexpr size_t WS_GV = 128 * MiB;
constexpr size_t WS_END = 256 * MiB;

__device__ __forceinline__ float bf2f(unsigned h) { return __builtin_bit_cast(float, h << 16); }
__device__ __forceinline__ float wave_sum(float v) {
#pragma unroll
    for (int o = 1; o < 64; o <<= 1) v += __shfl_xor(v, o);
    return v;
}
__device__ __forceinline__ float silu_f(float v) { return v / (1.f + __expf(-v)); }
__device__ __forceinline__ float gelu_f(float v) { return 0.5f * v * (1.f + erff(v * 0.70710678118654752f)); }

__device__ __forceinline__ int opaque_lane() { unsigned m = ~0u; asm volatile("" : "+s"(m)); return (int)__builtin_amdgcn_mbcnt_hi(m, __builtin_amdgcn_mbcnt_lo(m, 0u)); }

struct Ptrs {
    const float* x; const float* att_norm; const float* att_w_in; const float* dsw_qg; const float* dsw_kg; const float* diff_qg; const float* diff_kg;
    const float* lq1; const float* lk1; const float* lq2; const float* lk2; const float* subln; const float* att_w_out;
    const float* sgu_norm; const float* sgu_w_in; const float* ln_g; const float* ln_b; const float* w_s; const float* b_s; const float* sgu_w_out;
    float* out; unsigned char* ws;
};
#define FAST_MASK 0x1FF
#define DEBUG_NAIVE 0

namespace pg8 {
#define PG8_LAS __attribute__((address_space(3)))
typedef unsigned short bf16_t;
typedef short bf16x8 __attribute__((ext_vector_type(8)));
typedef float f32x4 __attribute__((ext_vector_type(4)));
typedef unsigned u32x4 __attribute__((ext_vector_type(4)));
constexpr int BM = 256, BK = 64, HALF = 128, HTB = HALF * BK * 2  , STAGE_BYTES = 8 * HTB, NXCD = 8, WGM = 8;

__host__ __device__ __forceinline__ int lds_byte(int r, int c) { const int st = (r >> 4) * 2 + (c >> 5), rr = r & 15, cc = c & 31, ob = rr * 64 + cc * 2; return st * 1024 + (ob ^ (((ob >> 9) & 1) << 5)); }
__host__ __device__ __forceinline__ void stage_rc(int b, int& R, int& C) { const int st = b / 1024, sb = b % 1024, swz = sb ^ (((sb >> 9) & 1) << 5); R = (st >> 1) * 16 + swz / 64; C = (st & 1) * 32 + (swz % 64) / 2; }
__host__ __device__ __forceinline__ int perm32(int rho) { const int n = rho >> 4, i = rho & 15; return 8 * (i >> 2) + 4 * n + (i & 3); }

struct Unit { int pm, pn; };
struct Gemm { const bf16_t* A; const bf16_t* Bt; int M, N, K; };

struct StaticOrder {
    int nM, nN, nwg, G, c;
    __host__ __device__ void init(int M, int N, int G_, int c_) { nM = M / BM; nN = N / BM; nwg = nM * nN; G = G_; c = c_; }
    __host__ __device__ bool next(int i, Unit& u) const {
        const long L = (long)i * G + c; if (L >= nwg) return false;
        int wgid = (int)L; { const int q = nwg / NXCD, r = nwg % NXCD, xcd = wgid % NXCD, off = wgid / NXCD; wgid = (xcd < r ? xcd * (q + 1) : r * (q + 1) + (xcd - r) * q) + off; }
        const int nig = WGM * nN, gid = wgid / nig, fm = gid * WGM, gsz = (nM - fm) < WGM ? (nM - fm) : WGM;
        u.pm = fm + ((wgid % nig) % gsz); u.pn = (wgid % nig) / gsz; return true;
    }
    __device__ __forceinline__ void a_ready(const Unit&) const {}
    __device__ __forceinline__ void done(const Unit&) const {}
};

__device__ __forceinline__ unsigned cvt_pk_bf16(float lo, float hi) { unsigned r; asm volatile("v_cvt_pk_bf16_f32 %0, %1, %2" : "=v"(r) : "v"(lo), "v"(hi)); return r; }
typedef float f32x2 __attribute__((ext_vector_type(2)));
__device__ __forceinline__ f32x2 gelu_pk(f32x2 v) {
    const f32x2 av = __builtin_elementwise_abs(v), d = av * 0.2316418882f + 1.0f;
    f32x2 t; t.x = __builtin_amdgcn_rcpf(d.x); t.y = __builtin_amdgcn_rcpf(d.y);
    f32x2 q = t * 0.5307027145f + (-0.7265760135f); q = q * t + 0.7107068705f; q = q * t + (-0.142248368f); q = q * t + 0.127414796f; q = q * t;
    const f32x2 s = (v * v) * (-0.72134752044f);
    f32x2 e; e.x = __builtin_amdgcn_exp2f(s.x); e.y = __builtin_amdgcn_exp2f(s.y);
    const f32x2 m = v * (q * e), r = v - m;
    f32x2 o; o.x = v.x < 0.f ? m.x : r.x; o.y = v.y < 0.f ? m.y : r.y; return o;
}
typedef float f32x2e __attribute__((ext_vector_type(2)));
__device__ __forceinline__ f32x4 silu4(f32x4 v) { f32x4 o; o.x = v.x / (1.f + __expf(-v.x)); o.y = v.y / (1.f + __expf(-v.y)); o.z = v.z / (1.f + __expf(-v.z)); o.w = v.w / (1.f + __expf(-v.w)); return o; }
__device__ __forceinline__ f32x4 gelu4(f32x4 v) { const f32x2 a = gelu_pk((f32x2){v.x, v.y}), b = gelu_pk((f32x2){v.z, v.w}); return (f32x4){a.x, a.y, b.x, b.y}; }
__device__ __forceinline__ u32x4 pack8(f32x4 a, f32x4 b) { u32x4 w; w.x = cvt_pk_bf16(a.x, a.y); w.y = cvt_pk_bf16(a.z, a.w); w.z = cvt_pk_bf16(b.x, b.y); w.w = cvt_pk_bf16(b.z, b.w); return w; }

struct EpiProj1 {
    static constexpr bool PERM = true, AFTER_DRAIN = false;
    unsigned char* ws;
    __device__ __forceinline__ void operator()(const f32x4 (&acc)[2][2][4][2], const Unit& u, int wr, int wc, int fr, int fq) const {
        const int type = u.pn >> 1;
        const int row0 = u.pm * BM + wr * 64 + fr;
        const int hcol = (u.pn & 1) * 256 + wc * 64 + 8 * fq;
        const bool isg = (type & 3) == 3;
        const int slot = type - (type >> 2);
        const size_t boff = isg ? (WS_G + (size_t)(type >> 2) * 1024) : (WS_QA + (size_t)slot * (16 * MiB));
        const int pitch = isg ? 1024 : 512;
        bf16_t* dst = (bf16_t*)(ws + boff) + hcol;
        if ((type & 2) == 0) {
            const float* gp = (const float*)(ws + WS_GAIN) + ((type & 1) + 2 * (type >> 2)) * 64;
            const float qs = (type & 1) ? 1.f : C2;
            f32x4 gn[2][2];
#pragma unroll
            for (int bj = 0; bj < 2; ++bj)
#pragma unroll
                for (int n = 0; n < 2; ++n) gn[bj][n] = *(const f32x4*)(gp + 32 * bj + 8 * fq + 4 * n);
            const float2* tab = (const float2*)(ws + WS_ROPE);
#pragma unroll
            for (int ai = 0; ai < 2; ++ai)
#pragma unroll
                for (int m = 0; m < 4; ++m) {
                    const int row = row0 + ai * HALF + m * 16;
                    f32x4 v[2][2]; float ss = 0.f;
#pragma unroll
                    for (int bj = 0; bj < 2; ++bj)
#pragma unroll
                        for (int n = 0; n < 2; ++n) { v[bj][n] = acc[ai][bj][m][n]; const f32x4 q = v[bj][n] * v[bj][n]; ss += (q.x + q.y) + (q.z + q.w); }
                    ss += __shfl_xor(ss, 16); ss += __shfl_xor(ss, 32);
                    const float ri = rsqrtf(ss * (1.f / 64.f) + RMS_EPS) * qs;
#pragma unroll
                    for (int bj = 0; bj < 2; ++bj)
#pragma unroll
                        for (int n = 0; n < 2; ++n) v[bj][n] = v[bj][n] * ri * gn[bj][n];
                    f32x4 ot[2];
#pragma unroll
                    for (int n = 0; n < 2; ++n) { ot[n].x = __shfl_xor(v[0][n].x, 16); ot[n].y = __shfl_xor(v[0][n].y, 16); ot[n].z = __shfl_xor(v[0][n].z, 16); ot[n].w = __shfl_xor(v[0][n].w, 16); }
                    if (fq < 2) {
                        const f32x4* tp = (const f32x4*)(tab + (size_t)row * 8);
                        const float sg = (fq == 0) ? -1.f : 1.f;
#pragma unroll
                        for (int n = 0; n < 2; ++n) { const f32x4 t0 = tp[2 * n], t1 = tp[2 * n + 1];
                            v[0][n].x = v[0][n].x * t0.x + sg * ot[n].x * t0.y; v[0][n].y = v[0][n].y * t0.z + sg * ot[n].y * t0.w;
                            v[0][n].z = v[0][n].z * t1.x + sg * ot[n].z * t1.y; v[0][n].w = v[0][n].w * t1.z + sg * ot[n].w * t1.w; }
                    }
                    bf16_t* rowp = dst + (size_t)row * pitch;
                    *(u32x4*)(rowp) = pack8(v[0][0], v[0][1]); *(u32x4*)(rowp + 32) = pack8(v[1][0], v[1][1]);
                }
        } else {
            const bool gate = (type & 1);
#pragma unroll
            for (int ai = 0; ai < 2; ++ai)
#pragma unroll
                for (int m = 0; m < 4; ++m) {
                    bf16_t* rowp = dst + (size_t)(row0 + ai * HALF + m * 16) * pitch;
#pragma unroll
                    for (int bj = 0; bj < 2; ++bj) { f32x4 a = acc[ai][bj][m][0], b = acc[ai][bj][m][1]; if (gate) { a = silu4(a); b = silu4(b); }
                        *(u32x4*)(rowp + 32 * bj) = pack8(a, b); }
                }
        }
    }
};
struct EpiRes {
    static constexpr bool PERM = false, AFTER_DRAIN = false;
    const float* base; float* out;
    __device__ __forceinline__ void operator()(const f32x4 (&acc)[2][2][4][2], const Unit& u, int wr, int wc, int fr, int fq) const {
        const int row0 = u.pm * BM + wr * 64 + fr, col0 = u.pn * BM + wc * 32 + 4 * fq;
#pragma unroll
        for (int ai = 0; ai < 2; ++ai)
#pragma unroll
            for (int m = 0; m < 4; ++m) { const size_t off = (size_t)(row0 + ai * HALF + m * 16) * DM + col0;
#pragma unroll
                for (int bj = 0; bj < 2; ++bj)
#pragma unroll
                    for (int n = 0; n < 2; ++n) { const f32x4 b = *(const f32x4*)(base + off + bj * HALF + n * 16); *(f32x4*)(out + off + bj * HALF + n * 16) = b + acc[ai][bj][m][n]; } }
    }
};
struct EpiProj2 {
    static constexpr bool PERM = true, AFTER_DRAIN = false;
    unsigned char* ws;
    __device__ __forceinline__ void operator()(const f32x4 (&acc)[2][2][4][2], const Unit& u, int wr, int wc, int fr, int fq) const {
        const int row0 = u.pm * BM + wr * 64 + fr;
        if (u.pn < 16) {
            bf16_t* dst = (bf16_t*)(ws + WS_UG) + u.pn * 128 + wc * 32 + 8 * fq;
#pragma unroll
            for (int ai = 0; ai < 2; ++ai)
#pragma unroll
                for (int m = 0; m < 4; ++m) {
                    const f32x4 a = gelu4(acc[ai][0][m][0]) * silu4(acc[ai][1][m][0]), b = gelu4(acc[ai][0][m][1]) * silu4(acc[ai][1][m][1]);
                    *(u32x4*)(dst + (size_t)(row0 + ai * HALF + m * 16) * SGU_W) = pack8(a, b);
                }
        } else {
            const int t = u.pn - 16;
            bf16_t* dst = (bf16_t*)(ws + WS_GV) + t * 256 + wc * 32 + 8 * fq;
            float2* st = (float2*)(ws + WS_STAT) + t * 4 + wc;
#pragma unroll
            for (int ai = 0; ai < 2; ++ai)
#pragma unroll
                for (int m = 0; m < 4; ++m) {
                    const int row = row0 + ai * HALF + m * 16; float s = 0.f, s2 = 0.f;
#pragma unroll
                    for (int bj = 0; bj < 2; ++bj) { const f32x4 a = gelu4(acc[ai][bj][m][0]), b = gelu4(acc[ai][bj][m][1]);
                        s += ((a.x + a.y) + (a.z + a.w)) + ((b.x + b.y) + (b.z + b.w));
                        s2 += ((a.x * a.x + a.y * a.y) + (a.z * a.z + a.w * a.w)) + ((b.x * b.x + b.y * b.y) + (b.z * b.z + b.w * b.w));
                        *(u32x4*)(dst + (size_t)row * SGU_W + bj * HALF) = pack8(a, b); }
                    s += __shfl_xor(s, 16); s += __shfl_xor(s, 32); s2 += __shfl_xor(s2, 16); s2 += __shfl_xor(s2, 32);
                    if (fq == 0) st[(size_t)row * 32] = make_float2(s, s2);
                }
        }
    }
};
template <class Epi, class Sched, bool ALIGN_EPI = false, bool SP2 = false>
__device__ __forceinline__ void gemm_phase(PG8_LAS unsigned char* lds, const Gemm g, const Sched& S, const Epi& E, const int wave_) {
    const int tid = wave_ * 64 + opaque_lane(), wid = wave_    , lane = tid & 63, wr = wid >> 2, wc = wid & 3, fr = lane & 15, fq = lane >> 4;
    const int K = g.K, nt = K / BK;
    unsigned voffA[2], voffB[2];
#pragma unroll
    for (int i = 0; i < 2; ++i) { int R, C; stage_rc(tid * 16 + i * 8192, R, C); const int Rb = Epi::PERM ? ((R & ~31) + perm32(R & 31)) : R;
        voffA[i] = (unsigned)(R * K + C) * 2u; voffB[i] = (unsigned)(Rb * K + C) * 2u; }
    const size_t kstep = (size_t)(BK * 2);
    const size_t hstep = (size_t)HALF * K * 2;
    const size_t tstep = 2 * hstep;
    const unsigned ldsw = (unsigned)wid * 1024u;
    const int aoff = lds_byte(wr * 64 + fr, fq * 8), boff = lds_byte(wc * 32 + fr, fq * 8);
#define PG8_SA(b, h) (((b) * 2 + (h)) * HTB)
#define PG8_SB(b, h) ((4 + (b) * 2 + (h)) * HTB)
#define PG8_STAGE(bufoff, gbase, voff) do { _Pragma("unroll") for (int _i = 0; _i < 2; ++_i) \
        __builtin_amdgcn_global_load_lds((const unsigned*)((const char*)(gbase) + (voff)[_i]), (PG8_LAS unsigned*)(lds + (bufoff) + ldsw + _i * 8192), 16, 0, 0); } while (0)
#define PG8_LDA(dst, b, h) do { _Pragma("unroll") for (int m = 0; m < 4; ++m) _Pragma("unroll") for (int k = 0; k < 2; ++k) dst[m][k] = *(const PG8_LAS bf16x8*)(lds + PG8_SA(b, h) + aoff + m * 2048 + k * 1024); } while (0)
#define PG8_LDB(dst, b, h) do { _Pragma("unroll") for (int n = 0; n < 2; ++n) _Pragma("unroll") for (int k = 0; k < 2; ++k) dst[n][k] = *(const PG8_LAS bf16x8*)(lds + PG8_SB(b, h) + boff + n * 2048 + k * 1024); } while (0)
#define PG8_MMA(ai, bj, At, Bt) do { __builtin_amdgcn_s_setprio(1); _Pragma("unroll") for (int m = 0; m < 4; ++m) _Pragma("unroll") for (int n = 0; n < 2; ++n) _Pragma("unroll") for (int k = 0; k < 2; ++k) \
        acc[ai][bj][m][n] = __builtin_amdgcn_mfma_f32_16x16x32_bf16(Bt[n][k], At[m][k], acc[ai][bj][m][n], 0, 0, 0); __builtin_amdgcn_s_setprio(0); } while (0)
#define PG8_WAIT_V(n) asm volatile("s_waitcnt vmcnt(" #n ")" ::: "memory")
#define PG8_WAIT_L(n) asm volatile("s_waitcnt lgkmcnt(" #n ")" ::: "memory")
#define PG8_BAR __builtin_amdgcn_s_barrier()
#define PG8_SCHED __builtin_amdgcn_sched_barrier(0)
    Unit cur, nxt; int ui = 0;
    if (!S.next(0, cur)) return;
    f32x4 acc[2][2][4][2];
#pragma unroll
    for (int a = 0; a < 2; ++a)
#pragma unroll
        for (int b = 0; b < 2; ++b)
#pragma unroll
            for (int m = 0; m < 4; ++m)
#pragma unroll
                for (int n = 0; n < 2; ++n) acc[a][b][m][n] = (f32x4){0.f, 0.f, 0.f, 0.f};
    bf16x8 At[4][2], B0[2][2], B1[2][2];
    const char* cA = (const char*)g.A + (size_t)cur.pm * tstep; const char* cB = (const char*)g.Bt + (size_t)cur.pn * tstep;
    S.a_ready(cur);
    if constexpr (SP2) {
        PG8_STAGE(PG8_SB(0, 0), cB, voffB); PG8_STAGE(PG8_SB(0, 1), cB + hstep, voffB); PG8_STAGE(PG8_SA(0, 0), cA, voffA); PG8_STAGE(PG8_SA(0, 1), cA + hstep, voffA);
        if (wr == 1) PG8_BAR;
        PG8_WAIT_V(2); PG8_BAR;
        PG8_STAGE(PG8_SB(1, 0), cB + kstep, voffB); PG8_STAGE(PG8_SA(1, 0), cA + kstep, voffA); PG8_STAGE(PG8_SB(1, 1), cB + hstep + kstep, voffB);
        PG8_WAIT_V(6); PG8_BAR;
    } else {
        PG8_STAGE(PG8_SB(0, 0), cB, voffB); PG8_STAGE(PG8_SA(0, 0), cA, voffA); PG8_STAGE(PG8_SB(0, 1), cB + hstep, voffB); PG8_STAGE(PG8_SA(0, 1), cA + hstep, voffA);
        if (wr == 1) PG8_BAR;
        PG8_WAIT_V(4); PG8_BAR;
        PG8_STAGE(PG8_SB(1, 0), cB + kstep, voffB); PG8_STAGE(PG8_SA(1, 0), cA + kstep, voffA); PG8_STAGE(PG8_SB(1, 1), cB + hstep + kstep, voffB);
        PG8_WAIT_V(6); PG8_BAR;
    }
    for (;;) {
        const bool has_next = S.next(ui + 1, nxt);
        const char* nA = has_next ? (const char*)g.A + (size_t)nxt.pm * tstep : cA; const char* nB = has_next ? (const char*)g.Bt + (size_t)nxt.pn * tstep : cB;
        for (int t = 0; t < nt; t += 2) {
            const bool last = (t == nt - 2);
            const char* a1 = cA + (size_t)(t + 1) * kstep;
            const char* a2 = last ? nA : cA + (size_t)(t + 2) * kstep; const char* b2 = last ? nB : cB + (size_t)(t + 2) * kstep;
            const char* a3 = a2 + kstep; const char* b3 = b2 + kstep;
            if (last && has_next) S.a_ready(nxt);
            if constexpr (SP2) {
            PG8_LDB(B0, 0, 0); PG8_LDB(B1, 0, 1); PG8_SCHED; PG8_LDA(At, 0, 0); PG8_STAGE(PG8_SA(1, 1), a1 + hstep, voffA);
            PG8_WAIT_V(8); PG8_WAIT_L(0); PG8_BAR; PG8_MMA(0, 0, At, B0); PG8_MMA(0, 1, At, B1); PG8_BAR; PG8_SCHED;
            PG8_LDA(At, 0, 1); PG8_STAGE(PG8_SB(0, 0), b2, voffB); PG8_STAGE(PG8_SB(0, 1), b2 + hstep, voffB); PG8_STAGE(PG8_SA(0, 0), a2, voffA);
            PG8_WAIT_V(8); PG8_WAIT_L(0); PG8_BAR; PG8_MMA(1, 0, At, B0); PG8_MMA(1, 1, At, B1); PG8_BAR; PG8_SCHED;
            PG8_LDB(B0, 1, 0); PG8_LDB(B1, 1, 1); PG8_SCHED; PG8_LDA(At, 1, 0); PG8_STAGE(PG8_SA(0, 1), a2 + hstep, voffA);
            PG8_WAIT_V(8); PG8_WAIT_L(0); PG8_BAR; PG8_MMA(0, 0, At, B0); PG8_MMA(0, 1, At, B1); PG8_BAR; PG8_SCHED;
            PG8_LDA(At, 1, 1); PG8_STAGE(PG8_SB(1, 0), b3, voffB); PG8_STAGE(PG8_SB(1, 1), b3 + hstep, voffB); PG8_STAGE(PG8_SA(1, 0), a3, voffA);
            PG8_WAIT_V(8); PG8_WAIT_L(0); PG8_BAR; PG8_MMA(1, 0, At, B0); PG8_MMA(1, 1, At, B1); PG8_BAR; PG8_SCHED;
            } else {
            PG8_LDB(B0, 0, 0); PG8_SCHED; PG8_LDA(At, 0, 0); PG8_STAGE(PG8_SA(1, 1), a1 + hstep, voffA);
            PG8_WAIT_L(8); PG8_BAR; PG8_WAIT_L(0); PG8_MMA(0, 0, At, B0); PG8_BAR; PG8_SCHED;
            PG8_LDB(B1, 0, 1); PG8_STAGE(PG8_SB(0, 0), b2, voffB);
            PG8_BAR; PG8_WAIT_L(0); PG8_MMA(0, 1, At, B1); PG8_BAR;
            PG8_LDA(At, 0, 1); PG8_STAGE(PG8_SA(0, 0), a2, voffA);
            PG8_BAR; PG8_WAIT_L(0); PG8_MMA(1, 0, At, B0); PG8_BAR; PG8_SCHED;
            PG8_STAGE(PG8_SB(0, 1), b2 + hstep, voffB);
            PG8_WAIT_V(6); PG8_BAR; PG8_MMA(1, 1, At, B1); PG8_BAR;
            PG8_LDB(B0, 1, 0); PG8_SCHED; PG8_LDA(At, 1, 0); PG8_STAGE(PG8_SA(0, 1), a2 + hstep, voffA);
            PG8_WAIT_L(8); PG8_BAR; PG8_WAIT_L(0); PG8_MMA(0, 0, At, B0); PG8_BAR; PG8_SCHED;
            PG8_LDB(B1, 1, 1); PG8_STAGE(PG8_SB(1, 0), b3, voffB);
            PG8_BAR; PG8_WAIT_L(0); PG8_MMA(0, 1, At, B1); PG8_BAR;
            PG8_LDA(At, 1, 1); PG8_STAGE(PG8_SA(1, 0), a3, voffA);
            PG8_BAR; PG8_WAIT_L(0); PG8_MMA(1, 0, At, B0); PG8_BAR; PG8_SCHED;
            PG8_STAGE(PG8_SB(1, 1), b3 + hstep, voffB);
            PG8_WAIT_V(6); PG8_BAR; PG8_MMA(1, 1, At, B1); PG8_BAR;
            }
        }
        if constexpr (ALIGN_EPI) { if (wr == 0) PG8_BAR; }
        if constexpr (!Epi::AFTER_DRAIN) { E(acc, cur, wr, wc, fr, fq); S.done(cur); }
        if (!has_next) break;
#pragma unroll
        for (int a = 0; a < 2; ++a)
#pragma unroll
            for (int b = 0; b < 2; ++b)
#pragma unroll
                for (int m = 0; m < 4; ++m)
#pragma unroll
                    for (int n = 0; n < 2; ++n) acc[a][b][m][n] = (f32x4){0.f, 0.f, 0.f, 0.f};
        cur = nxt; cA = nA; cB = nB; ++ui;
        if constexpr (ALIGN_EPI) { if (wr == 1) PG8_BAR; }
    }
    PG8_WAIT_V(0);
    if constexpr (!ALIGN_EPI) { if (wr == 0) PG8_BAR; }
    PG8_BAR;
    if constexpr (Epi::AFTER_DRAIN) { E.fused(acc, cur, wr, wc, fr, fq, lds, wid, lane); S.done(cur); }
#undef PG8_SA
#undef PG8_SB
#undef PG8_STAGE
#undef PG8_LDA
#undef PG8_LDB
#undef PG8_MMA
#undef PG8_WAIT_V
#undef PG8_WAIT_L
#undef PG8_BAR
#undef PG8_SCHED
}
}

#ifndef PG8_SP2
#define PG8_SP2 true
#endif
#ifndef PG8_ALIGN
#define PG8_ALIGN true
#endif
#include <hip/hip_bf16.h>
#include <cmath>
namespace attn_body {
using bf16=__hip_bfloat16;
using bf16x8=__attribute__((ext_vector_type(8)))short;
using s16x4=__attribute__((ext_vector_type(4)))short;
using f32x16=__attribute__((ext_vector_type(16)))float;
using u32x4=__attribute__((ext_vector_type(4)))unsigned;
constexpr int SEQ=16384,D=64,DM=512;
constexpr int NW=8,QBLK=32,QB=QBLK*NW,KVBLK=64,NQB=SEQ/QB;
constexpr int ATTN_PITCH=DM, ATTN_UNIT_ROWS=QB;
__device__ __forceinline__ int crow(int r,int hi){return (r&3)+8*(r>>2)+4*hi;}
#define SBAR() __builtin_amdgcn_sched_barrier(0)
__device__ __forceinline__ void cmask(f32x16&p0,f32x16&p1,int jb,int qrel,int hi){
  const float NEG=-INFINITY; int kb=64*jb+4*hi;
  #pragma unroll
  for(int r=0;r<16;++r){int kv=kb+(r&3)+8*(r>>2); if(kv>qrel)p0[r]=NEG; if(kv+32>qrel)p1[r]=NEG;}
}

constexpr int NSLOT=3, SLOTB=8192;
constexpr int LDS_K=0, LDS_V=NSLOT*SLOTB, LDS_WS=2*NSLOT*SLOTB, LDS_OST=LDS_WS+NW*64*4, LDS_BYTES=LDS_OST+NW*4096;
constexpr float C2=0.125f*1.4426950408889634f;
__device__ __forceinline__ void glds16(const void*gsrc,unsigned lds_dst){unsigned keep;
  asm volatile("s_mov_b32 %0, m0\n\ts_mov_b32 m0, %2\n\ts_nop 0\n\tglobal_load_lds_dwordx4 %1, off\n\ts_mov_b32 m0, %0":"=&s"(keep):"v"(gsrc),"s"(lds_dst):"memory");}
__device__ __forceinline__ float max3f(float a,float b,float c){float r;asm("v_max3_f32 %0, %1, %2, %3":"=v"(r):"v"(a),"v"(b),"v"(c));return r;}
__device__ __forceinline__ float max2f(float a,float b){float r;asm("v_max_f32_e32 %0, %1, %2":"=v"(r):"v"(a),"v"(b));return r;}
__device__ __forceinline__ float fadd_s(float a,float b){float r;asm("v_add_f32_e32 %0, %1, %2":"=v"(r):"v"(a),"v"(b));return r;}
__device__ __forceinline__ float fsub_s(float a,float b){float r;asm("v_sub_f32_e32 %0, %1, %2":"=v"(r):"v"(a),"v"(b));return r;}
typedef float f32x2_t __attribute__((ext_vector_type(2))); typedef __bf16 bf16x2_t __attribute__((ext_vector_type(2)));
__device__ __forceinline__ unsigned cvtpk_s(float lo,float hi){f32x2_t v={lo,hi};bf16x2_t b=__builtin_convertvector(v,bf16x2_t);return __builtin_bit_cast(unsigned,b);}
#define WAIT_BAR(N) asm volatile("s_waitcnt vmcnt(" #N ") lgkmcnt(0)\n\ts_barrier":::"memory")

__device__ __forceinline__ void qkt(f32x16&p0,f32x16&p1,const char*Kslot,const bf16x8*qr,const f32x16&negm,int r32,int hi){
  const char*kb=Kslot+hi*1024+r32*16;
  #pragma unroll
  for(int d0=0;d0<4;++d0){
    const bf16x8 b0=*reinterpret_cast<const bf16x8*>(kb+d0*2048);
    const bf16x8 b1=*reinterpret_cast<const bf16x8*>(kb+d0*2048+512);
    if(d0==0){p0=__builtin_amdgcn_mfma_f32_32x32x16_bf16(b0,qr[0],negm,0,0,0);p1=__builtin_amdgcn_mfma_f32_32x32x16_bf16(b1,qr[0],negm,0,0,0);}
    else{p0=__builtin_amdgcn_mfma_f32_32x32x16_bf16(b0,qr[d0],p0,0,0,0);p1=__builtin_amdgcn_mfma_f32_32x32x16_bf16(b1,qr[d0],p1,0,0,0);}}
}
typedef __attribute__((address_space(3))) const char* lds_cptr;
typedef short v4i16_t __attribute__((ext_vector_type(4)));
__device__ __forceinline__ void kload8(bf16x8*kf,lds_cptr kp){
  kf[0]=*(const __attribute__((address_space(3))) bf16x8*)(kp);      kf[1]=*(const __attribute__((address_space(3))) bf16x8*)(kp+512);
  kf[2]=*(const __attribute__((address_space(3))) bf16x8*)(kp+2048); kf[3]=*(const __attribute__((address_space(3))) bf16x8*)(kp+2560);
  kf[4]=*(const __attribute__((address_space(3))) bf16x8*)(kp+4096); kf[5]=*(const __attribute__((address_space(3))) bf16x8*)(kp+4608);
  kf[6]=*(const __attribute__((address_space(3))) bf16x8*)(kp+6144); kf[7]=*(const __attribute__((address_space(3))) bf16x8*)(kp+6656);
}
__device__ __forceinline__ void kload2(bf16x8*kf,lds_cptr kp,int j){ kf[2*j]=*(const __attribute__((address_space(3))) bf16x8*)(kp+j*2048); kf[2*j+1]=*(const __attribute__((address_space(3))) bf16x8*)(kp+j*2048+512); }
__device__ __forceinline__ s16x4 vtr(lds_cptr p){ return __builtin_bit_cast(s16x4,__builtin_amdgcn_ds_read_tr16_b64_v4i16((__attribute__((address_space(3))) v4i16_t*)p)); }
__device__ __forceinline__ float rowmax(const f32x16&p0,const f32x16&p1){
  float a=max3f(p0[0],p0[1],p1[0]),b=max3f(p0[2],p0[3],p1[1]);a=max3f(a,p1[2],p1[3]);
  #pragma unroll
  for(int r=4;r<16;r+=4){a=max3f(a,p0[r],p0[r+1]);b=max3f(b,p0[r+2],p0[r+3]);a=max3f(a,p1[r],p1[r+1]);b=max3f(b,p1[r+2],p1[r+3]);}
  const float m=max2f(a,b);
  auto rr=__builtin_amdgcn_permlane32_swap(__float_as_uint(m),__float_as_uint(m),false,false);
  return max2f(__uint_as_float(rr[0]),__uint_as_float(rr[1]));
}
__device__ __forceinline__ void pv(f32x16*o,int vb,bf16x8 pa0,bf16x8 pa1,bf16x8 pa2,bf16x8 pa3){
  #pragma unroll
  for(int d0=0;d0<2;++d0){s16x4 lo[4],hi[4];
    #pragma unroll
    for(int ks=0;ks<4;++ks){
      asm volatile("ds_read_b64_tr_b16 %0,%1 offset:%c2":"=&v"(lo[ks]):"v"(vb),"i"(d0*4096+ks*1024):"memory");
      asm volatile("ds_read_b64_tr_b16 %0,%1 offset:%c2":"=&v"(hi[ks]):"v"(vb),"i"(d0*4096+ks*1024+512):"memory");}
    asm volatile("s_waitcnt lgkmcnt(0)":::"memory");SBAR();
    #define PK(k) (bf16x8){lo[k][0],lo[k][1],lo[k][2],lo[k][3],hi[k][0],hi[k][1],hi[k][2],hi[k][3]}
    o[d0]=__builtin_amdgcn_mfma_f32_32x32x16_bf16(pa0,PK(0),o[d0],0,0,0);
    o[d0]=__builtin_amdgcn_mfma_f32_32x32x16_bf16(pa1,PK(1),o[d0],0,0,0);
    o[d0]=__builtin_amdgcn_mfma_f32_32x32x16_bf16(pa2,PK(2),o[d0],0,0,0);
    o[d0]=__builtin_amdgcn_mfma_f32_32x32x16_bf16(pa3,PK(3),o[d0],0,0,0);
    #undef PK
  }
}

#ifndef ATTN_STORE16
#define ATTN_STORE16(p,v) (*(u32x4*)(p)=(v))
#endif
template<int THRL> __device__ __forceinline__ void attn_unit(int qb,const bf16*Qh,const bf16*__restrict__ Kh,const bf16*__restrict__ Vh,bf16*Oh,char*shm,const int wid){
  const int lane=opaque_lane(),tid=wid*64+lane,r32=lane&31,hi=lane>>5;
  const int q0=qb*QB;
  const bf16*Qw=Qh+(long)(q0+wid*QBLK)*DM;
  const unsigned lds0=(unsigned)(uintptr_t)shm;
  float*wsf=(float*)(shm+LDS_WS)+wid*64;
  const bf16*ksrc=Kh+(long)lane*DM+wid*8;
  const bf16*vsrc=Vh+(long)(16*(wid&3)+(lane>>2))*DM+(wid>>2)*32+(lane&3)*8;
  const unsigned kdst=lds0+LDS_K+wid*1024, vdst=lds0+LDS_V+wid*1024;
  #define DMA_K(t,slot) glds16(ksrc+(long)(t)*KVBLK*DM,(unsigned)__builtin_amdgcn_readfirstlane(kdst+(slot)))
  #define DMA_V(t,slot) glds16(vsrc+(long)(t)*KVBLK*DM,(unsigned)__builtin_amdgcn_readfirstlane(vdst+(slot)))
  const int vb0=(int)(lds0+LDS_V)+((lane>>4)&1)*32+(lane&3)*8+(4*hi+((lane&15)>>2))*64;
  const char*Kbase=shm+LDS_K; bf16x8 kf[8];
  const lds_cptr shm3=(lds_cptr)shm; const lds_cptr kp0=shm3+LDS_K+hi*1024+r32*16; const lds_cptr vp0=shm3+LDS_V+((lane>>4)&1)*32+(lane&3)*8+(4*hi+((lane&15)>>2))*64;
  const int NT=(q0+QB)/KVBLK;
  DMA_K(0,0);DMA_V(0,0);DMA_K(1,SLOTB);
  bf16x8 qr[4];
  #pragma unroll
  for(int d0=0;d0<4;++d0)qr[d0]=*reinterpret_cast<const bf16x8*>(&Qw[(long)r32*DM+d0*16+hi*8]);
  float mhat=0.f,l_reg=0.f; float zz_=0.f; asm volatile("":"+v"(zz_));
  f32x16 o[2]; f32x16 negm;
  #pragma unroll
  for(int r=0;r<16;++r){o[0][r]=zz_;o[1][r]=zz_;negm[r]=zz_;}
  asm volatile("":"+v"(negm));
  const int qrel=wid*QBLK+r32;
  #define CMASK(P0,P1,t) do{int jb_=(t)-(NT-4); if(jb_>=0)cmask(P0,P1,jb_,qrel,hi);}while(0)
  bool resc=false;
  #define START(P0,P1) do{ const float rm=rowmax(P0,P1); resc=false; \
    { const float dl=rm; mhat=fadd_s(mhat,dl); \
      _Pragma("unroll") for(int r=0;r<16;++r){P0[r]=fsub_s(P0[r],dl);P1[r]=fsub_s(P1[r],dl);} \
      _Pragma("unroll") for(int r=0;r<16;++r)negm[r]=-mhat; asm volatile("":"+v"(negm)); } \
    _Pragma("unroll") for(int r=0;r<16;++r)P0[r]=__builtin_amdgcn_exp2f(P0[r]); }while(0)
  #define RESC() do{ if(resc){ asm volatile("s_waitcnt lgkmcnt(0)":::"memory"); \
      _Pragma("unroll") for(int d_=0;d_<2;++d_) _Pragma("unroll") for(int r=0;r<16;++r)o[d_][r]*=wsf[crow(r,hi)]; } }while(0)
  f32x16 pA0,pA1,pB0,pB1;
  int sl_prev=0,sl_cur=0,sl_next=SLOTB;
  #define ROT() do{sl_prev=sl_cur;sl_cur=sl_next;sl_next=(sl_next==(NSLOT-1)*SLOTB)?0:sl_next+SLOTB;}while(0)
  DMA_K(2,2*SLOTB);
  WAIT_BAR(3);
  qkt(pA0,pA1,Kbase,qr,negm,r32,hi);asm volatile("s_nop 15\n\ts_nop 7":"+v"(pA0),"+v"(pA1));CMASK(pA0,pA1,0);
  START(pA0,pA1);
  _Pragma("unroll") for(int r=0;r<16;++r)pA1[r]=__builtin_amdgcn_exp2f(pA1[r]);
  WAIT_BAR(0);
  DMA_K(3,0);DMA_V(1,SLOTB);
  ROT();
  kload8(kf,kp0+sl_cur);
  WAIT_BAR(2);
  s16x4 vlo[8],vhi[8]; u32x4 pw0,pw1,pw2,pw3;
  #define PKW(P,B) cvtpk_s(P[B],P[B+1])
  #define PAF(k) __builtin_bit_cast(bf16x8,pw##k)
  #define VFR(i) (bf16x8){vlo[i][0],vlo[i][1],vlo[i][2],vlo[i][3],vhi[i][0],vhi[i][1],vhi[i][2],vhi[i][3]}
  #define PIN(x) asm volatile("":"+v"(x))
  #define MX3(a,b,c) __builtin_fmaxf(__builtin_fmaxf((a),(b)),(c))
  #define GAPA(MF,A0,A1,A2,A3,W0,W1,PW) do{ MF; sacc+=A0; sacc+=A1; sacc+=A2; sacc+=A3; PIN(sacc); W0; W1; PIN(PW); SBAR(); }while(0)
  #define EX(v) __builtin_amdgcn_exp2f(v)
  #define GAPB(MF,X,B) do{ MF; X[B]=EX(X[B]); X[B+1]=EX(X[B+1]); X[B+2]=EX(X[B+2]); X[B+3]=EX(X[B+3]); PIN(X); SBAR(); }while(0)
  #define VRD(i) do{ vlo[i]=vtr(vp_+(((i)>>2)*4096+((i)&3)*1024)); vhi[i]=vtr(vp_+(((i)>>2)*4096+((i)&3)*1024+512)); }while(0)
  #define KRD(G,j) do{ if(G){ kload2(kf,kp0+sl_next,j); SBAR(); } }while(0)
  #define STEP(C0,C1,P0,P1,t,GK,GV,GL) do{ SBAR(); \
    const lds_cptr vp_=vp0+sl_prev; \
    VRD(0); SBAR(); float sacc=(P0[0]+P0[1]); \
    GAPA(C0=__builtin_amdgcn_mfma_f32_32x32x16_bf16(kf[0],qr[0],negm,0,0,0), P0[2],P0[3],P0[4],P0[5],     pw0[0]=PKW(P0,0), pw0[1]=PKW(P0,2), pw0); \
    VRD(4); SBAR(); GAPA(C1=__builtin_amdgcn_mfma_f32_32x32x16_bf16(kf[1],qr[0],negm,0,0,0), P0[6],P0[7],P0[8],P0[9],     pw0[2]=PKW(P0,4), pw0[3]=PKW(P0,6), pw0); \
    VRD(1); SBAR(); GAPA(C0=__builtin_amdgcn_mfma_f32_32x32x16_bf16(kf[2],qr[1],C0,0,0,0),   P0[10],P0[11],P0[12],P0[13], pw1[0]=PKW(P0,8), pw1[1]=PKW(P0,10), pw1); \
    VRD(5); SBAR(); GAPA(C1=__builtin_amdgcn_mfma_f32_32x32x16_bf16(kf[3],qr[1],C1,0,0,0),   P0[14],P0[15],P1[0],P1[1],   pw1[2]=PKW(P0,12),pw1[3]=PKW(P0,14), pw1); \
    VRD(2); SBAR(); GAPA(C0=__builtin_amdgcn_mfma_f32_32x32x16_bf16(kf[4],qr[2],C0,0,0,0),   P1[2],P1[3],P1[4],P1[5],     pw2[0]=PKW(P1,0), pw2[1]=PKW(P1,2), pw2); \
    VRD(6); SBAR(); GAPA(C1=__builtin_amdgcn_mfma_f32_32x32x16_bf16(kf[5],qr[2],C1,0,0,0),   P1[6],P1[7],P1[8],P1[9],     pw2[2]=PKW(P1,4), pw2[3]=PKW(P1,6), pw2); \
    VRD(3); SBAR(); GAPA(C0=__builtin_amdgcn_mfma_f32_32x32x16_bf16(kf[6],qr[3],C0,0,0,0),   P1[10],P1[11],P1[12],P1[13], pw3[0]=PKW(P1,8), pw3[1]=PKW(P1,10), pw3); \
    VRD(7); SBAR(); GAPA(C1=__builtin_amdgcn_mfma_f32_32x32x16_bf16(kf[7],qr[3],C1,0,0,0),   P1[14],P1[15],0.f,0.f,       pw3[2]=PKW(P1,12),pw3[3]=PKW(P1,14), pw3); \
    l_reg+=sacc; \
    if(GK){DMA_K((t)+3,sl_cur);} if(GV){DMA_V((t)+1,sl_next);} \
    CMASK(C0,C1,t); \
    { float a=MX3(C0[0],C0[1],C1[0]),b=MX3(C0[2],C0[3],C1[1]); a=MX3(a,C1[2],C1[3]); \
      _Pragma("unroll") for(int r=4;r<16;r+=4){a=MX3(a,C0[r],C0[r+1]);b=MX3(b,C0[r+2],C0[r+3]);a=MX3(a,C1[r],C1[r+1]);b=MX3(b,C1[r+2],C1[r+3]);} \
      float rm=__builtin_fmaxf(a,b); { auto rr=__builtin_amdgcn_permlane32_swap(__float_as_uint(rm),__float_as_uint(rm),false,false); rm=__builtin_fmaxf(__uint_as_float(rr[0]),__uint_as_float(rr[1])); } \
      resc=false; \
      if(__builtin_expect(__any(rm>(float)THRL),0)){ const float dl=__builtin_fmaxf(rm,0.f); mhat+=dl; \
        _Pragma("unroll") for(int r=0;r<16;++r){C0[r]-=dl;C1[r]-=dl;} \
        _Pragma("unroll") for(int r=0;r<16;++r)negm[r]=-mhat; asm volatile("":"+v"(negm)); \
        const float f=__builtin_amdgcn_exp2f(-dl); l_reg*=f; if(hi==0)wsf[r32]=f; resc=true; } } \
    SBAR(); \
    GAPB(o[0]=__builtin_amdgcn_mfma_f32_32x32x16_bf16(PAF(0),VFR(0),o[0],0,0,0), C0,0); \
    GAPB(o[1]=__builtin_amdgcn_mfma_f32_32x32x16_bf16(PAF(0),VFR(4),o[1],0,0,0), C0,4); \
    KRD(GL,0); GAPB(o[0]=__builtin_amdgcn_mfma_f32_32x32x16_bf16(PAF(1),VFR(1),o[0],0,0,0), C0,8); \
    KRD(GL,1); GAPB(o[1]=__builtin_amdgcn_mfma_f32_32x32x16_bf16(PAF(1),VFR(5),o[1],0,0,0), C0,12); \
    KRD(GL,2); GAPB(o[0]=__builtin_amdgcn_mfma_f32_32x32x16_bf16(PAF(2),VFR(2),o[0],0,0,0), C1,0); \
    KRD(GL,3); GAPB(o[1]=__builtin_amdgcn_mfma_f32_32x32x16_bf16(PAF(2),VFR(6),o[1],0,0,0), C1,4); \
    GAPB(o[0]=__builtin_amdgcn_mfma_f32_32x32x16_bf16(PAF(3),VFR(3),o[0],0,0,0), C1,8); \
    GAPB(o[1]=__builtin_amdgcn_mfma_f32_32x32x16_bf16(PAF(3),VFR(7),o[1],0,0,0), C1,12); \
    }while(0)
  int t=1;
  #undef CMASK
  #define CMASK(P0,P1,t) do{}while(0)
  for(;t+5<NT;t+=2){
    STEP(pB0,pB1,pA0,pA1,t,true,true,true);     WAIT_BAR(2); RESC(); ROT();
    STEP(pA0,pA1,pB0,pB1,t+1,true,true,true);   WAIT_BAR(2); RESC(); ROT();
  }
  #undef CMASK
  #define CMASK(P0,P1,t) do{int jb_=(t)-(NT-4); if(jb_>=0)cmask(P0,P1,jb_,qrel,hi);}while(0)
  #define ENDW(tt) do{ if((tt)+3<NT){WAIT_BAR(2);} else if((tt)+2<NT){WAIT_BAR(1);} else {WAIT_BAR(0);} }while(0)
  for(;t+1<NT;t+=2){
    STEP(pB0,pB1,pA0,pA1,t,(t+3<NT),(t+1<NT),(t+1<NT));       ENDW(t);   RESC(); ROT();
    STEP(pA0,pA1,pB0,pB1,t+1,(t+4<NT),(t+2<NT),(t+2<NT));     ENDW(t+1); RESC(); ROT();
  }
  STEP(pB0,pB1,pA0,pA1,NT-1,false,false,false); RESC();
  { float sacc=pB0[0]+pB0[1]; _Pragma("unroll") for(int r=2;r<16;++r)sacc+=pB0[r]; _Pragma("unroll") for(int r=0;r<16;++r)sacc+=pB1[r]; l_reg+=sacc;
    pw0=(u32x4){PKW(pB0,0),PKW(pB0,2),PKW(pB0,4),PKW(pB0,6)};pw1=(u32x4){PKW(pB0,8),PKW(pB0,10),PKW(pB0,12),PKW(pB0,14)};pw2=(u32x4){PKW(pB1,0),PKW(pB1,2),PKW(pB1,4),PKW(pB1,6)};pw3=(u32x4){PKW(pB1,8),PKW(pB1,10),PKW(pB1,12),PKW(pB1,14)};
    SBAR(); pv(o,vb0+sl_cur,PAF(0),PAF(1),PAF(2),PAF(3)); }
  #undef PKW
  #undef PAF
  #undef VFR
  #undef PIN
  #undef MX3
  #undef GAPA
  #undef GAPB
  #undef EX
  #undef VRD
  #undef KRD
  #undef STEP
  #undef ENDW
  {auto rr=__builtin_amdgcn_permlane32_swap(__float_as_uint(l_reg),__float_as_uint(l_reg),false,false);l_reg=__uint_as_float(rr[0])+__uint_as_float(rr[1]);}
  if(hi==0)wsf[32+r32]=l_reg;asm volatile("s_waitcnt lgkmcnt(0)":::"memory");
  float rli[16];
  #pragma unroll
  for(int r=0;r<16;++r)rli[r]=__builtin_amdgcn_rcpf(wsf[32+crow(r,hi)]);
  bf16*Ow=Oh+(long)(q0+wid*QBLK)*DM;
  { bf16*stg=(bf16*)(shm+LDS_OST)+wid*2048;
    #pragma unroll
    for(int r=0;r<16;++r){const int orow=crow(r,hi);
      #pragma unroll
      for(int d0=0;d0<2;++d0)stg[orow*64+d0*32+r32]=__float2bfloat16(o[d0][r]*rli[r]);}
    asm volatile("s_waitcnt lgkmcnt(0)":::"memory");
    #pragma unroll
    for(int i=0;i<4;++i){const int row=i*8+(lane>>3),ch=lane&7; const u32x4 v=*(const u32x4*)(stg+row*64+ch*8); ATTN_STORE16(Ow+(long)row*DM+ch*8,v);} }
  asm volatile("s_waitcnt lgkmcnt(0)\n\ts_barrier":::"memory");
  #undef DMA_K
  #undef DMA_V
  #undef CMASK
  #undef START
  #undef RESC
  #undef ROT
}
constexpr int ATTN_LDS_BYTES=LDS_BYTES;
constexpr int W_K=0, W_V=4*SLOTB, W_WS=W_V+4*2*SLOTB, W_OST=0, W_LDS_BYTES=W_WS+NW*64*4;
__device__ __forceinline__ void pv4(f32x16*o,int vb,bf16x8 pa0,bf16x8 pa1,bf16x8 pa2,bf16x8 pa3){
  #pragma unroll
  for(int d0=0;d0<4;++d0){s16x4 lo[4],hi[4];
    #pragma unroll
    for(int ks=0;ks<4;++ks){
      asm volatile("ds_read_b64_tr_b16 %0,%1 offset:%c2":"=&v"(lo[ks]):"v"(vb),"i"(d0*4096+ks*1024):"memory");
      asm volatile("ds_read_b64_tr_b16 %0,%1 offset:%c2":"=&v"(hi[ks]):"v"(vb),"i"(d0*4096+ks*1024+512):"memory");}
    asm volatile("s_waitcnt lgkmcnt(0)":::"memory");SBAR();
    #define PK(k) (bf16x8){lo[k][0],lo[k][1],lo[k][2],lo[k][3],hi[k][0],hi[k][1],hi[k][2],hi[k][3]}
    o[d0]=__builtin_amdgcn_mfma_f32_32x32x16_bf16(pa0,PK(0),o[d0],0,0,0);
    o[d0]=__builtin_amdgcn_mfma_f32_32x32x16_bf16(pa1,PK(1),o[d0],0,0,0);
    o[d0]=__builtin_amdgcn_mfma_f32_32x32x16_bf16(pa2,PK(2),o[d0],0,0,0);
    o[d0]=__builtin_amdgcn_mfma_f32_32x32x16_bf16(pa3,PK(3),o[d0],0,0,0);
    #undef PK
  }
}
template<int THRL> __device__ __forceinline__ void attn_unit128(int qb,const bf16*Qh,const bf16*__restrict__ Kh,const bf16*__restrict__ Vh,bf16*Oh,char*shm,const int wid){
  const int lane=opaque_lane(),tid=wid*64+lane,r32=lane&31,hi=lane>>5;
  const int q0=qb*QB;
  const bf16*Qw=Qh+(long)(q0+wid*QBLK)*DM;
  const unsigned lds0=(unsigned)(uintptr_t)shm;
  float*wsf=(float*)(shm+W_WS)+wid*64;
  const bf16*ksrc=Kh+(long)lane*DM+wid*8;
  const bf16*vsrc=Vh+(long)(16*(wid&3)+(lane>>2))*DM+(wid>>2)*32+(lane&3)*8;
  const unsigned kdst=lds0+W_K+wid*1024, vdst=lds0+W_V+wid*1024;
  #define DMA_K(t,slot) glds16(ksrc+(long)(t)*KVBLK*DM,(unsigned)__builtin_amdgcn_readfirstlane(kdst+(slot)))
  #define DMA_V(t,slot) do{ glds16(vsrc+(long)(t)*KVBLK*DM,(unsigned)__builtin_amdgcn_readfirstlane(vdst+(slot))); glds16(vsrc+64+(long)(t)*KVBLK*DM,(unsigned)__builtin_amdgcn_readfirstlane(vdst+8192+(slot))); }while(0)
  const int vb0=(int)(lds0+W_V)+((lane>>4)&1)*32+(lane&3)*8+(4*hi+((lane&15)>>2))*64;
  const char*Kbase=shm+W_K; bf16x8 kf[8];
  const lds_cptr shm3=(lds_cptr)shm; const lds_cptr kp0=shm3+W_K+hi*1024+r32*16; const lds_cptr vp0=shm3+W_V+((lane>>4)&1)*32+(lane&3)*8+(4*hi+((lane&15)>>2))*64;
  const int NT=(q0+QB)/KVBLK;
  DMA_K(0,0);DMA_V(0,0);DMA_K(1,SLOTB);DMA_V(1,2*SLOTB);
  bf16x8 qr[4];
  #pragma unroll
  for(int d0=0;d0<4;++d0)qr[d0]=*reinterpret_cast<const bf16x8*>(&Qw[(long)r32*DM+d0*16+hi*8]);
  float mhat=0.f,l_reg=0.f; float zz_=0.f; asm volatile("":"+v"(zz_));
  f32x16 o[4]; const f32x16 zero16=f32x16{};
  #pragma unroll
  for(int r=0;r<16;++r){o[0][r]=zz_;o[1][r]=zz_;o[2][r]=zz_;o[3][r]=zz_;}
  const int qrel=wid*QBLK+r32;
  #define CMASK(P0,P1,t) do{int jb_=(t)-(NT-4); if(jb_>=0)cmask(P0,P1,jb_,qrel,hi);}while(0)
  bool resc=false;
  #define START(P0,P1) do{ const float rm=rowmax(P0,P1); resc=false; \
    { const float dl=rm; mhat=fadd_s(mhat,dl); \
      _Pragma("unroll") for(int r=0;r<16;++r){P0[r]=fsub_s(P0[r],dl);P1[r]=fsub_s(P1[r],dl);} \
      } \
    _Pragma("unroll") for(int r=0;r<16;++r)P0[r]=__builtin_amdgcn_exp2f(P0[r]); }while(0)
  #define RESC() do{ if(resc){ asm volatile("s_waitcnt lgkmcnt(0)":::"memory"); \
      _Pragma("unroll") for(int d_=0;d_<4;++d_) _Pragma("unroll") for(int r=0;r<16;++r)o[d_][r]*=wsf[crow(r,hi)]; } }while(0)
  DMA_K(2,2*SLOTB);DMA_K(3,3*SLOTB);
  WAIT_BAR(7);
  f32x16 C0,C1; u32x4 pw0,pw1,pw2,pw3;
  #define PKW(P,B) cvtpk_s(P[B],P[B+1])
  qkt(C0,C1,Kbase,qr,zero16,r32,hi);asm volatile("s_nop 15\n\ts_nop 7":"+v"(C0),"+v"(C1));CMASK(C0,C1,0);
  _Pragma("unroll") for(int r=0;r<16;++r){C0[r]=__builtin_amdgcn_exp2f(C0[r]);C1[r]=__builtin_amdgcn_exp2f(C1[r]);}
  { float sacc=C0[0]+C0[1]; _Pragma("unroll") for(int r=2;r<16;++r)sacc+=C0[r]; _Pragma("unroll") for(int r=0;r<16;++r)sacc+=C1[r]; l_reg+=sacc;
    pw0=(u32x4){PKW(C0,0),PKW(C0,2),PKW(C0,4),PKW(C0,6)};pw1=(u32x4){PKW(C0,8),PKW(C0,10),PKW(C0,12),PKW(C0,14)};pw2=(u32x4){PKW(C1,0),PKW(C1,2),PKW(C1,4),PKW(C1,6)};pw3=(u32x4){PKW(C1,8),PKW(C1,10),PKW(C1,12),PKW(C1,14)}; }
  WAIT_BAR(4);
  DMA_K(4,0);DMA_V(2,4*SLOTB);
  kload8(kf,kp0+SLOTB);
  WAIT_BAR(4);
  s16x4 vlo[16],vhi[16];
  #define PAF(k) __builtin_bit_cast(bf16x8,pw##k)
  #define VFR(i) (bf16x8){vlo[i][0],vlo[i][1],vlo[i][2],vlo[i][3],vhi[i][0],vhi[i][1],vhi[i][2],vhi[i][3]}
  #define PIN(x) asm volatile("":"+v"(x))
  #define MX3(a,b,c) __builtin_fmaxf(__builtin_fmaxf((a),(b)),(c))
  #define EX(v) __builtin_amdgcn_exp2f(v)
  #define GAPB(MF,X,B,PN,I) do{ MF; X[B]=EX(X[B]); X[B+1]=EX(X[B+1]); sacc+=X[B]; sacc+=X[B+1]; PN[I]=PKW(X,B); PIN(sacc); PIN(PN); SBAR(); }while(0)
  #define VRD(i) do{ vlo[i]=vtr(vp_+(((i)>>2)*4096+((i)&3)*1024)); vhi[i]=vtr(vp_+(((i)>>2)*4096+((i)&3)*1024+512)); }while(0)
  #define KRD(G,j) do{ if(G){ kload2(kf,kp0+kn_,j); SBAR(); } }while(0)
  #define QK(C,kk,qq,CI) do{ C=__builtin_amdgcn_mfma_f32_32x32x16_bf16(kf[kk],qr[qq],CI,0,0,0); SBAR(); }while(0)
  #define STEP(t,GK,GV,GL) do{ SBAR(); \
    const lds_cptr vp_=vp0+(((t)-1)&3)*(2*SLOTB); const int kn_=(((t)+1)&3)*SLOTB; \
    VRD(0); SBAR(); QK(C0,0,0,zero16); QK(C1,1,0,zero16); \
    VRD(4); SBAR(); QK(C0,2,1,C0); QK(C1,3,1,C1); \
    VRD(8); SBAR(); QK(C0,4,2,C0); QK(C1,5,2,C1); \
    VRD(12); SBAR(); QK(C0,6,3,C0); QK(C1,7,3,C1); \
    if(GK){DMA_K((t)+4,((t)&3)*SLOTB);} if(GV){DMA_V((t)+2,(((t)+2)&3)*(2*SLOTB));} \
    CMASK(C0,C1,t); \
    SBAR(); float sacc=0.f; \
    VRD(1); SBAR(); o[0]=__builtin_amdgcn_mfma_f32_32x32x16_bf16(PAF(0),VFR(0),o[0],0,0,0); SBAR(); \
    VRD(5); SBAR(); o[1]=__builtin_amdgcn_mfma_f32_32x32x16_bf16(PAF(0),VFR(4),o[1],0,0,0); SBAR(); \
    VRD(9); SBAR(); o[2]=__builtin_amdgcn_mfma_f32_32x32x16_bf16(PAF(0),VFR(8),o[2],0,0,0); SBAR(); \
    VRD(13); SBAR(); o[3]=__builtin_amdgcn_mfma_f32_32x32x16_bf16(PAF(0),VFR(12),o[3],0,0,0); SBAR(); \
    VRD(2); SBAR(); GAPB(o[0]=__builtin_amdgcn_mfma_f32_32x32x16_bf16(PAF(1),VFR(1),o[0],0,0,0), C0,0,pw0,0); \
    VRD(6); SBAR(); GAPB(o[1]=__builtin_amdgcn_mfma_f32_32x32x16_bf16(PAF(1),VFR(5),o[1],0,0,0), C0,2,pw0,1); \
    VRD(10); SBAR(); GAPB(o[2]=__builtin_amdgcn_mfma_f32_32x32x16_bf16(PAF(1),VFR(9),o[2],0,0,0), C0,4,pw0,2); \
    VRD(14); SBAR(); GAPB(o[3]=__builtin_amdgcn_mfma_f32_32x32x16_bf16(PAF(1),VFR(13),o[3],0,0,0), C0,6,pw0,3); \
    VRD(3); SBAR(); KRD(GL,0); GAPB(o[0]=__builtin_amdgcn_mfma_f32_32x32x16_bf16(PAF(2),VFR(2),o[0],0,0,0), C0,8,pw1,0); \
    VRD(7); SBAR(); KRD(GL,1); GAPB(o[1]=__builtin_amdgcn_mfma_f32_32x32x16_bf16(PAF(2),VFR(6),o[1],0,0,0), C0,10,pw1,1); \
    VRD(11); SBAR(); KRD(GL,2); GAPB(o[2]=__builtin_amdgcn_mfma_f32_32x32x16_bf16(PAF(2),VFR(10),o[2],0,0,0), C0,12,pw1,2); \
    VRD(15); SBAR(); KRD(GL,3); GAPB(o[3]=__builtin_amdgcn_mfma_f32_32x32x16_bf16(PAF(2),VFR(14),o[3],0,0,0), C0,14,pw1,3); \
    GAPB(o[0]=__builtin_amdgcn_mfma_f32_32x32x16_bf16(PAF(3),VFR(3),o[0],0,0,0), C1,0,pw2,0); \
    GAPB(o[1]=__builtin_amdgcn_mfma_f32_32x32x16_bf16(PAF(3),VFR(7),o[1],0,0,0), C1,2,pw2,1); \
    GAPB(o[2]=__builtin_amdgcn_mfma_f32_32x32x16_bf16(PAF(3),VFR(11),o[2],0,0,0), C1,4,pw2,2); \
    GAPB(o[3]=__builtin_amdgcn_mfma_f32_32x32x16_bf16(PAF(3),VFR(15),o[3],0,0,0), C1,6,pw2,3); \
    GAPB((void)0, C1,8,pw3,0); \
    GAPB((void)0, C1,10,pw3,1); \
    GAPB((void)0, C1,12,pw3,2); \
    GAPB((void)0, C1,14,pw3,3); \
    l_reg+=sacc; \
    }while(0)
  int t=1;
  #undef CMASK
  #define CMASK(P0,P1,t) do{}while(0)
  for(;t+4<NT;++t){ STEP(t,true,true,true); WAIT_BAR(6); }
  #undef CMASK
  #define CMASK(P0,P1,t) do{int jb_=(t)-(NT-4); if(jb_>=0)cmask(P0,P1,jb_,qrel,hi);}while(0)
  #define ENDW(tt) do{ if((tt)+3<NT){WAIT_BAR(5);} else if((tt)+2<NT){WAIT_BAR(4);} else {WAIT_BAR(0);} }while(0)
  for(;t+1<NT;++t){ STEP(t,(t+4<NT),(t+2<NT),(t+1<NT)); ENDW(t); }
  STEP(NT-1,false,false,false);
  SBAR(); pv4(o,vb0+((NT-1)&3)*(2*SLOTB),PAF(0),PAF(1),PAF(2),PAF(3));
  #undef PKW
  #undef PAF
  #undef VFR
  #undef PIN
  #undef MX3
  #undef GAPB
  #undef EX
  #undef VRD
  #undef KRD
  #undef QK
  #undef STEP
  #undef ENDW
  {auto rr=__builtin_amdgcn_permlane32_swap(__float_as_uint(l_reg),__float_as_uint(l_reg),false,false);l_reg=__uint_as_float(rr[0])+__uint_as_float(rr[1]);}
  if(hi==0)wsf[32+r32]=l_reg;asm volatile("s_waitcnt lgkmcnt(0)":::"memory");
  float rli[16];
  #pragma unroll
  for(int r=0;r<16;++r)rli[r]=__builtin_amdgcn_rcpf(wsf[32+crow(r,hi)]);
  bf16*Ow=Oh+(long)(q0+wid*QBLK)*DM;
  asm volatile("s_waitcnt lgkmcnt(0)\n\ts_barrier":::"memory");
  { bf16*stg=(bf16*)(shm+W_OST)+wid*4096;
    #pragma unroll
    for(int r=0;r<16;++r){const int orow=crow(r,hi);
      #pragma unroll
      for(int d0=0;d0<4;++d0)stg[orow*128+d0*32+r32]=__float2bfloat16(o[d0][r]*rli[r]);}
    asm volatile("s_waitcnt lgkmcnt(0)":::"memory");
    #pragma unroll
    for(int i=0;i<8;++i){const int row=i*4+(lane>>4),ch=lane&15; const u32x4 v=*(const u32x4*)(stg+row*128+ch*8); ATTN_STORE16(Ow+(long)row*DM+ch*8,v);} }
  asm volatile("s_waitcnt lgkmcnt(0)\n\ts_barrier":::"memory");
  #undef DMA_K
  #undef DMA_V
  #undef CMASK
  #undef START
  #undef RESC
}
constexpr int DSW_K=0, DSW_V=6*SLOTB, DSW_WS=12*SLOTB, DSW_OST=DSW_WS+NW*64*4, DSW_LDS_BYTES=DSW_OST+NW*4096;
__device__ __forceinline__ void dsw_unit(int dil,int r,int blk,const bf16*Qh,const bf16*__restrict__ Kh,const bf16*__restrict__ Vh,bf16*Oh,float*lse,char*shm,const int wid){
  const int lane=opaque_lane(),r32=lane&31,hi=lane>>5;
  const int L=256*blk;
  const unsigned lds0=(unsigned)(uintptr_t)shm;
  float*wsf=(float*)(shm+DSW_WS)+wid*64;
  #pragma unroll
  for(int tau=0;tau<6;++tau){
    int lk=L-128+64*tau+lane; lk=lk<0?0:lk;
    glds16(Kh+((long)lk*dil+r)*DM+wid*8,(unsigned)__builtin_amdgcn_readfirstlane(lds0+DSW_K+tau*SLOTB+wid*1024));
    int lv=L-128+64*tau+16*(wid&3)+(lane>>2); lv=lv<0?0:lv;
    glds16(Vh+((long)lv*dil+r)*DM+(wid>>2)*32+(lane&3)*8,(unsigned)__builtin_amdgcn_readfirstlane(lds0+DSW_V+tau*SLOTB+wid*1024));
  }
  const long tq=(long)(L+wid*QBLK+r32)*dil+r;
  bf16x8 qr[4];
  #pragma unroll
  for(int d0=0;d0<4;++d0)qr[d0]=*reinterpret_cast<const bf16x8*>(&Qh[tq*DM+d0*16+hi*8]);
  WAIT_BAR(0);
  const int tau0=wid>>1;
  const f32x16 zero=f32x16{};
  f32x16 s00,s01,s10,s11,s20,s21;
  qkt(s00,s01,shm+DSW_K+(tau0+0)*SLOTB,qr,zero,r32,hi);
  qkt(s10,s11,shm+DSW_K+(tau0+1)*SLOTB,qr,zero,r32,hi);
  qkt(s20,s21,shm+DSW_K+(tau0+2)*SLOTB,qr,zero,r32,hi);
  const int lq=wid*QBLK+r32;
  { const int th=lq-128-(-128+64*tau0+4*hi);
    _Pragma("unroll") for(int rr=0;rr<16;++rr){ const int c0=(rr&3)+8*(rr>>2); s00[rr]=(c0>=th)?s00[rr]:-INFINITY; s01[rr]=(c0+32>=th)?s01[rr]:-INFINITY; } }
  { const int th=lq-(-128+64*(tau0+2)+4*hi);
    _Pragma("unroll") for(int rr=0;rr<16;++rr){ const int c0=(rr&3)+8*(rr>>2); s20[rr]=(c0<=th)?s20[rr]:-INFINITY; s21[rr]=(c0+32<=th)?s21[rr]:-INFINITY; } }
  if(blk==0){
    if(tau0<2){ _Pragma("unroll") for(int rr=0;rr<16;++rr){ s00[rr]=-INFINITY; s01[rr]=-INFINITY; } }
    if(tau0<1){ _Pragma("unroll") for(int rr=0;rr<16;++rr){ s10[rr]=-INFINITY; s11[rr]=-INFINITY; } }
  }
  float l=0.f;
  #define DSW_EXP(P) do{ _Pragma("unroll") for(int rr=0;rr<16;++rr){ P[rr]=__builtin_amdgcn_exp2f(P[rr]); l+=P[rr]; } }while(0)
  DSW_EXP(s00); DSW_EXP(s01); DSW_EXP(s10); DSW_EXP(s11); DSW_EXP(s20); DSW_EXP(s21);
  #undef DSW_EXP
  { auto pr=__builtin_amdgcn_permlane32_swap(__float_as_uint(l),__float_as_uint(l),false,false); l=__uint_as_float(pr[0])+__uint_as_float(pr[1]); }
  f32x16 o[2]; o[0]=f32x16{}; o[1]=f32x16{};
  const int vb0=(int)(lds0+DSW_V)+((lane>>4)&1)*32+(lane&3)*8+(4*hi+((lane&15)>>2))*64;
  #define DSW_PV(P0,P1,jj) do{ u32x4 w0,w1,w2,w3; \
      w0=(u32x4){cvtpk_s(P0[0],P0[1]),cvtpk_s(P0[2],P0[3]),cvtpk_s(P0[4],P0[5]),cvtpk_s(P0[6],P0[7])}; w1=(u32x4){cvtpk_s(P0[8],P0[9]),cvtpk_s(P0[10],P0[11]),cvtpk_s(P0[12],P0[13]),cvtpk_s(P0[14],P0[15])}; \
      w2=(u32x4){cvtpk_s(P1[0],P1[1]),cvtpk_s(P1[2],P1[3]),cvtpk_s(P1[4],P1[5]),cvtpk_s(P1[6],P1[7])}; w3=(u32x4){cvtpk_s(P1[8],P1[9]),cvtpk_s(P1[10],P1[11]),cvtpk_s(P1[12],P1[13]),cvtpk_s(P1[14],P1[15])}; \
      SBAR(); pv(o,vb0+(tau0+(jj))*SLOTB,__builtin_bit_cast(bf16x8,w0),__builtin_bit_cast(bf16x8,w1),__builtin_bit_cast(bf16x8,w2),__builtin_bit_cast(bf16x8,w3)); }while(0)
  DSW_PV(s00,s01,0); DSW_PV(s10,s11,1); DSW_PV(s20,s21,2);
  #undef DSW_PV
  if(hi==0){ wsf[32+r32]=l; lse[tq*8]=__builtin_log2f(l); }
  asm volatile("s_waitcnt lgkmcnt(0)":::"memory");
  float rli[16];
  #pragma unroll
  for(int rr=0;rr<16;++rr)rli[rr]=__builtin_amdgcn_rcpf(wsf[32+crow(rr,hi)]);
  { bf16*stg=(bf16*)(shm+DSW_OST)+wid*2048;
    #pragma unroll
    for(int rr=0;rr<16;++rr){const int orow=crow(rr,hi);
      #pragma unroll
      for(int d0=0;d0<2;++d0)stg[orow*64+d0*32+r32]=__float2bfloat16(o[d0][rr]*rli[rr]);}
    asm volatile("s_waitcnt lgkmcnt(0)":::"memory");
    #pragma unroll
    for(int i=0;i<4;++i){const int row=i*8+(lane>>3),ch=lane&7; const u32x4 v=*(const u32x4*)(stg+row*64+ch*8);
      *(u32x4*)(Oh+((long)(L+wid*QBLK+row)*dil+r)*DM+ch*8)=v;} }
  asm volatile("s_waitcnt lgkmcnt(0)\n\ts_barrier":::"memory");
}
#ifndef NREP_DIFF
#define NREP_DIFF 1
#endif
#ifndef NREP_DSW
#define NREP_DSW 1
#endif
#ifndef ATT_VSPLIT
#define ATT_VSPLIT 0
#endif
struct AttnArgs { const bf16*QD; const bf16*KD; const bf16*VD; bf16*DO0; bf16*DO1; const bf16*QA; const bf16*KA; const bf16*VA; bf16*OP; float*LSE; };
template<int THRL=8> __device__ __forceinline__ void attn_phase_all(char*lds,const AttnArgs&A,int vcu,const int wid){
#ifndef NO_DIFF
#if ATT_VSPLIT
  { const int vh=vcu>>4,s=vcu&15,h=vh>>2,c=(vh>>1)&1,half=vh&1;
    const bf16*Qh=A.QD+(2*h+c)*64; const bf16*Kh=A.KD+(2*h+c)*64; const bf16*Vh=A.VD+h*128+half*64; bf16*Oh=(c?A.DO1:A.DO0)+h*128+half*64;
    for(int rep_=0;rep_<NREP_DIFF;++rep_) for(int i=0;i<4;++i){ const int qb=(i==0)?63-s:(i==1)?32+s:(i==2)?31-s:s; attn_unit<THRL>(qb,Qh,Kh,Vh,Oh,lds,wid); } }
#else
  { const int hc=vcu>>5,s=vcu&31,h=hc>>1,c=hc&1;
    const bf16*Qh=A.QD+hc*64; const bf16*Kh=A.KD+hc*64; const bf16*Vh=A.VD+h*128; bf16*Oh=(c?A.DO1:A.DO0)+h*128;
    for(int rep_=0;rep_<NREP_DIFF;++rep_) for(int i=0;i<2;++i){ const int qb=(i==0)?63-s:s; attn_unit128<THRL>(qb,Qh,Kh,Vh,Oh,lds,wid); } }
#endif
#endif
#ifndef NO_DSW
  for(int rep_=0;rep_<NREP_DSW;++rep_) for(int i=0;i<6;++i){ const int u=vcu+256*i; const int p=u>>9,h=(u>>6)&7,idx=u&63; const int dil=(p==0)?1:(p==1)?4:16; const int nblk=64/dil; const int r=idx/nblk,blk=idx-r*nblk;
    dsw_unit(dil,r,blk,A.QA+h*64,A.KA+h*64,A.VA+h*64,A.OP+(size_t)p*SEQ*DM+h*64,A.LSE+(size_t)p*SEQ*8+h,lds,wid); }
#endif
}
#undef SBAR
#undef WAIT_BAR
}
#define GAS __attribute__((address_space(1)))
#define LAS __attribute__((address_space(3)))
typedef unsigned short bf16;
typedef unsigned v4u __attribute__((ext_vector_type(4)));
typedef float f32x4 __attribute__((ext_vector_type(4)));
typedef short bf16x8 __attribute__((ext_vector_type(8)));
typedef GAS unsigned gu32;
typedef GAS unsigned long long gu64;
#define RLX_AGENT __ATOMIC_RELAXED, __HIP_MEMORY_SCOPE_AGENT
#define LDS_WAIT() asm volatile("s_waitcnt lgkmcnt(0)" ::: "memory")
#define VM_WAIT() asm volatile("s_waitcnt vmcnt(0)" ::: "memory")
__device__ __forceinline__ unsigned long long rt() { return __builtin_amdgcn_s_memrealtime(); }
__device__ __forceinline__ unsigned f2bf(float f) { unsigned u = __builtin_bit_cast(unsigned, f); return (u + 0x7fffu + ((u >> 16) & 1u)) >> 16; }
__device__ __forceinline__ unsigned pk2(float lo, float hi) { return f2bf(lo) | (f2bf(hi) << 16); }

#define XB_TMO      128
#define XB_XCNT(j)  (256  + 64 * (j))
#define XB_XSUB(j)  (1280 + 64 * (j))
#define XB_XGEN(j)  (2304 + 64 * (j))
#define XB_TOP      3328
#define XB_TOPGEN   3392
#define XCD_BAR_WORDS 3456
#define XB_SPIN_CAP (1u << 18)

__device__ __forceinline__ unsigned xb_ld(unsigned* p)              { return __hip_atomic_load(p, __ATOMIC_RELAXED, __HIP_MEMORY_SCOPE_AGENT); }
__device__ __forceinline__ unsigned xb_add(unsigned* p, unsigned v) { return __hip_atomic_fetch_add(p, v, __ATOMIC_RELAXED, __HIP_MEMORY_SCOPE_AGENT); }
__device__ __forceinline__ unsigned xb_xcc_id() { return (unsigned)__builtin_amdgcn_s_getreg((3 << 11) | 20) & 0xFu; }
#define XB_SPIN(cond, bar) do { unsigned _sp = 0; while (cond) { __builtin_amdgcn_s_sleep(1); \
    if ((++_sp & 255u) == 0u) { if (xb_ld(&(bar)[XB_TMO])) break; if (_sp > XB_SPIN_CAP) { atomicAdd(&(bar)[XB_TMO], 1u); break; } } } } while (0)

struct XcdBarrier {
    unsigned* bar; unsigned x; int wave;
    volatile LAS unsigned* st;
};

__device__ __forceinline__ XcdBarrier xcd_barrier_post(unsigned* bar, volatile LAS unsigned* st) {
    XcdBarrier b; b.bar = bar; b.x = xb_xcc_id(); b.st = st;
    if (threadIdx.x == 0) (void)xb_add(&bar[XB_XCNT(b.x)], 1u);
    return b;
}
__device__ __forceinline__ void xcd_barrier_complete(unsigned* bar, unsigned x, unsigned& nloc, unsigned& nx) {
    const unsigned G = gridDim.x * gridDim.y * gridDim.z;
    unsigned sum, cnt, mine, sp = 0u;
    for (;;) {
        sum = 0u; cnt = 0u; mine = 0u;
#pragma unroll
        for (unsigned j = 0; j < 16; ++j) { const unsigned c = xb_ld(&bar[XB_XCNT(j)]); sum += c; cnt += (c > 0u) ? 1u : 0u; mine = (j == x) ? c : mine; }
        if (sum == G) break;
        __builtin_amdgcn_s_sleep(1);
        if ((++sp & 255u) == 0u) { if (xb_ld(&bar[XB_TMO])) break; if (sp > XB_SPIN_CAP) { atomicAdd(&bar[XB_TMO], 1u); break; } }
    }
    nloc = mine > 0u ? mine : 1u; nx = cnt > 0u ? cnt : 1u;
}

__device__ __forceinline__ void xcd_barrier(const XcdBarrier& b) {
    asm volatile("s_waitcnt vmcnt(0)" ::: "memory");
    __syncthreads();
    if (b.wave == 0 && opaque_lane() == 0) {
        unsigned* bar = b.bar;
        __builtin_amdgcn_s_waitcnt(0);
        unsigned nloc = b.st[0], nx = b.st[1];
        if (nloc == 0u) { xcd_barrier_complete(bar, b.x, nloc, nx); b.st[0] = nloc; b.st[1] = nx; }
        const unsigned old = xb_add(&bar[XB_XSUB(b.x)], 1u);
        const unsigned gen = old / nloc;
        if (old + 1u == (gen + 1u) * nloc) {
            __builtin_amdgcn_fence(__ATOMIC_RELEASE, "agent");
            asm volatile("s_waitcnt vmcnt(0)" ::: "memory");
            const unsigned og = xb_add(&bar[XB_TOP], 1u);
            const unsigned tg = og / nx;
            if (og + 1u == (tg + 1u) * nx) xb_add(&bar[XB_TOPGEN], 1u);
            else XB_SPIN(xb_ld(&bar[XB_TOPGEN]) == tg, bar);
            __builtin_amdgcn_fence(__ATOMIC_ACQUIRE, "agent");
            xb_add(&bar[XB_XGEN(b.x)], 1u);
            asm volatile("s_waitcnt vmcnt(0)" ::: "memory");
        } else {
            XB_SPIN(xb_ld(&bar[XB_XGEN(b.x)]) == gen, bar);
            __builtin_amdgcn_fence(__ATOMIC_ACQUIRE, "agent");
            asm volatile("s_waitcnt vmcnt(0)" ::: "memory");
        }
    }
    __syncthreads();
}
constexpr int NWAVES = 8;
constexpr int RING_OFF = 0, RING_BYTES = 135168;
constexpr int LDSCTL_OFF = RING_BYTES, MISC_OFF = LDSCTL_OFF + 320;
constexpr int LDS_BYTES = 147456;
static_assert(MISC_OFF + 128 <= LDS_BYTES && attn_body::DSW_LDS_BYTES <= RING_BYTES && attn_body::ATTN_LDS_BYTES <= RING_BYTES, "LDS map");
constexpr int CW_TMO = 0, CW_CODE = 1;
constexpr int CW_BAR = 4096;
constexpr int N_PHASES = 9;
static_assert((CW_BAR + N_PHASES * XCD_BAR_WORDS) * 4 <= (int)CTL_ZERO_BYTES, "CTL words inside the memset region");

struct Frame {
    LAS unsigned char* lds; volatile LAS unsigned* MISC; gu32* ctl;
    int tid, lane, wave, vcu, G;
};

__device__ __forceinline__ void p0_transpose_item(const float* W, int K, int N, bf16* WT, int n0p, int n0l, int k0, LAS float* scr, int lane) {
#pragma unroll 8
    for (int i = 0; i < 32; ++i) { const int kk = 2 * i + (lane >> 5); scr[kk * 33 + (lane & 31)] = W[(size_t)(k0 + kk) * N + n0l + (lane & 31)]; }
    LDS_WAIT(); asm volatile("" ::: "memory");
    const int c = lane & 7;
#pragma unroll
    for (int j = 0; j < 4; ++j) { const int n = (lane >> 3) + 8 * j; const LAS float* s = scr + (8 * c) * 33 + n;
        v4u o; o.x = pk2(s[0 * 33], s[1 * 33]); o.y = pk2(s[2 * 33], s[3 * 33]); o.z = pk2(s[4 * 33], s[5 * 33]); o.w = pk2(s[6 * 33], s[7 * 33]);
        *(GAS v4u*)(WT + (size_t)(n0p + n) * K + k0 + 8 * c) = o; }
    LDS_WAIT(); asm volatile("" ::: "memory");
}
__device__ __forceinline__ void rms_row_to_bf16(int lane, const float* xrow, const float* g, bf16* orow) {
    const GAS f32x4* xr = (const GAS f32x4*)xrow + lane;
    f32x4 v[4]; float s = 0.f;
#pragma unroll
    for (int j = 0; j < 4; ++j) { v[j] = xr[64 * j]; s += (v[j].x * v[j].x + v[j].y * v[j].y) + (v[j].z * v[j].z + v[j].w * v[j].w); }
    const float r = rsqrtf(wave_sum(s) * (1.f / DM) + RMS_EPS);
    GAS unsigned long long* o8 = (GAS unsigned long long*)orow + lane;
#pragma unroll
    for (int j = 0; j < 4; ++j) { const f32x4 gg = ((const GAS f32x4*)g)[lane + 64 * j];
        o8[64 * j] = (unsigned long long)pk2(v[j].x * r * gg.x, v[j].y * r * gg.y) | ((unsigned long long)pk2(v[j].z * r * gg.z, v[j].w * r * gg.w) << 32); }
}
__device__ __forceinline__ float2 rope_entry(int pos, int i) {
    const double inv[8] = {1.0, 0.19392274474868576, 0.03760603093086393, 0.007292664737217109, 0.001414213562373095, 0.0002742481756762073, 5.318295896944988e-05, 1.031338537721246e-05};
    double iv = inv[0];
#pragma unroll
    for (int k = 1; k < 8; ++k) iv = (i == k) ? inv[k] : iv;
    const double a = (double)pos * iv * 0.63661977236758134308;
    const double q = __builtin_rint(a);
    const double th = (a - q) * 1.57079632679489661923, t2 = th * th;
    const double sn = th * (1.0 + t2 * (-1.0 / 6 + t2 * (1.0 / 120 + t2 * (-1.0 / 5040 + t2 * (1.0 / 362880 + t2 * (-1.0 / 39916800 + t2 * (1.0 / 6227020800.0)))))));
    const double cs = 1.0 + t2 * (-0.5 + t2 * (1.0 / 24 + t2 * (-1.0 / 720 + t2 * (1.0 / 40320 + t2 * (-1.0 / 3628800 + t2 * (1.0 / 479001600.0 + t2 * (-1.0 / 87178291200.0)))))));
    const int qi = ((int)q) & 3;
    double c, s;
    if (qi == 0) { c = cs; s = sn; } else if (qi == 1) { c = -sn; s = cs; } else if (qi == 2) { c = -cs; s = -sn; } else { c = sn; s = -cs; }
    return make_float2((float)c, (float)s);
}
__device__ __forceinline__ void p0_prologue(Frame& F, const Ptrs& P) {
    unsigned char* ws = P.ws;
    LAS float* scr = (LAS float*)(F.lds + RING_OFF + F.wave * 16384);
    const int gw = F.vcu * NWAVES + F.wave, NGW = F.G * NWAVES;
    constexpr int I1 = 16 * 128, IO = 16 * 32, I2 = 16 * 192, I3 = 32 * 32, NITEMS = I1 + IO + I2 + I3;
    for (int it = gw; it < NITEMS; it += NGW) {
        int r = it;
        if (r < I1) { const int kb = r >> 7, n0p = (r & 127) * 32, rho = n0p & 255, n0l = (n0p & ~255) + 64 * ((rho >> 5) & 3) + 32 * (rho >> 7);
            p0_transpose_item(P.att_w_in, DM, ATT_IN, (bf16*)(ws + WS_W1T), n0p, n0l, kb * 64, scr, F.lane); continue; } r -= I1;
        if (r < IO) { const int kb = r >> 5, n0p = (r & 31) * 32; p0_transpose_item(P.att_w_out, DM, DM, (bf16*)(ws + WS_WOT), n0p, n0p, kb * 64, scr, F.lane); continue; } r -= IO;
        if (r < I2) { const int kb = r / 192, n0p = (r % 192) * 32, pn = n0p >> 8, rho = n0p & 255;
            const int n0l = (pn < 16) ? ((rho < 128) ? 128 * pn + rho : 4096 + 128 * pn + (rho - 128)) : 2048 + 256 * (pn - 16) + rho;
            p0_transpose_item(P.sgu_w_in, DM, SGU_IN, (bf16*)(ws + WS_W2T), n0p, n0l, kb * 64, scr, F.lane); continue; } r -= I2;
        { const int kb = r >> 5, n0p = (r & 31) * 32; p0_transpose_item(P.sgu_w_out, SGU_W, DM, (bf16*)(ws + WS_W3T), n0p, n0p, kb * 64, scr, F.lane); }
    }
    const int gt = gw * 64 + F.lane, NGT = NGW * 64;
    for (int i = gt; i < SEQ * 8; i += NGT) ((float2*)(ws + WS_ROPE))[i] = rope_entry(i >> 3, i & 7);
    for (int i = gt; i < 8 * 128 * 128; i += NGT) { const int t = (i >> 7) & 127, s = i & 127; ((bf16*)(ws + WS_WSB))[i] = (bf16)((s <= t) ? f2bf(P.w_s[i]) : 0u); }
    if (gt < 64) { float* gd = (float*)(ws + WS_GAIN); gd[gt] = P.dsw_qg[gt]; gd[64 + gt] = P.dsw_kg[gt]; gd[128 + gt] = P.diff_qg[gt]; gd[192 + gt] = P.diff_kg[gt]; }
    for (int m = gw; m < SEQ; m += NGW) rms_row_to_bf16(F.lane, P.x + (size_t)m * DM, P.att_norm, (bf16*)(ws + WS_XN) + (size_t)m * DM);
}

__device__ __forceinline__ void merge_row(const Ptrs& P, int t, int lane, float lam, bf16* yout) {
    unsigned char* ws = P.ws;
    bf16* G = (bf16*)(ws + WS_G) + (size_t)t * 1024 + lane * 16;
    const uint4 g0 = *(const uint4*)G, g1 = *(const uint4*)(G + 8);
    const unsigned gw[8] = {g0.x, g0.y, g0.z, g0.w, g1.x, g1.y, g1.z, g1.w};
    float y[16];
    if (lane < 32) {
        const int h = lane >> 2; const float* L = (const float*)(ws + WS_LSE);
        const float l0 = L[((size_t)0 * SEQ + t) * 8 + h], l1 = L[((size_t)1 * SEQ + t) * 8 + h], l2 = L[((size_t)2 * SEQ + t) * 8 + h];
        const float mx = fmaxf(l0, fmaxf(l1, l2)); float w0 = exp2f(l0 - mx), w1 = exp2f(l1 - mx), w2 = exp2f(l2 - mx); const float wi = 1.f / (w0 + w1 + w2); w0 *= wi; w1 *= wi; w2 *= wi;
        const bf16* O = (const bf16*)(ws + WS_OP) + (size_t)t * 512 + lane * 16;
        const float wt[3] = {w0, w1, w2};
#pragma unroll
        for (int i = 0; i < 16; ++i) y[i] = 0.f;
#pragma unroll
        for (int p = 0; p < 3; ++p) { const uint4 a = *(const uint4*)(O + (size_t)p * SEQ * 512), b = *(const uint4*)(O + (size_t)p * SEQ * 512 + 8);
            const unsigned ow[8] = {a.x, a.y, a.z, a.w, b.x, b.y, b.z, b.w};
#pragma unroll
            for (int i = 0; i < 8; ++i) { y[2 * i] += wt[p] * bf2f(ow[i] & 0xffffu); y[2 * i + 1] += wt[p] * bf2f(ow[i] >> 16); } }
    } else {
        const int cidx = (lane - 32) * 16;
        const bf16* A = (const bf16*)(ws + WS_DO0) + (size_t)t * 512 + cidx; const bf16* B = (const bf16*)(ws + WS_DO1) + (size_t)t * 512 + cidx;
        const uint4 a0 = *(const uint4*)A, a1 = *(const uint4*)(A + 8), b0 = *(const uint4*)B, b1 = *(const uint4*)(B + 8);
        const unsigned aw[8] = {a0.x, a0.y, a0.z, a0.w, a1.x, a1.y, a1.z, a1.w}, bw[8] = {b0.x, b0.y, b0.z, b0.w, b1.x, b1.y, b1.z, b1.w};
#pragma unroll
        for (int i = 0; i < 8; ++i) { y[2 * i] = bf2f(aw[i] & 0xffffu) - lam * bf2f(bw[i] & 0xffffu); y[2 * i + 1] = bf2f(aw[i] >> 16) - lam * bf2f(bw[i] >> 16); }
    }
    float ss = 0.f;
#pragma unroll
    for (int i = 0; i < 16; ++i) ss += y[i] * y[i];
    ss += __shfl_xor(ss, 1); ss += __shfl_xor(ss, 2); ss += __shfl_xor(ss, 4);
    if (lane >= 32) {
        const float r = rsqrtf(ss * (1.f / 128.f) + RMS_EPS) * (1.f - LAM_INIT);
        const float* sg = P.subln + ((lane - 32) & 7) * 16;
#pragma unroll
        for (int i = 0; i < 16; ++i) y[i] = y[i] * r * sg[i];
    }
    unsigned ow[8];
#pragma unroll
    for (int i = 0; i < 8; ++i) ow[i] = f2bf(y[2 * i] * bf2f(gw[i] & 0xffffu)) | (f2bf(y[2 * i + 1] * bf2f(gw[i] >> 16)) << 16);
    bf16* Y = yout + (size_t)t * 1024 + lane * 16;
    *(uint4*)Y = make_uint4(ow[0], ow[1], ow[2], ow[3]); *(uint4*)(Y + 8) = make_uint4(ow[4], ow[5], ow[6], ow[7]);
}
__device__ __forceinline__ float lam_value(const Ptrs& P, int lane) {
    const float a = wave_sum(P.lq1[lane] * P.lk1[lane]), b = wave_sum(P.lq2[lane] * P.lk2[lane]);
    return expf(a) - expf(b) + LAM_INIT;
}

typedef float f32x16 __attribute__((ext_vector_type(16)));
typedef short s16x4v __attribute__((ext_vector_type(4)));
__device__ __forceinline__ void sgu_phase(Frame& F, const Ptrs& P) {
    unsigned char* ws = P.ws;
    const int lane = F.lane, w = F.wave, r32 = lane & 31, hi = lane >> 5;
    const int n = F.vcu >> 1;
    typedef float f32x2s __attribute__((ext_vector_type(2)));
    LAS f32x2s* stt = (LAS f32x2s*)(F.lds + 131072);
    {
        const int row = 16 * w + (lane >> 2), part = lane & 3;
        const f32x4* sp = (const f32x4*)((const float2*)(ws + WS_STAT) + (size_t)(n * 128 + row) * 32 + part * 8);
        float s = 0.f, s2 = 0.f;
#pragma unroll
        for (int i = 0; i < 4; ++i) { const f32x4 v = sp[i]; s += v.x + v.z; s2 += v.y + v.w; }
        s += __shfl_xor(s, 1); s += __shfl_xor(s, 2); s2 += __shfl_xor(s2, 1); s2 += __shfl_xor(s2, 2);
        const float mu = s * (1.f / SGU_W), var = s2 * (1.f / SGU_W) - mu * mu;
        if (part == 0) stt[row] = (f32x2s){mu, rsqrtf(var + LN_EPS)};
    }
    __syncthreads();
    LAS unsigned char* wl = F.lds + w * 16384;
    const unsigned wl_addr = (unsigned)(uintptr_t)wl;
    const bf16* GV = (const bf16*)(ws + WS_GV); bf16* UG = (bf16*)(ws + WS_UG); const bf16* WSB = (const bf16*)(ws + WS_WSB);
    const int cc = (lane & 3) * 8, rq = lane >> 2, g0 = 4 * (F.vcu & 1);
    v4u gvr[8], ugr[8];
#pragma unroll
    for (int it = 0; it < 8; ++it) { const size_t off = (size_t)(n * 128 + 16 * it + rq) * SGU_W + g0 * 256 + 32 * w + cc; gvr[it] = *(const v4u*)(GV + off); ugr[it] = *(const v4u*)(UG + off); }
#pragma unroll 1
    for (int gi = 0; gi < 4; ++gi) {
        const int g = g0 + gi, c0 = g * 256 + 32 * w;
        {
            const f32x4 lg0 = *(const f32x4*)(P.ln_g + c0 + cc), lg1 = *(const f32x4*)(P.ln_g + c0 + cc + 4), lb0 = *(const f32x4*)(P.ln_b + c0 + cc), lb1 = *(const f32x4*)(P.ln_b + c0 + cc + 4);
#pragma unroll
            for (int it = 0; it < 8; ++it) {
                const int s = 16 * it + rq; const v4u raw = gvr[it];
                const f32x2s mr = stt[s];
                f32x4 a = {bf2f(raw.x & 0xffffu), bf2f(raw.x >> 16), bf2f(raw.y & 0xffffu), bf2f(raw.y >> 16)}, b = {bf2f(raw.z & 0xffffu), bf2f(raw.z >> 16), bf2f(raw.w & 0xffffu), bf2f(raw.w >> 16)};
                a = (a - mr.x) * mr.y * lg0 + lb0; b = (b - mr.x) * mr.y * lg1 + lb1;
                v4u o; o.x = pk2(a.x, a.y); o.y = pk2(a.z, a.w); o.z = pk2(b.x, b.y); o.w = pk2(b.z, b.w);
                *(LAS v4u*)(wl + s * 64 + cc * 2) = o;
            }
        }
        if (gi < 3) {
#pragma unroll
            for (int it = 0; it < 8; ++it) gvr[it] = *(const v4u*)(GV + (size_t)(n * 128 + 16 * it + rq) * SGU_W + c0 + 256 + cc);
        }
        LDS_WAIT(); asm volatile("" ::: "memory");
        bf16x8 bfr[8];
        {
            const unsigned va = wl_addr + (unsigned)((8 * hi + ((lane & 15) >> 2)) * 64 + ((lane >> 4) & 1) * 32 + (lane & 3) * 8);
#pragma unroll
            for (int ks = 0; ks < 8; ++ks) { s16x4v lo, hh;
                asm volatile("ds_read_b64_tr_b16 %0,%1 offset:%c2" : "=&v"(lo) : "v"(va), "i"(ks * 1024) : "memory");
                asm volatile("ds_read_b64_tr_b16 %0,%1 offset:%c2" : "=&v"(hh) : "v"(va), "i"(ks * 1024 + 256) : "memory");
                asm volatile("s_waitcnt lgkmcnt(0)" : "+v"(lo), "+v"(hh) :: "memory");
                bfr[ks] = (bf16x8){lo[0], lo[1], lo[2], lo[3], hh[0], hh[1], hh[2], hh[3]}; }
        }
        __builtin_amdgcn_sched_barrier(0);
        f32x16 acc[4];
#pragma unroll
        for (int i = 0; i < 4; ++i) {
            acc[i] = f32x16{};
            const bf16* wrow = WSB + ((size_t)g * 128 + 32 * i + r32) * 128 + 8 * hi;
#pragma unroll
            for (int ks = 0; ks < 2 * i + 2; ++ks) { const bf16x8 af = *(const bf16x8*)(wrow + 16 * ks); acc[i] = __builtin_amdgcn_mfma_f32_32x32x16_bf16(af, bfr[ks], acc[i], 0, 0, 0); }
            __builtin_amdgcn_sched_barrier(0);
        }
#pragma unroll
        for (int i = 0; i < 4; ++i)
#pragma unroll
            for (int rr = 0; rr < 16; ++rr) { const int t = 32 * i + (rr & 3) + 8 * (rr >> 2) + 4 * hi; *(LAS float*)(wl + t * 128 + r32 * 4) = acc[i][rr]; }
        LDS_WAIT(); asm volatile("" ::: "memory");
#pragma unroll
        for (int it = 0; it < 8; ++it) {
            const int t = 16 * it + rq; bf16* up = UG + (size_t)(n * 128 + t) * SGU_W + c0 + cc;
            const float bs = P.b_s[g * 128 + t];
            const v4u raw = ugr[it]; const f32x4 s0 = *(LAS f32x4*)(wl + t * 128 + cc * 4) + bs, s1 = *(LAS f32x4*)(wl + t * 128 + cc * 4 + 16) + bs;
            v4u o; o.x = pk2(bf2f(raw.x & 0xffffu) * s0.x, bf2f(raw.x >> 16) * s0.y); o.y = pk2(bf2f(raw.y & 0xffffu) * s0.z, bf2f(raw.y >> 16) * s0.w);
            o.z = pk2(bf2f(raw.z & 0xffffu) * s1.x, bf2f(raw.z >> 16) * s1.y); o.w = pk2(bf2f(raw.w & 0xffffu) * s1.z, bf2f(raw.w >> 16) * s1.w);
            *(v4u*)up = o;
        }
        if (gi < 3) {
#pragma unroll
            for (int it = 0; it < 8; ++it) ugr[it] = *(const v4u*)(UG + (size_t)(n * 128 + 16 * it + rq) * SGU_W + c0 + 256 + cc);
        }
        LDS_WAIT(); asm volatile("" ::: "memory");
    }
}

struct Args { Ptrs p; int ph_lo, ph_hi, li, pad; };
__global__ void __launch_bounds__(NWAVES * 64, 2) mega_fwd(Args args) {
    extern __shared__ __attribute__((aligned(16))) unsigned char lds[];
    Frame F;
    F.lds = (LAS unsigned char*)lds;
    F.MISC = (volatile LAS unsigned*)(F.lds + MISC_OFF);
    F.wave = __builtin_amdgcn_readfirstlane((int)threadIdx.x >> 6); F.lane = opaque_lane(); F.tid = F.wave * 64 + F.lane;
    F.G = gridDim.x; { const int bx = blockIdx.x; F.vcu = (F.G % 8 == 0) ? (bx % 8) * (F.G / 8) + bx / 8 : bx; }
    const Ptrs& P = args.p;
    unsigned char* ws = P.ws;
    F.ctl = (gu32*)(ws + WS_CTL);
    for (int u = F.tid; u < (LDS_BYTES - LDSCTL_OFF) / 4; u += NWAVES * 64) ((LAS unsigned*)(F.lds + LDSCTL_OFF))[u] = 0u;
    __syncthreads();
    const int lo = args.ph_lo, hi = args.ph_hi;
    XcdBarrier bar; bar.bar = (unsigned*)(F.ctl + CW_BAR) + args.li * XCD_BAR_WORDS; bar.x = 0; bar.st = nullptr;
    if (hi - lo > 1) bar = xcd_barrier_post((unsigned*)(F.ctl + CW_BAR) + args.li * XCD_BAR_WORDS, F.MISC + 8);
    bar.wave = F.wave;
#ifndef PH_EN
#define PH_EN 0x1FF
#endif
#define IN(k) (((PH_EN >> (k)) & 1) && lo <= (k) && (k) < hi)
#ifndef REPEAT_PHASE
#define REPEAT_PHASE -1
#endif
#define REP(k) for (int rep_ = 0; rep_ < ((REPEAT_PHASE == (k)) ? 2 : 1); ++rep_, (rep_ < ((REPEAT_PHASE == (k)) ? 2 : 1) ? xcd_barrier(bar) : (void)0))
#define SEAM(k) do { if (IN(k) && IN((k) + 1)) xcd_barrier(bar); { F.lane = opaque_lane(); F.tid = F.wave * 64 + F.lane; } } while (0)

    if (IN(0)) REP(0) { p0_prologue(F, P); }
    SEAM(0);
    if (IN(1)) REP(1) {
        pg8::Gemm g{(const bf16*)(ws + WS_XN), (const bf16*)(ws + WS_W1T), SEQ, ATT_IN, DM}; pg8::StaticOrder S; S.init(SEQ, ATT_IN, F.G, (int)blockIdx.x);
        pg8::EpiProj1 E{ws};
        pg8::gemm_phase<pg8::EpiProj1, pg8::StaticOrder, PG8_ALIGN, PG8_SP2>(F.lds + RING_OFF, g, S, E, F.wave);
    }
    SEAM(1);
    if (IN(2)) REP(2) {
        using abf = attn_body::bf16;
        const attn_body::AttnArgs A{(const abf*)(ws + WS_QD), (const abf*)(ws + WS_KD), (const abf*)(ws + WS_VD), (abf*)(ws + WS_DO0), (abf*)(ws + WS_DO1),
                                    (const abf*)(ws + WS_QA), (const abf*)(ws + WS_KA), (const abf*)(ws + WS_VA), (abf*)(ws + WS_OP), (float*)(ws + WS_LSE)};
        attn_body::attn_phase_all<8>((char*)lds + RING_OFF, A, F.vcu, F.wave);
    }
    SEAM(2);
    if (IN(3)) REP(3) {
        const float lam = lam_value(P, F.lane);
        for (int t = F.vcu * NWAVES + F.wave; t < SEQ; t += F.G * NWAVES) merge_row(P, t, F.lane, lam, (bf16*)(ws + ((REPEAT_PHASE == 3 && rep_ == 0) ? WS_QA : WS_G)));
    }
    SEAM(3);
    if (IN(4)) REP(4) {
        pg8::Gemm g{(const bf16*)(ws + WS_G), (const bf16*)(ws + WS_WOT), SEQ, DM, DM}; pg8::StaticOrder S; S.init(SEQ, DM, F.G, (int)blockIdx.x);
        pg8::EpiRes E{P.x, P.out};
        pg8::gemm_phase<pg8::EpiRes, pg8::StaticOrder, false, PG8_SP2>(F.lds + RING_OFF, g, S, E, F.wave);
    }
    SEAM(4);
    if (IN(5)) REP(5) {
        for (int m = F.vcu * NWAVES + F.wave; m < SEQ; m += F.G * NWAVES) rms_row_to_bf16(F.lane, P.out + (size_t)m * DM, P.sgu_norm, (bf16*)(ws + WS_XN) + (size_t)m * DM);
    }
    SEAM(5);
    if (IN(6)) REP(6) {
        pg8::Gemm g{(const bf16*)(ws + WS_XN), (const bf16*)(ws + WS_W2T), SEQ, SGU_IN, DM}; pg8::StaticOrder S; S.init(SEQ, SGU_IN, F.G, (int)blockIdx.x);
        pg8::EpiProj2 E{ws};
        pg8::gemm_phase<pg8::EpiProj2, pg8::StaticOrder, PG8_ALIGN, PG8_SP2>(F.lds + RING_OFF, g, S, E, F.wave);
    }
    SEAM(6);
    if (IN(7)) REP(7) { sgu_phase(F, P); }
    SEAM(7);
    if (IN(8)) REP(8) {
        pg8::Gemm g{(const bf16*)(ws + WS_UG), (const bf16*)(ws + WS_W3T), SEQ, DM, SGU_W}; pg8::StaticOrder S; S.init(SEQ, DM, F.G, (int)blockIdx.x);
        pg8::EpiRes E{P.out, (REPEAT_PHASE == 8 && rep_ == 0) ? (float*)(ws + WS_GV) : P.out};
        pg8::gemm_phase<pg8::EpiRes, pg8::StaticOrder, false, PG8_SP2>(F.lds + RING_OFF, g, S, E, F.wave);
    }
#undef IN
#undef SEAM
}
#if DEBUG_NAIVE
__global__ void k_rope(float2* tab) {
    const int idx = blockIdx.x * blockDim.x + threadIdx.x; if (idx >= SEQ * 8) return;
    const int pos = idx >> 3, i = idx & 7;
    const double inv[8] = {1.0, 0.19392274474868576, 0.03760603093086393, 0.007292664737217109, 0.001414213562373095, 0.0002742481756762073, 5.318295896944988e-05, 1.031338537721246e-05};
    double iv = inv[0];
#pragma unroll
    for (int k = 1; k < 8; ++k) iv = (i == k) ? inv[k] : iv;
    const double ang = (double)pos * iv;
    const double a = ang * 0.63661977236758134308;
    const double q = __builtin_rint(a);
    const double th = (a - q) * 1.57079632679489661923;
    const double t2 = th * th;
    double sn = th * (1.0 + t2 * (-1.0 / 6 + t2 * (1.0 / 120 + t2 * (-1.0 / 5040 + t2 * (1.0 / 362880 + t2 * (-1.0 / 39916800 + t2 * (1.0 / 6227020800.0)))))));
    double cs = 1.0 + t2 * (-0.5 + t2 * (1.0 / 24 + t2 * (-1.0 / 720 + t2 * (1.0 / 40320 + t2 * (-1.0 / 3628800 + t2 * (1.0 / 479001600.0 + t2 * (-1.0 / 87178291200.0)))))));
    const int qi = ((int)q) & 3;
    double c, s;
    if (qi == 0) { c = cs; s = sn; } else if (qi == 1) { c = -sn; s = cs; } else if (qi == 2) { c = -cs; s = -sn; } else { c = sn; s = -cs; }
    tab[idx] = make_float2((float)c, (float)s);
}

__global__ void __launch_bounds__(256) k_rmsnorm(const float* x, const float* g, bf16* out) {
    const int row = blockIdx.x * 4 + (threadIdx.x >> 6), lane = threadIdx.x & 63;
    const f32x4* xr = (const f32x4*)(x + (size_t)row * DM) + lane;
    f32x4 v[4]; float s = 0.f;
#pragma unroll
    for (int j = 0; j < 4; ++j) { v[j] = xr[64 * j]; s += (v[j].x * v[j].x + v[j].y * v[j].y) + (v[j].z * v[j].z + v[j].w * v[j].w); }
    const float r = rsqrtf(wave_sum(s) * (1.f / DM) + RMS_EPS);
    unsigned long long* o8 = (unsigned long long*)(out + (size_t)row * DM) + lane;
#pragma unroll
    for (int j = 0; j < 4; ++j) { const f32x4 gg = ((const f32x4*)g)[lane + 64 * j];
        const unsigned lo = f2bf(v[j].x * r * gg.x) | (f2bf(v[j].y * r * gg.y) << 16), hi = f2bf(v[j].z * r * gg.z) | (f2bf(v[j].w * r * gg.w) << 16);
        o8[64 * j] = (unsigned long long)lo | ((unsigned long long)hi << 32); }
}

template <int MODE> __global__ void __launch_bounds__(256) k_ngemm(const bf16* A, int lda, const float* B, int N, int K, Ptrs P) {
    __shared__ float As[16][68];
    __shared__ float Bs[16][68];
    __shared__ float Bs2[16][68];
    __shared__ float T[64][65];
    __shared__ float T2[64][65];
    __shared__ float rinv[64];
    constexpr bool DUAL = (MODE == 3);
    const int tid = threadIdx.x, tx = tid & 15, ty = tid >> 4;
    const int row0 = blockIdx.y * 64, grp = blockIdx.x;
    int col0 = grp * 64, col0b = 0;
    bool dual = false;
    if (MODE == 3) { if (grp < 32) { col0 = grp * 64; col0b = 4096 + grp * 64; dual = true; } else { col0 = 2048 + (grp - 32) * 64; } }
    float acc[4][4], acc2[4][4];
#pragma unroll
    for (int i = 0; i < 4; ++i)
#pragma unroll
        for (int j = 0; j < 4; ++j) { acc[i][j] = 0.f; acc2[i][j] = 0.f; }
    for (int k0 = 0; k0 < K; k0 += 16) {
        { const int r = tid >> 2, kk = (tid & 3) * 4; const uint2 a = *(const uint2*)(A + (size_t)(row0 + r) * lda + k0 + kk);
          As[kk + 0][r] = bf2f(a.x & 0xffffu); As[kk + 1][r] = bf2f(a.x >> 16); As[kk + 2][r] = bf2f(a.y & 0xffffu); As[kk + 3][r] = bf2f(a.y >> 16); }
        { const int kk = tid >> 4, c = (tid & 15) * 4; const f32x4 b = *(const f32x4*)(B + (size_t)(k0 + kk) * N + col0 + c);
          Bs[kk][c] = b.x; Bs[kk][c + 1] = b.y; Bs[kk][c + 2] = b.z; Bs[kk][c + 3] = b.w;
          if (DUAL && dual) { const f32x4 b2 = *(const f32x4*)(B + (size_t)(k0 + kk) * N + col0b + c); Bs2[kk][c] = b2.x; Bs2[kk][c + 1] = b2.y; Bs2[kk][c + 2] = b2.z; Bs2[kk][c + 3] = b2.w; } }
        __syncthreads();
#pragma unroll
        for (int k = 0; k < 16; ++k) {
            float a[4], b[4], b2[4];
#pragma unroll
            for (int i = 0; i < 4; ++i) { a[i] = As[k][ty * 4 + i]; b[i] = Bs[k][tx * 4 + i]; b2[i] = DUAL ? Bs2[k][tx * 4 + i] : 0.f; }
#pragma unroll
            for (int i = 0; i < 4; ++i)
#pragma unroll
                for (int j = 0; j < 4; ++j) { acc[i][j] += a[i] * b[j]; if (DUAL) acc2[i][j] += a[i] * b2[j]; }
        }
        __syncthreads();
    }
#pragma unroll
    for (int i = 0; i < 4; ++i)
#pragma unroll
        for (int j = 0; j < 4; ++j) { T[ty * 4 + i][tx * 4 + j] = acc[i][j]; if (DUAL) T2[ty * 4 + i][tx * 4 + j] = acc2[i][j]; }
    __syncthreads();
    unsigned char* ws = P.ws;
    if (MODE == 1) {
        const int type = grp >> 3, hd = grp & 7;
        const bool isq = (type == 0 || type == 4), isk = (type == 1 || type == 5), isg = (type == 3 || type == 7);
        const float* gain = (type == 0) ? P.dsw_qg : (type == 1) ? P.dsw_kg : (type == 4) ? P.diff_qg : P.diff_kg;
        if (isq || isk) {
            if (tid < 64) { float ss = 0.f; for (int j = 0; j < 64; ++j) ss += T[tid][j] * T[tid][j]; rinv[tid] = rsqrtf(ss * (1.f / 64.f) + RMS_EPS); }
            __syncthreads();
        }
        bf16* dst; int pitch, cb;
        if (type == 0) { dst = (bf16*)(ws + WS_QA); pitch = 512; cb = hd * 64; } else if (type == 1) { dst = (bf16*)(ws + WS_KA); pitch = 512; cb = hd * 64; }
        else if (type == 2) { dst = (bf16*)(ws + WS_VA); pitch = 512; cb = hd * 64; } else if (type == 3) { dst = (bf16*)(ws + WS_G); pitch = 1024; cb = hd * 64; }
        else if (type == 4) { dst = (bf16*)(ws + WS_QD); pitch = 512; cb = hd * 64; } else if (type == 5) { dst = (bf16*)(ws + WS_KD); pitch = 512; cb = hd * 64; }
        else if (type == 6) { dst = (bf16*)(ws + WS_VD); pitch = 512; cb = hd * 64; } else { dst = (bf16*)(ws + WS_G); pitch = 1024; cb = 512 + hd * 64; }
        const float2* tab = (const float2*)(ws + WS_ROPE);
        const int r = tid >> 2;
        for (int jj = 0; jj < 16; ++jj) {
            const int j = (tid & 3) * 16 + jj; float val = T[r][j];
            if (isq || isk) {
                const float ri = rinv[r];
                val = val * ri * gain[j];
                if (j < 16) { const int i = j & 7; const float2 cs = tab[(size_t)(row0 + r) * 8 + i];
                    const float x1 = T[r][i] * ri * gain[i], x2 = T[r][i + 8] * ri * gain[i + 8];
                    val = (j < 8) ? (x1 * cs.x - x2 * cs.y) : (x2 * cs.x + x1 * cs.y); }
                if (isq) val *= C2;
            } else if (isg) val = silu_f(val);
            dst[(size_t)(row0 + r) * pitch + cb + j] = (bf16)f2bf(val);
        }
    } else if (MODE == 2) {
        const int r = tid >> 2;
        for (int jj = 0; jj < 16; ++jj) { const int j = (tid & 3) * 16 + jj; const size_t o = (size_t)(row0 + r) * DM + col0 + j; P.out[o] = P.x[o] + T[r][j]; }
    } else if (MODE == 3) {
        const int r = tid >> 2;
        if (dual) {
            bf16* ug = (bf16*)(ws + WS_UG);
            for (int jj = 0; jj < 16; ++jj) { const int j = (tid & 3) * 16 + jj; ug[(size_t)(row0 + r) * SGU_W + col0 + j] = (bf16)f2bf(gelu_f(T[r][j]) * silu_f(T2[r][j])); }
        } else {
            bf16* gv = (bf16*)(ws + WS_GV);
            for (int jj = 0; jj < 16; ++jj) { const int j = (tid & 3) * 16 + jj; const float v = gelu_f(T[r][j]); T[r][j] = v; gv[(size_t)(row0 + r) * SGU_W + (col0 - 2048) + j] = (bf16)f2bf(v); }
            __syncthreads();
            if (tid < 64) { float s = 0.f, s2 = 0.f; for (int j = 0; j < 64; ++j) { const float v = T[tid][j]; s += v; s2 += v * v; }
                ((float2*)(ws + WS_STAT))[(size_t)(row0 + tid) * 32 + (grp - 32)] = make_float2(s, s2); }
        }
    } else {
        const int r = tid >> 2;
        for (int jj = 0; jj < 16; ++jj) { const int j = (tid & 3) * 16 + jj; const size_t o = (size_t)(row0 + r) * DM + col0 + j; P.out[o] = P.out[o] + T[r][j]; }
    }
}

__global__ void __launch_bounds__(256) k_ndsw(Ptrs P) {
    const int w = blockIdx.x * 4 + (threadIdx.x >> 6), lane = threadIdx.x & 63;
    const int p = w / (SEQ * 8), rem = w % (SEQ * 8), t = rem >> 3, h = rem & 7;
    const int dil = (p == 0) ? 1 : (p == 1) ? 4 : 16;
    const bf16* QA = (const bf16*)(P.ws + WS_QA); const bf16* KA = (const bf16*)(P.ws + WS_KA); const bf16* VA = (const bf16*)(P.ws + WS_VA);
    const float q = bf2f(QA[(size_t)t * 512 + h * 64 + lane]);
    float m = -INFINITY, l = 0.f, o = 0.f;
    for (int j = 0; j <= 128; ++j) {
        const int tk = t - j * dil; if (tk < 0) break;
        const float s = wave_sum(q * bf2f(KA[(size_t)tk * 512 + h * 64 + lane]));
        const float mn = fmaxf(m, s), a = exp2f(m - mn), pe = exp2f(s - mn);
        l = l * a + pe; o = o * a + pe * bf2f(VA[(size_t)tk * 512 + h * 64 + lane]); m = mn;
    }
    ((bf16*)(P.ws + WS_OP))[((size_t)p * SEQ + t) * 512 + h * 64 + lane] = (bf16)f2bf(o / l);
    if (lane == 0) ((float*)(P.ws + WS_LSE))[((size_t)p * SEQ + t) * 8 + h] = m + log2f(l);
}
__global__ void __launch_bounds__(256) k_ndiff(Ptrs P) {
    const int w = blockIdx.x * 4 + (threadIdx.x >> 6), lane = threadIdx.x & 63;
    const int t = SEQ - 1 - (w >> 3), vq = w & 7, h = vq >> 1, c = vq & 1;
    const bf16* QD = (const bf16*)(P.ws + WS_QD); const bf16* KD = (const bf16*)(P.ws + WS_KD); const bf16* VD = (const bf16*)(P.ws + WS_VD);
    const float q = bf2f(QD[(size_t)t * 512 + vq * 64 + lane]);
    float m = -INFINITY, l = 0.f, o0 = 0.f, o1 = 0.f;
    int tk = 0;
    for (; tk + 3 <= t; tk += 4) {
        float s[4];
#pragma unroll
        for (int u = 0; u < 4; ++u) s[u] = q * bf2f(KD[(size_t)(tk + u) * 512 + vq * 64 + lane]);
#pragma unroll
        for (int o = 1; o < 64; o <<= 1) {
#pragma unroll
            for (int u = 0; u < 4; ++u) s[u] += __shfl_xor(s[u], o); }
        const float mn = fmaxf(fmaxf(m, fmaxf(s[0], s[1])), fmaxf(s[2], s[3])), a = exp2f(m - mn);
        l *= a; o0 *= a; o1 *= a; m = mn;
#pragma unroll
        for (int u = 0; u < 4; ++u) { const float pe = exp2f(s[u] - mn); l += pe;
            o0 += pe * bf2f(VD[(size_t)(tk + u) * 512 + h * 128 + lane]); o1 += pe * bf2f(VD[(size_t)(tk + u) * 512 + h * 128 + 64 + lane]); }
    }
    for (; tk <= t; ++tk) {
        const float s = wave_sum(q * bf2f(KD[(size_t)tk * 512 + vq * 64 + lane]));
        const float mn = fmaxf(m, s), a = exp2f(m - mn), pe = exp2f(s - mn);
        l = l * a + pe; o0 = o0 * a + pe * bf2f(VD[(size_t)tk * 512 + h * 128 + lane]); o1 = o1 * a + pe * bf2f(VD[(size_t)tk * 512 + h * 128 + 64 + lane]); m = mn;
    }
    bf16* O = (bf16*)(P.ws + (c ? WS_DO1 : WS_DO0));
    O[(size_t)t * 512 + h * 128 + lane] = (bf16)f2bf(o0 / l); O[(size_t)t * 512 + h * 128 + 64 + lane] = (bf16)f2bf(o1 / l);
}

__global__ void __launch_bounds__(256) k_merge(Ptrs P) {
    const int t = blockIdx.x * 4 + (threadIdx.x >> 6), lane = threadIdx.x & 63;
    const float lam = lam_value(P, lane);
    merge_row(P, t, lane, lam, (bf16*)(P.ws + WS_G));
}

__global__ void k_nstats(Ptrs P) {
    const int t = blockIdx.x * blockDim.x + threadIdx.x; if (t >= SEQ) return;
    const float2* st = (const float2*)(P.ws + WS_STAT) + (size_t)t * 32; float s = 0.f, s2 = 0.f;
    for (int i = 0; i < 32; ++i) { s += st[i].x; s2 += st[i].y; }
    const float mu = s * (1.f / SGU_W), var = s2 * (1.f / SGU_W) - mu * mu;
    ((float2*)(P.ws + WS_MUR))[t] = make_float2(mu, rsqrtf(var + LN_EPS));
}
__global__ void __launch_bounds__(256) k_nsgu(Ptrs P) {
    const int n = blockIdx.x >> 3, g = blockIdx.x & 7, c = g * 256 + threadIdx.x;
    const bf16* GV = (const bf16*)(P.ws + WS_GV); bf16* UG = (bf16*)(P.ws + WS_UG); const float2* mur = (const float2*)(P.ws + WS_MUR);
    const float lg = P.ln_g[c], lb = P.ln_b[c];
    for (int t = 0; t < 128; ++t) {
        const float* wrow = P.w_s + ((size_t)g * 128 + t) * 128; float acc = 0.f;
        for (int s = 0; s <= t; ++s) { const float2 mr = mur[n * 128 + s]; const float vn = (bf2f(GV[(size_t)(n * 128 + s) * SGU_W + c]) - mr.x) * mr.y * lg + lb; acc += wrow[s] * vn; }
        acc += P.b_s[g * 128 + t];
        const size_t o = (size_t)(n * 128 + t) * SGU_W + c;
        UG[o] = (bf16)f2bf(bf2f(UG[o]) * acc);
    }
}

#endif
#ifndef FAST_MASK
#define FAST_MASK 0x1FF
#endif
extern "C" void kernel_launch(void* const* d_in, const int* in_sizes, int n_in, void* d_out, int out_size, void* d_ws, size_t ws_size, hipStream_t stream) {
    static int grid = 0;
    if (grid == 0) {
        if (n_in != 20 || in_sizes[0] != SEQ * DM || out_size != SEQ * DM || ws_size < WS_END) { fprintf(stderr, "kernel_launch: unexpected shapes (n_in %d out %d ws %zu); nothing launched\n", n_in, out_size, ws_size); grid = -1; return; }
        int dev = 0, cus = 0, per_cu = 0;
        if (hipGetDevice(&dev) != hipSuccess || hipDeviceGetAttribute(&cus, hipDeviceAttributeMultiprocessorCount, dev) != hipSuccess) { grid = -1; return; }
        if (hipFuncSetAttribute((const void*)mega_fwd, hipFuncAttributeMaxDynamicSharedMemorySize, LDS_BYTES) != hipSuccess) { fprintf(stderr, "kernel_launch: hipFuncSetAttribute failed\n"); grid = -1; return; }
        if (hipOccupancyMaxActiveBlocksPerMultiprocessor(&per_cu, (const void*)mega_fwd, NWAVES * 64, LDS_BYTES) != hipSuccess || per_cu < 1) fprintf(stderr, "kernel_launch: occupancy query reports %d blocks per CU\n", per_cu);
        (void)hipGetLastError();
        grid = cus;
        if (grid != 256) { fprintf(stderr, "kernel_launch: this kernel needs a 256-CU device (got %d)\n", grid); grid = -1; return; }
    }
    if (grid < 0) return;
    if (hipMemsetAsync((char*)d_ws + WS_CTL, 0, CTL_ZERO_BYTES, stream) != hipSuccess) return;
    Args a{};
    { const float** pp = (const float**)&a.p; for (int i = 0; i < 20; ++i) pp[i] = (const float*)d_in[i]; }
    a.p.out = (float*)d_out; a.p.ws = (unsigned char*)d_ws;
    const unsigned mask = FAST_MASK;
    int li = 0;
#if DEBUG_NAIVE
    const Ptrs P = a.p; unsigned char* ws = P.ws;
    if (mask && !(mask & 1u)) { a.ph_lo = 0; a.ph_hi = 1; a.li = li++; hipLaunchKernelGGL(mega_fwd, dim3(grid), dim3(NWAVES * 64), LDS_BYTES, stream, a); }
#endif
    for (int k = 0; k < N_PHASES;) {
        if (mask & (1u << k)) {
            int e = k; while (e < N_PHASES && (mask & (1u << e))) ++e;
            a.ph_lo = k; a.ph_hi = e; a.li = li++;
            hipLaunchKernelGGL(mega_fwd, dim3(grid), dim3(NWAVES * 64), LDS_BYTES, stream, a);
            k = e; continue;
        }
#if DEBUG_NAIVE
        switch (k) {
            case 0: k_rope<<<SEQ * 8 / 256, 256, 0, stream>>>((float2*)(ws + WS_ROPE)); k_rmsnorm<<<SEQ / 4, 256, 0, stream>>>(P.x, P.att_norm, (bf16*)(ws + WS_XN)); break;
            case 1: k_ngemm<1><<<dim3(64, SEQ / 64), 256, 0, stream>>>((const bf16*)(ws + WS_XN), DM, P.att_w_in, ATT_IN, DM, P); break;
            case 2: k_ndsw<<<3 * SEQ * 8 / 4, 256, 0, stream>>>(P); k_ndiff<<<SEQ * 8 / 4, 256, 0, stream>>>(P); break;
            case 3: k_merge<<<SEQ / 4, 256, 0, stream>>>(P); break;
            case 4: k_ngemm<2><<<dim3(16, SEQ / 64), 256, 0, stream>>>((const bf16*)(ws + WS_G), DM, P.att_w_out, DM, DM, P); break;
            case 5: k_rmsnorm<<<SEQ / 4, 256, 0, stream>>>(P.out, P.sgu_norm, (bf16*)(ws + WS_XN)); break;
            case 6: k_ngemm<3><<<dim3(64, SEQ / 64), 256, 0, stream>>>((const bf16*)(ws + WS_XN), DM, P.sgu_w_in, SGU_IN, DM, P); break;
            case 7: k_nstats<<<SEQ / 256, 256, 0, stream>>>(P); k_nsgu<<<128 * 8, 256, 0, stream>>>(P); break;
            case 8: k_ngemm<4><<<dim3(16, SEQ / 64), 256, 0, stream>>>((const bf16*)(ws + WS_UG), SGU_W, P.sgu_w_out, DM, SGU_W, P); break;
        }
#endif
        ++k;
    }
}
```

```cpp
#include <hip/hip_runtime.h>
#include <hip/hip_bf16.h>
#include <cstdint>
#include <cstdio>
#include <cmath>

constexpr int SEQ = 16384, DM = 1024;
constexpr int ATT_IN = 4096, SGU_W = 2048, SGU_IN = 6144;
constexpr float RMS_EPS = 1e-6f, LN_EPS = 1e-5f;
constexpr float C2 = 0.18033688011112042f;
constexpr float LAM_INIT = 0.2f;

typedef unsigned short bf16;
typedef float f32x4 __attribute__((ext_vector_type(4)));

constexpr size_t MiB = 1u << 20;
constexpr size_t WS_CTL = 0, CTL_ZERO_BYTES = 1 * MiB;
constexpr size_t WS_ROPE = 1 * MiB;
constexpr size_t WS_W1T = 2 * MiB, WS_WOT = 10 * MiB, WS_W2T = 12 * MiB, WS_W3T = 24 * MiB;
constexpr size_t WS_STAT = 28 * MiB;
constexpr size_t WS_XN = 32 * MiB;
constexpr size_t WS_DO0 = 32 * MiB, WS_DO1 = 48 * MiB;
constexpr size_t WS_QA = 64 * MiB, WS_KA = 80 * MiB, WS_VA = 96 * MiB, WS_QD = 112 * MiB, WS_KD = 128 * MiB, WS_VD = 144 * MiB;
constexpr size_t WS_G = 160 * MiB;
constexpr size_t WS_OP = 192 * MiB;
constexpr size_t WS_LSE = 240 * MiB;
constexpr size_t WS_MUR = 242 * MiB;
constexpr size_t WS_WSB = 243 * MiB;
constexpr size_t WS_GAIN = 243 * MiB + 262144;
constexpr size_t WS_UG = 64 * MiB;
constexpr size_t WS_GV = 128 * MiB;
constexpr size_t WS_END = 256 * MiB;

__device__ __forceinline__ float bf2f(unsigned h) { return __builtin_bit_cast(float, h << 16); }
__device__ __forceinline__ float wave_sum(float v) {
#pragma unroll
    for (int o = 1; o < 64; o <<= 1) v += __shfl_xor(v, o);
    return v;
}
__device__ __forceinline__ float silu_f(float v) { return v / (1.f + __expf(-v)); }
__device__ __forceinline__ float gelu_f(float v) { return 0.5f * v * (1.f + erff(v * 0.70710678118654752f)); }

__device__ __forceinline__ int opaque_lane() { unsigned m = ~0u; asm volatile("" : "+s"(m)); return (int)__builtin_amdgcn_mbcnt_hi(m, __builtin_amdgcn_mbcnt_lo(m, 0u)); }

struct Ptrs {
    const float* x; const float* att_norm; const float* att_w_in; const float* dsw_qg; const float* dsw_kg; const float* diff_qg; const float* diff_kg;
    const float* lq1; const float* lk1; const float* lq2; const float* lk2; const float* subln; const float* att_w_out;
    const float* sgu_norm; const float* sgu_w_in; const float* ln_g; const float* ln_b; const float* w_s; const float* b_s; const float* sgu_w_out;
    float* out; unsigned char* ws;
};
#define FAST_MASK 0x1FF
#define DEBUG_NAIVE 0

namespace pg8 {
#define PG8_LAS __attribute__((address_space(3)))
typedef unsigned short bf16_t;
typedef short bf16x8 __attribute__((ext_vector_type(8)));
typedef float f32x4 __attribute__((ext_vector_type(4)));
typedef unsigned u32x4 __attribute__((ext_vector_type(4)));
constexpr int BM = 256, BK = 64, HALF = 128, HTB = HALF * BK * 2  , STAGE_BYTES = 8 * HTB, NXCD = 8, WGM = 8;

__host__ __device__ __forceinline__ int lds_byte(int r, int c) { const int st = (r >> 4) * 2 + (c >> 5), rr = r & 15, cc = c & 31, ob = rr * 64 + cc * 2; return st * 1024 + (ob ^ (((ob >> 9) & 1) << 5)); }
__host__ __device__ __forceinline__ void stage_rc(int b, int& R, int& C) { const int st = b / 1024, sb = b % 1024, swz = sb ^ (((sb >> 9) & 1) << 5); R = (st >> 1) * 16 + swz / 64; C = (st & 1) * 32 + (swz % 64) / 2; }
__host__ __device__ __forceinline__ int perm32(int rho) { const int n = rho >> 4, i = rho & 15; return 8 * (i >> 2) + 4 * n + (i & 3); }

struct Unit { int pm, pn; };
struct Gemm { const bf16_t* A; const bf16_t* Bt; int M, N, K; };

struct StaticOrder {
    int nM, nN, nwg, G, c;
    __host__ __device__ void init(int M, int N, int G_, int c_) { nM = M / BM; nN = N / BM; nwg = nM * nN; G = G_; c = c_; }
    __host__ __device__ bool next(int i, Unit& u) const {
        const long L = (long)i * G + c; if (L >= nwg) return false;
        int wgid = (int)L; { const int q = nwg / NXCD, r = nwg % NXCD, xcd = wgid % NXCD, off = wgid / NXCD; wgid = (xcd < r ? xcd * (q + 1) : r * (q + 1) + (xcd - r) * q) + off; }
        const int nig = WGM * nN, gid = wgid / nig, fm = gid * WGM, gsz = (nM - fm) < WGM ? (nM - fm) : WGM;
        u.pm = fm + ((wgid % nig) % gsz); u.pn = (wgid % nig) / gsz; return true;
    }
    __device__ __forceinline__ void a_ready(const Unit&) const {}
    __device__ __forceinline__ void done(const Unit&) const {}
};

__device__ __forceinline__ unsigned cvt_pk_bf16(float lo, float hi) { unsigned r; asm volatile("v_cvt_pk_bf16_f32 %0, %1, %2" : "=v"(r) : "v"(lo), "v"(hi)); return r; }
typedef float f32x2 __attribute__((ext_vector_type(2)));
__device__ __forceinline__ f32x2 gelu_pk(f32x2 v) {
    const f32x2 av = __builtin_elementwise_abs(v), d = av * 0.2316418882f + 1.0f;
    f32x2 t; t.x = __builtin_amdgcn_rcpf(d.x); t.y = __builtin_amdgcn_rcpf(d.y);
    f32x2 q = t * 0.5307027145f + (-0.7265760135f); q = q * t + 0.7107068705f; q = q * t + (-0.142248368f); q = q * t + 0.127414796f; q = q * t;
    const f32x2 s = (v * v) * (-0.72134752044f);
    f32x2 e; e.x = __builtin_amdgcn_exp2f(s.x); e.y = __builtin_amdgcn_exp2f(s.y);
    const f32x2 m = v * (q * e), r = v - m;
    f32x2 o; o.x = v.x < 0.f ? m.x : r.x; o.y = v.y < 0.f ? m.y : r.y; return o;
}
typedef float f32x2e __attribute__((ext_vector_type(2)));
__device__ __forceinline__ f32x4 silu4(f32x4 v) { f32x4 o; o.x = v.x / (1.f + __expf(-v.x)); o.y = v.y / (1.f + __expf(-v.y)); o.z = v.z / (1.f + __expf(-v.z)); o.w = v.w / (1.f + __expf(-v.w)); return o; }
__device__ __forceinline__ f32x4 gelu4(f32x4 v) { const f32x2 a = gelu_pk((f32x2){v.x, v.y}), b = gelu_pk((f32x2){v.z, v.w}); return (f32x4){a.x, a.y, b.x, b.y}; }
__device__ __forceinline__ u32x4 pack8(f32x4 a, f32x4 b) { u32x4 w; w.x = cvt_pk_bf16(a.x, a.y); w.y = cvt_pk_bf16(a.z, a.w); w.z = cvt_pk_bf16(b.x, b.y); w.w = cvt_pk_bf16(b.z, b.w); return w; }

struct EpiProj1 {
    static constexpr bool PERM = true, AFTER_DRAIN = false;
    unsigned char* ws;
    __device__ __forceinline__ void operator()(const f32x4 (&acc)[2][2][4][2], const Unit& u, int wr, int wc, int fr, int fq) const {
        const int type = u.pn >> 1;
        const int row0 = u.pm * BM + wr * 64 + fr;
        const int hcol = (u.pn & 1) * 256 + wc * 64 + 8 * fq;
        const bool isg = (type & 3) == 3;
        const int slot = type - (type >> 2);
        const size_t boff = isg ? (WS_G + (size_t)(type >> 2) * 1024) : (WS_QA + (size_t)slot * (16 * MiB));
        const int pitch = isg ? 1024 : 512;
        bf16_t* dst = (bf16_t*)(ws + boff) + hcol;
        if ((type & 2) == 0) {
            const float* gp = (const float*)(ws + WS_GAIN) + ((type & 1) + 2 * (type >> 2)) * 64;
            const float qs = (type & 1) ? 1.f : C2;
            f32x4 gn[2][2];
#pragma unroll
            for (int bj = 0; bj < 2; ++bj)
#pragma unroll
                for (int n = 0; n < 2; ++n) gn[bj][n] = *(const f32x4*)(gp + 32 * bj + 8 * fq + 4 * n);
            const float2* tab = (const float2*)(ws + WS_ROPE);
#pragma unroll
            for (int ai = 0; ai < 2; ++ai)
#pragma unroll
                for (int m = 0; m < 4; ++m) {
                    const int row = row0 + ai * HALF + m * 16;
                    f32x4 v[2][2]; float ss = 0.f;
#pragma unroll
                    for (int bj = 0; bj < 2; ++bj)
#pragma unroll
                        for (int n = 0; n < 2; ++n) { v[bj][n] = acc[ai][bj][m][n]; const f32x4 q = v[bj][n] * v[bj][n]; ss += (q.x + q.y) + (q.z + q.w); }
                    ss += __shfl_xor(ss, 16); ss += __shfl_xor(ss, 32);
                    const float ri = rsqrtf(ss * (1.f / 64.f) + RMS_EPS) * qs;
#pragma unroll
                    for (int bj = 0; bj < 2; ++bj)
#pragma unroll
                        for (int n = 0; n < 2; ++n) v[bj][n] = v[bj][n] * ri * gn[bj][n];
                    f32x4 ot[2];
#pragma unroll
                    for (int n = 0; n < 2; ++n) { ot[n].x = __shfl_xor(v[0][n].x, 16); ot[n].y = __shfl_xor(v[0][n].y, 16); ot[n].z = __shfl_xor(v[0][n].z, 16); ot[n].w = __shfl_xor(v[0][n].w, 16); }
                    if (fq < 2) {
                        const f32x4* tp = (const f32x4*)(tab + (size_t)row * 8);
                        const float sg = (fq == 0) ? -1.f : 1.f;
#pragma unroll
                        for (int n = 0; n < 2; ++n) { const f32x4 t0 = tp[2 * n], t1 = tp[2 * n + 1];
                            v[0][n].x = v[0][n].x * t0.x + sg * ot[n].x * t0.y; v[0][n].y = v[0][n].y * t0.z + sg * ot[n].y * t0.w;
                            v[0][n].z = v[0][n].z * t1.x + sg * ot[n].z * t1.y; v[0][n].w = v[0][n].w * t1.z + sg * ot[n].w * t1.w; }
                    }
                    bf16_t* rowp = dst + (size_t)row * pitch;
                    *(u32x4*)(rowp) = pack8(v[0][0], v[0][1]); *(u32x4*)(rowp + 32) = pack8(v[1][0], v[1][1]);
                }
        } else {
            const bool gate = (type & 1);
#pragma unroll
            for (int ai = 0; ai < 2; ++ai)
#pragma unroll
                for (int m = 0; m < 4; ++m) {
                    bf16_t* rowp = dst + (size_t)(row0 + ai * HALF + m * 16) * pitch;
#pragma unroll
                    for (int bj = 0; bj < 2; ++bj) { f32x4 a = acc[ai][bj][m][0], b = acc[ai][bj][m][1]; if (gate) { a = silu4(a); b = silu4(b); }
                        *(u32x4*)(rowp + 32 * bj) = pack8(a, b); }
                }
        }
    }
};
struct EpiRes {
    static constexpr bool PERM = false, AFTER_DRAIN = false;
    const float* base; float* out;
    __device__ __forceinline__ void operator()(const f32x4 (&acc)[2][2][4][2], const Unit& u, int wr, int wc, int fr, int fq) const {
        const int row0 = u.pm * BM + wr * 64 + fr, col0 = u.pn * BM + wc * 32 + 4 * fq;
#pragma unroll
        for (int ai = 0; ai < 2; ++ai)
#pragma unroll
            for (int m = 0; m < 4; ++m) { const size_t off = (size_t)(row0 + ai * HALF + m * 16) * DM + col0;
#pragma unroll
                for (int bj = 0; bj < 2; ++bj)
#pragma unroll
                    for (int n = 0; n < 2; ++n) { const f32x4 b = *(const f32x4*)(base + off + bj * HALF + n * 16); *(f32x4*)(out + off + bj * HALF + n * 16) = b + acc[ai][bj][m][n]; } }
    }
};
struct EpiProj2 {
    static constexpr bool PERM = true, AFTER_DRAIN = false;
    unsigned char* ws;
    __device__ __forceinline__ void operator()(const f32x4 (&acc)[2][2][4][2], const Unit& u, int wr, int wc, int fr, int fq) const {
        const int row0 = u.pm * BM + wr * 64 + fr;
        if (u.pn < 16) {
            bf16_t* dst = (bf16_t*)(ws + WS_UG) + u.pn * 128 + wc * 32 + 8 * fq;
#pragma unroll
            for (int ai = 0; ai < 2; ++ai)
#pragma unroll
                for (int m = 0; m < 4; ++m) {
                    const f32x4 a = gelu4(acc[ai][0][m][0]) * silu4(acc[ai][1][m][0]), b = gelu4(acc[ai][0][m][1]) * silu4(acc[ai][1][m][1]);
                    *(u32x4*)(dst + (size_t)(row0 + ai * HALF + m * 16) * SGU_W) = pack8(a, b);
                }
        } else {
            const int t = u.pn - 16;
            bf16_t* dst = (bf16_t*)(ws + WS_GV) + t * 256 + wc * 32 + 8 * fq;
            float2* st = (float2*)(ws + WS_STAT) + t * 4 + wc;
#pragma unroll
            for (int ai = 0; ai < 2; ++ai)
#pragma unroll
                for (int m = 0; m < 4; ++m) {
                    const int row = row0 + ai * HALF + m * 16; float s = 0.f, s2 = 0.f;
#pragma unroll
                    for (int bj = 0; bj < 2; ++bj) { const f32x4 a = gelu4(acc[ai][bj][m][0]), b = gelu4(acc[ai][bj][m][1]);
                        s += ((a.x + a.y) + (a.z + a.w)) + ((b.x + b.y) + (b.z + b.w));
                        s2 += ((a.x * a.x + a.y * a.y) + (a.z * a.z + a.w * a.w)) + ((b.x * b.x + b.y * b.y) + (b.z * b.z + b.w * b.w));
                        *(u32x4*)(dst + (size_t)row * SGU_W + bj * HALF) = pack8(a, b); }
                    s += __shfl_xor(s, 16); s += __shfl_xor(s, 32); s2 += __shfl_xor(s2, 16); s2 += __shfl_xor(s2, 32);
                    if (fq == 0) st[(size_t)row * 32] = make_float2(s, s2);
                }
        }
    }
};
template <class Epi, class Sched, bool ALIGN_EPI = false, bool SP2 = false>
__device__ __forceinline__ void gemm_phase(PG8_LAS unsigned char* lds, const Gemm g, const Sched& S, const Epi& E, const int wave_) {
    const int tid = wave_ * 64 + opaque_lane(), wid = wave_    , lane = tid & 63, wr = wid >> 2, wc = wid & 3, fr = lane & 15, fq = lane >> 4;
    const int K = g.K, nt = K / BK;
    unsigned voffA[2], voffB[2];
#pragma unroll
    for (int i = 0; i < 2; ++i) { int R, C; stage_rc(tid * 16 + i * 8192, R, C); const int Rb = Epi::PERM ? ((R & ~31) + perm32(R & 31)) : R;
        voffA[i] = (unsigned)(R * K + C) * 2u; voffB[i] = (unsigned)(Rb * K + C) * 2u; }
    const size_t kstep = (size_t)(BK * 2);
    const size_t hstep = (size_t)HALF * K * 2;
    const size_t tstep = 2 * hstep;
    const unsigned ldsw = (unsigned)wid * 1024u;
    const int aoff = lds_byte(wr * 64 + fr, fq * 8), boff = lds_byte(wc * 32 + fr, fq * 8);
#define PG8_SA(b, h) (((b) * 2 + (h)) * HTB)
#define PG8_SB(b, h) ((4 + (b) * 2 + (h)) * HTB)
#define PG8_STAGE(bufoff, gbase, voff) do { _Pragma("unroll") for (int _i = 0; _i < 2; ++_i) \
        __builtin_amdgcn_global_load_lds((const unsigned*)((const char*)(gbase) + (voff)[_i]), (PG8_LAS unsigned*)(lds + (bufoff) + ldsw + _i * 8192), 16, 0, 0); } while (0)
#define PG8_LDA(dst, b, h) do { _Pragma("unroll") for (int m = 0; m < 4; ++m) _Pragma("unroll") for (int k = 0; k < 2; ++k) dst[m][k] = *(const PG8_LAS bf16x8*)(lds + PG8_SA(b, h) + aoff + m * 2048 + k * 1024); } while (0)
#define PG8_LDB(dst, b, h) do { _Pragma("unroll") for (int n = 0; n < 2; ++n) _Pragma("unroll") for (int k = 0; k < 2; ++k) dst[n][k] = *(const PG8_LAS bf16x8*)(lds + PG8_SB(b, h) + boff + n * 2048 + k * 1024); } while (0)
#define PG8_MMA(ai, bj, At, Bt) do { __builtin_amdgcn_s_setprio(1); _Pragma("unroll") for (int m = 0; m < 4; ++m) _Pragma("unroll") for (int n = 0; n < 2; ++n) _Pragma("unroll") for (int k = 0; k < 2; ++k) \
        acc[ai][bj][m][n] = __builtin_amdgcn_mfma_f32_16x16x32_bf16(Bt[n][k], At[m][k], acc[ai][bj][m][n], 0, 0, 0); __builtin_amdgcn_s_setprio(0); } while (0)
#define PG8_WAIT_V(n) asm volatile("s_waitcnt vmcnt(" #n ")" ::: "memory")
#define PG8_WAIT_L(n) asm volatile("s_waitcnt lgkmcnt(" #n ")" ::: "memory")
#define PG8_BAR __builtin_amdgcn_s_barrier()
#define PG8_SCHED __builtin_amdgcn_sched_barrier(0)
    Unit cur, nxt; int ui = 0;
    if (!S.next(0, cur)) return;
    f32x4 acc[2][2][4][2];
#pragma unroll
    for (int a = 0; a < 2; ++a)
#pragma unroll
        for (int b = 0; b < 2; ++b)
#pragma unroll
            for (int m = 0; m < 4; ++m)
#pragma unroll
                for (int n = 0; n < 2; ++n) acc[a][b][m][n] = (f32x4){0.f, 0.f, 0.f, 0.f};
    bf16x8 At[4][2], B0[2][2], B1[2][2];
    const char* cA = (const char*)g.A + (size_t)cur.pm * tstep; const char* cB = (const char*)g.Bt + (size_t)cur.pn * tstep;
    S.a_ready(cur);
    if constexpr (SP2) {
        PG8_STAGE(PG8_SB(0, 0), cB, voffB); PG8_STAGE(PG8_SB(0, 1), cB + hstep, voffB); PG8_STAGE(PG8_SA(0, 0), cA, voffA); PG8_STAGE(PG8_SA(0, 1), cA + hstep, voffA);
        if (wr == 1) PG8_BAR;
        PG8_WAIT_V(2); PG8_BAR;
        PG8_STAGE(PG8_SB(1, 0), cB + kstep, voffB); PG8_STAGE(PG8_SA(1, 0), cA + kstep, voffA); PG8_STAGE(PG8_SB(1, 1), cB + hstep + kstep, voffB);
        PG8_WAIT_V(6); PG8_BAR;
    } else {
        PG8_STAGE(PG8_SB(0, 0), cB, voffB); PG8_STAGE(PG8_SA(0, 0), cA, voffA); PG8_STAGE(PG8_SB(0, 1), cB + hstep, voffB); PG8_STAGE(PG8_SA(0, 1), cA + hstep, voffA);
        if (wr == 1) PG8_BAR;
        PG8_WAIT_V(4); PG8_BAR;
        PG8_STAGE(PG8_SB(1, 0), cB + kstep, voffB); PG8_STAGE(PG8_SA(1, 0), cA + kstep, voffA); PG8_STAGE(PG8_SB(1, 1), cB + hstep + kstep, voffB);
        PG8_WAIT_V(6); PG8_BAR;
    }
    for (;;) {
        const bool has_next = S.next(ui + 1, nxt);
        const char* nA = has_next ? (const char*)g.A + (size_t)nxt.pm * tstep : cA; const char* nB = has_next ? (const char*)g.Bt + (size_t)nxt.pn * tstep : cB;
        for (int t = 0; t < nt; t += 2) {
            const bool last = (t == nt - 2);
            const char* a1 = cA + (size_t)(t + 1) * kstep;
            const char* a2 = last ? nA : cA + (size_t)(t + 2) * kstep; const char* b2 = last ? nB : cB + (size_t)(t + 2) * kstep;
            const char* a3 = a2 + kstep; const char* b3 = b2 + kstep;
            if (last && has_next) S.a_ready(nxt);
            if constexpr (SP2) {
            PG8_LDB(B0, 0, 0); PG8_LDB(B1, 0, 1); PG8_SCHED; PG8_LDA(At, 0, 0); PG8_STAGE(PG8_SA(1, 1), a1 + hstep, voffA);
            PG8_WAIT_V(8); PG8_WAIT_L(0); PG8_BAR; PG8_MMA(0, 0, At, B0); PG8_MMA(0, 1, At, B1); PG8_BAR; PG8_SCHED;
            PG8_LDA(At, 0, 1); PG8_STAGE(PG8_SB(0, 0), b2, voffB); PG8_STAGE(PG8_SB(0, 1), b2 + hstep, voffB); PG8_STAGE(PG8_SA(0, 0), a2, voffA);
            PG8_WAIT_V(8); PG8_WAIT_L(0); PG8_BAR; PG8_MMA(1, 0, At, B0); PG8_MMA(1, 1, At, B1); PG8_BAR; PG8_SCHED;
            PG8_LDB(B0, 1, 0); PG8_LDB(B1, 1, 1); PG8_SCHED; PG8_LDA(At, 1, 0); PG8_STAGE(PG8_SA(0, 1), a2 + hstep, voffA);
            PG8_WAIT_V(8); PG8_WAIT_L(0); PG8_BAR; PG8_MMA(0, 0, At, B0); PG8_MMA(0, 1, At, B1); PG8_BAR; PG8_SCHED;
            PG8_LDA(At, 1, 1); PG8_STAGE(PG8_SB(1, 0), b3, voffB); PG8_STAGE(PG8_SB(1, 1), b3 + hstep, voffB); PG8_STAGE(PG8_SA(1, 0), a3, voffA);
            PG8_WAIT_V(8); PG8_WAIT_L(0); PG8_BAR; PG8_MMA(1, 0, At, B0); PG8_MMA(1, 1, At, B1); PG8_BAR; PG8_SCHED;
            } else {
            PG8_LDB(B0, 0, 0); PG8_SCHED; PG8_LDA(At, 0, 0); PG8_STAGE(PG8_SA(1, 1), a1 + hstep, voffA);
            PG8_WAIT_L(8); PG8_BAR; PG8_WAIT_L(0); PG8_MMA(0, 0, At, B0); PG8_BAR; PG8_SCHED;
            PG8_LDB(B1, 0, 1); PG8_STAGE(PG8_SB(0, 0), b2, voffB);
            PG8_BAR; PG8_WAIT_L(0); PG8_MMA(0, 1, At, B1); PG8_BAR;
            PG8_LDA(At, 0, 1); PG8_STAGE(PG8_SA(0, 0), a2, voffA);
            PG8_BAR; PG8_WAIT_L(0); PG8_MMA(1, 0, At, B0); PG8_BAR; PG8_SCHED;
            PG8_STAGE(PG8_SB(0, 1), b2 + hstep, voffB);
            PG8_WAIT_V(6); PG8_BAR; PG8_MMA(1, 1, At, B1); PG8_BAR;
            PG8_LDB(B0, 1, 0); PG8_SCHED; PG8_LDA(At, 1, 0); PG8_STAGE(PG8_SA(0, 1), a2 + hstep, voffA);
            PG8_WAIT_L(8); PG8_BAR; PG8_WAIT_L(0); PG8_MMA(0, 0, At, B0); PG8_BAR; PG8_SCHED;
            PG8_LDB(B1, 1, 1); PG8_STAGE(PG8_SB(1, 0), b3, voffB);
            PG8_BAR; PG8_WAIT_L(0); PG8_MMA(0, 1, At, B1); PG8_BAR;
            PG8_LDA(At, 1, 1); PG8_STAGE(PG8_SA(1, 0), a3, voffA);
            PG8_BAR; PG8_WAIT_L(0); PG8_MMA(1, 0, At, B0); PG8_BAR; PG8_SCHED;
            PG8_STAGE(PG8_SB(1, 1), b3 + hstep, voffB);
            PG8_WAIT_V(6); PG8_BAR; PG8_MMA(1, 1, At, B1); PG8_BAR;
            }
        }
        if constexpr (ALIGN_EPI) { if (wr == 0) PG8_BAR; }
        if constexpr (!Epi::AFTER_DRAIN) { E(acc, cur, wr, wc, fr, fq); S.done(cur); }
        if (!has_next) break;
#pragma unroll
        for (int a = 0; a < 2; ++a)
#pragma unroll
            for (int b = 0; b < 2; ++b)
#pragma unroll
                for (int m = 0; m < 4; ++m)
#pragma unroll
                    for (int n = 0; n < 2; ++n) acc[a][b][m][n] = (f32x4){0.f, 0.f, 0.f, 0.f};
        cur = nxt; cA = nA; cB = nB; ++ui;
        if constexpr (ALIGN_EPI) { if (wr == 1) PG8_BAR; }
    }
    PG8_WAIT_V(0);
    if constexpr (!ALIGN_EPI) { if (wr == 0) PG8_BAR; }
    PG8_BAR;
    if constexpr (Epi::AFTER_DRAIN) { E.fused(acc, cur, wr, wc, fr, fq, lds, wid, lane); S.done(cur); }
#undef PG8_SA
#undef PG8_SB
#undef PG8_STAGE
#undef PG8_LDA
#undef PG8_LDB
#undef PG8_MMA
#undef PG8_WAIT_V
#undef PG8_WAIT_L
#undef PG8_BAR
#undef PG8_SCHED
}
}

#ifndef PG8_SP2
#define PG8_SP2 true
#endif
#ifndef PG8_ALIGN
#define PG8_ALIGN true
#endif
#include <hip/hip_bf16.h>
#include <cmath>
namespace attn_body {
using bf16=__hip_bfloat16;
using bf16x8=__attribute__((ext_vector_type(8)))short;
using s16x4=__attribute__((ext_vector_type(4)))short;
using f32x16=__attribute__((ext_vector_type(16)))float;
using u32x4=__attribute__((ext_vector_type(4)))unsigned;
constexpr int SEQ=16384,D=64,DM=512;
constexpr int NW=8,QBLK=32,QB=QBLK*NW,KVBLK=64,NQB=SEQ/QB;
constexpr int ATTN_PITCH=DM, ATTN_UNIT_ROWS=QB;
__device__ __forceinline__ int crow(int r,int hi){return (r&3)+8*(r>>2)+4*hi;}
#define SBAR() __builtin_amdgcn_sched_barrier(0)
__device__ __forceinline__ void cmask(f32x16&p0,f32x16&p1,int jb,int qrel,int hi){
  const float NEG=-INFINITY; int kb=64*jb+4*hi;
  #pragma unroll
  for(int r=0;r<16;++r){int kv=kb+(r&3)+8*(r>>2); if(kv>qrel)p0[r]=NEG; if(kv+32>qrel)p1[r]=NEG;}
}

constexpr int NSLOT=3, SLOTB=8192;
constexpr int LDS_K=0, LDS_V=NSLOT*SLOTB, LDS_WS=2*NSLOT*SLOTB, LDS_OST=LDS_WS+NW*64*4, LDS_BYTES=LDS_OST+NW*4096;
constexpr float C2=0.125f*1.4426950408889634f;
__device__ __forceinline__ void glds16(const void*gsrc,unsigned lds_dst){unsigned keep;
  asm volatile("s_mov_b32 %0, m0\n\ts_mov_b32 m0, %2\n\ts_nop 0\n\tglobal_load_lds_dwordx4 %1, off\n\ts_mov_b32 m0, %0":"=&s"(keep):"v"(gsrc),"s"(lds_dst):"memory");}
__device__ __forceinline__ float max3f(float a,float b,float c){float r;asm("v_max3_f32 %0, %1, %2, %3":"=v"(r):"v"(a),"v"(b),"v"(c));return r;}
__device__ __forceinline__ float max2f(float a,float b){float r;asm("v_max_f32_e32 %0, %1, %2":"=v"(r):"v"(a),"v"(b));return r;}
__device__ __forceinline__ float fadd_s(float a,float b){float r;asm("v_add_f32_e32 %0, %1, %2":"=v"(r):"v"(a),"v"(b));return r;}
__device__ __forceinline__ float fsub_s(float a,float b){float r;asm("v_sub_f32_e32 %0, %1, %2":"=v"(r):"v"(a),"v"(b));return r;}
typedef float f32x2_t __attribute__((ext_vector_type(2))); typedef __bf16 bf16x2_t __attribute__((ext_vector_type(2)));
__device__ __forceinline__ unsigned cvtpk_s(float lo,float hi){f32x2_t v={lo,hi};bf16x2_t b=__builtin_convertvector(v,bf16x2_t);return __builtin_bit_cast(unsigned,b);}
#define WAIT_BAR(N) asm volatile("s_waitcnt vmcnt(" #N ") lgkmcnt(0)\n\ts_barrier":::"memory")

__device__ __forceinline__ void qkt(f32x16&p0,f32x16&p1,const char*Kslot,const bf16x8*qr,const f32x16&negm,int r32,int hi){
  const char*kb=Kslot+hi*1024+r32*16;
  #pragma unroll
  for(int d0=0;d0<4;++d0){
    const bf16x8 b0=*reinterpret_cast<const bf16x8*>(kb+d0*2048);
    const bf16x8 b1=*reinterpret_cast<const bf16x8*>(kb+d0*2048+512);
    if(d0==0){p0=__builtin_amdgcn_mfma_f32_32x32x16_bf16(b0,qr[0],negm,0,0,0);p1=__builtin_amdgcn_mfma_f32_32x32x16_bf16(b1,qr[0],negm,0,0,0);}
    else{p0=__builtin_amdgcn_mfma_f32_32x32x16_bf16(b0,qr[d0],p0,0,0,0);p1=__builtin_amdgcn_mfma_f32_32x32x16_bf16(b1,qr[d0],p1,0,0,0);}}
}
typedef __attribute__((address_space(3))) const char* lds_cptr;
typedef short v4i16_t __attribute__((ext_vector_type(4)));
__device__ __forceinline__ void kload8(bf16x8*kf,lds_cptr kp){
  kf[0]=*(const __attribute__((address_space(3))) bf16x8*)(kp);      kf[1]=*(const __attribute__((address_space(3))) bf16x8*)(kp+512);
  kf[2]=*(const __attribute__((address_space(3))) bf16x8*)(kp+2048); kf[3]=*(const __attribute__((address_space(3))) bf16x8*)(kp+2560);
  kf[4]=*(const __attribute__((address_space(3))) bf16x8*)(kp+4096); kf[5]=*(const __attribute__((address_space(3))) bf16x8*)(kp+4608);
  kf[6]=*(const __attribute__((address_space(3))) bf16x8*)(kp+6144); kf[7]=*(const __attribute__((address_space(3))) bf16x8*)(kp+6656);
}
__device__ __forceinline__ void kload2(bf16x8*kf,lds_cptr kp,int j){ kf[2*j]=*(const __attribute__((address_space(3))) bf16x8*)(kp+j*2048); kf[2*j+1]=*(const __attribute__((address_space(3))) bf16x8*)(kp+j*2048+512); }
__device__ __forceinline__ s16x4 vtr(lds_cptr p){ return __builtin_bit_cast(s16x4,__builtin_amdgcn_ds_read_tr16_b64_v4i16((__attribute__((address_space(3))) v4i16_t*)p)); }
__device__ __forceinline__ float rowmax(const f32x16&p0,const f32x16&p1){
  float a=max3f(p0[0],p0[1],p1[0]),b=max3f(p0[2],p0[3],p1[1]);a=max3f(a,p1[2],p1[3]);
  #pragma unroll
  for(int r=4;r<16;r+=4){a=max3f(a,p0[r],p0[r+1]);b=max3f(b,p0[r+2],p0[r+3]);a=max3f(a,p1[r],p1[r+1]);b=max3f(b,p1[r+2],p1[r+3]);}
  const float m=max2f(a,b);
  auto rr=__builtin_amdgcn_permlane32_swap(__float_as_uint(m),__float_as_uint(m),false,false);
  return max2f(__uint_as_float(rr[0]),__uint_as_float(rr[1]));
}
__device__ __forceinline__ void pv(f32x16*o,int vb,bf16x8 pa0,bf16x8 pa1,bf16x8 pa2,bf16x8 pa3){
  #pragma unroll
  for(int d0=0;d0<2;++d0){s16x4 lo[4],hi[4];
    #pragma unroll
    for(int ks=0;ks<4;++ks){
      asm volatile("ds_read_b64_tr_b16 %0,%1 offset:%c2":"=&v"(lo[ks]):"v"(vb),"i"(d0*4096+ks*1024):"memory");
      asm volatile("ds_read_b64_tr_b16 %0,%1 offset:%c2":"=&v"(hi[ks]):"v"(vb),"i"(d0*4096+ks*1024+512):"memory");}
    asm volatile("s_waitcnt lgkmcnt(0)":::"memory");SBAR();
    #define PK(k) (bf16x8){lo[k][0],lo[k][1],lo[k][2],lo[k][3],hi[k][0],hi[k][1],hi[k][2],hi[k][3]}
    o[d0]=__builtin_amdgcn_mfma_f32_32x32x16_bf16(pa0,PK(0),o[d0],0,0,0);
    o[d0]=__builtin_amdgcn_mfma_f32_32x32x16_bf16(pa1,PK(1),o[d0],0,0,0);
    o[d0]=__builtin_amdgcn_mfma_f32_32x32x16_bf16(pa2,PK(2),o[d0],0,0,0);
    o[d0]=__builtin_amdgcn_mfma_f32_32x32x16_bf16(pa3,PK(3),o[d0],0,0,0);
    #undef PK
  }
}

#ifndef ATTN_STORE16
#define ATTN_STORE16(p,v) (*(u32x4*)(p)=(v))
#endif
template<int THRL> __device__ __forceinline__ void attn_unit(int qb,const bf16*Qh,const bf16*__restrict__ Kh,const bf16*__restrict__ Vh,bf16*Oh,char*shm,const int wid){
  const int lane=opaque_lane(),tid=wid*64+lane,r32=lane&31,hi=lane>>5;
  const int q0=qb*QB;
  const bf16*Qw=Qh+(long)(q0+wid*QBLK)*DM;
  const unsigned lds0=(unsigned)(uintptr_t)shm;
  float*wsf=(float*)(shm+LDS_WS)+wid*64;
  const bf16*ksrc=Kh+(long)lane*DM+wid*8;
  const bf16*vsrc=Vh+(long)(16*(wid&3)+(lane>>2))*DM+(wid>>2)*32+(lane&3)*8;
  const unsigned kdst=lds0+LDS_K+wid*1024, vdst=lds0+LDS_V+wid*1024;
  #define DMA_K(t,slot) glds16(ksrc+(long)(t)*KVBLK*DM,(unsigned)__builtin_amdgcn_readfirstlane(kdst+(slot)))
  #define DMA_V(t,slot) glds16(vsrc+(long)(t)*KVBLK*DM,(unsigned)__builtin_amdgcn_readfirstlane(vdst+(slot)))
  const int vb0=(int)(lds0+LDS_V)+((lane>>4)&1)*32+(lane&3)*8+(4*hi+((lane&15)>>2))*64;
  const char*Kbase=shm+LDS_K; bf16x8 kf[8];
  const lds_cptr shm3=(lds_cptr)shm; const lds_cptr kp0=shm3+LDS_K+hi*1024+r32*16; const lds_cptr vp0=shm3+LDS_V+((lane>>4)&1)*32+(lane&3)*8+(4*hi+((lane&15)>>2))*64;
  const int NT=(q0+QB)/KVBLK;
  DMA_K(0,0);DMA_V(0,0);DMA_K(1,SLOTB);
  bf16x8 qr[4];
  #pragma unroll
  for(int d0=0;d0<4;++d0)qr[d0]=*reinterpret_cast<const bf16x8*>(&Qw[(long)r32*DM+d0*16+hi*8]);
  float mhat=0.f,l_reg=0.f; float zz_=0.f; asm volatile("":"+v"(zz_));
  f32x16 o[2]; f32x16 negm;
  #pragma unroll
  for(int r=0;r<16;++r){o[0][r]=zz_;o[1][r]=zz_;negm[r]=zz_;}
  asm volatile("":"+v"(negm));
  const int qrel=wid*QBLK+r32;
  #define CMASK(P0,P1,t) do{int jb_=(t)-(NT-4); if(jb_>=0)cmask(P0,P1,jb_,qrel,hi);}while(0)
  bool resc=false;
  #define START(P0,P1) do{ const float rm=rowmax(P0,P1); resc=false; \
    { const float dl=rm; mhat=fadd_s(mhat,dl); \
      _Pragma("unroll") for(int r=0;r<16;++r){P0[r]=fsub_s(P0[r],dl);P1[r]=fsub_s(P1[r],dl);} \
      _Pragma("unroll") for(int r=0;r<16;++r)negm[r]=-mhat; asm volatile("":"+v"(negm)); } \
    _Pragma("unroll") for(int r=0;r<16;++r)P0[r]=__builtin_amdgcn_exp2f(P0[r]); }while(0)
  #define RESC() do{ if(resc){ asm volatile("s_waitcnt lgkmcnt(0)":::"memory"); \
      _Pragma("unroll") for(int d_=0;d_<2;++d_) _Pragma("unroll") for(int r=0;r<16;++r)o[d_][r]*=wsf[crow(r,hi)]; } }while(0)
  f32x16 pA0,pA1,pB0,pB1;
  int sl_prev=0,sl_cur=0,sl_next=SLOTB;
  #define ROT() do{sl_prev=sl_cur;sl_cur=sl_next;sl_next=(sl_next==(NSLOT-1)*SLOTB)?0:sl_next+SLOTB;}while(0)
  DMA_K(2,2*SLOTB);
  WAIT_BAR(3);
  qkt(pA0,pA1,Kbase,qr,negm,r32,hi);asm volatile("s_nop 15\n\ts_nop 7":"+v"(pA0),"+v"(pA1));CMASK(pA0,pA1,0);
  START(pA0,pA1);
  _Pragma("unroll") for(int r=0;r<16;++r)pA1[r]=__builtin_amdgcn_exp2f(pA1[r]);
  WAIT_BAR(0);
  DMA_K(3,0);DMA_V(1,SLOTB);
  ROT();
  kload8(kf,kp0+sl_cur);
  WAIT_BAR(2);
  s16x4 vlo[8],vhi[8]; u32x4 pw0,pw1,pw2,pw3;
  #define PKW(P,B) cvtpk_s(P[B],P[B+1])
  #define PAF(k) __builtin_bit_cast(bf16x8,pw##k)
  #define VFR(i) (bf16x8){vlo[i][0],vlo[i][1],vlo[i][2],vlo[i][3],vhi[i][0],vhi[i][1],vhi[i][2],vhi[i][3]}
  #define PIN(x) asm volatile("":"+v"(x))
  #define MX3(a,b,c) __builtin_fmaxf(__builtin_fmaxf((a),(b)),(c))
  #define GAPA(MF,A0,A1,A2,A3,W0,W1,PW) do{ MF; sacc+=A0; sacc+=A1; sacc+=A2; sacc+=A3; PIN(sacc); W0; W1; PIN(PW); SBAR(); }while(0)
  #define EX(v) __builtin_amdgcn_exp2f(v)
  #define GAPB(MF,X,B) do{ MF; X[B]=EX(X[B]); X[B+1]=EX(X[B+1]); X[B+2]=EX(X[B+2]); X[B+3]=EX(X[B+3]); PIN(X); SBAR(); }while(0)
  #define VRD(i) do{ vlo[i]=vtr(vp_+(((i)>>2)*4096+((i)&3)*1024)); vhi[i]=vtr(vp_+(((i)>>2)*4096+((i)&3)*1024+512)); }while(0)
  #define KRD(G,j) do{ if(G){ kload2(kf,kp0+sl_next,j); SBAR(); } }while(0)
  #define STEP(C0,C1,P0,P1,t,GK,GV,GL) do{ SBAR(); \
    const lds_cptr vp_=vp0+sl_prev; \
    VRD(0); SBAR(); float sacc=(P0[0]+P0[1]); \
    GAPA(C0=__builtin_amdgcn_mfma_f32_32x32x16_bf16(kf[0],qr[0],negm,0,0,0), P0[2],P0[3],P0[4],P0[5],     pw0[0]=PKW(P0,0), pw0[1]=PKW(P0,2), pw0); \
    VRD(4); SBAR(); GAPA(C1=__builtin_amdgcn_mfma_f32_32x32x16_bf16(kf[1],qr[0],negm,0,0,0), P0[6],P0[7],P0[8],P0[9],     pw0[2]=PKW(P0,4), pw0[3]=PKW(P0,6), pw0); \
    VRD(1); SBAR(); GAPA(C0=__builtin_amdgcn_mfma_f32_32x32x16_bf16(kf[2],qr[1],C0,0,0,0),   P0[10],P0[11],P0[12],P0[13], pw1[0]=PKW(P0,8), pw1[1]=PKW(P0,10), pw1); \
    VRD(5); SBAR(); GAPA(C1=__builtin_amdgcn_mfma_f32_32x32x16_bf16(kf[3],qr[1],C1,0,0,0),   P0[14],P0[15],P1[0],P1[1],   pw1[2]=PKW(P0,12),pw1[3]=PKW(P0,14), pw1); \
    VRD(2); SBAR(); GAPA(C0=__builtin_amdgcn_mfma_f32_32x32x16_bf16(kf[4],qr[2],C0,0,0,0),   P1[2],P1[3],P1[4],P1[5],     pw2[0]=PKW(P1,0), pw2[1]=PKW(P1,2), pw2); \
    VRD(6); SBAR(); GAPA(C1=__builtin_amdgcn_mfma_f32_32x32x16_bf16(kf[5],qr[2],C1,0,0,0),   P1[6],P1[7],P1[8],P1[9],     pw2[2]=PKW(P1,4), pw2[3]=PKW(P1,6), pw2); \
    VRD(3); SBAR(); GAPA(C0=__builtin_amdgcn_mfma_f32_32x32x16_bf16(kf[6],qr[3],C0,0,0,0),   P1[10],P1[11],P1[12],P1[13], pw3[0]=PKW(P1,8), pw3[1]=PKW(P1,10), pw3); \
    VRD(7); SBAR(); GAPA(C1=__builtin_amdgcn_mfma_f32_32x32x16_bf16(kf[7],qr[3],C1,0,0,0),   P1[14],P1[15],0.f,0.f,       pw3[2]=PKW(P1,12),pw3[3]=PKW(P1,14), pw3); \
    l_reg+=sacc; \
    if(GK){DMA_K((t)+3,sl_cur);} if(GV){DMA_V((t)+1,sl_next);} \
    CMASK(C0,C1,t); \
    { float a=MX3(C0[0],C0[1],C1[0]),b=MX3(C0[2],C0[3],C1[1]); a=MX3(a,C1[2],C1[3]); \
      _Pragma("unroll") for(int r=4;r<16;r+=4){a=MX3(a,C0[r],C0[r+1]);b=MX3(b,C0[r+2],C0[r+3]);a=MX3(a,C1[r],C1[r+1]);b=MX3(b,C1[r+2],C1[r+3]);} \
      float rm=__builtin_fmaxf(a,b); { auto rr=__builtin_amdgcn_permlane32_swap(__float_as_uint(rm),__float_as_uint(rm),false,false); rm=__builtin_fmaxf(__uint_as_float(rr[0]),__uint_as_float(rr[1])); } \
      resc=false; \
      if(__builtin_expect(__any(rm>(float)THRL),0)){ const float dl=__builtin_fmaxf(rm,0.f); mhat+=dl; \
        _Pragma("unroll") for(int r=0;r<16;++r){C0[r]-=dl;C1[r]-=dl;} \
        _Pragma("unroll") for(int r=0;r<16;++r)negm[r]=-mhat; asm volatile("":"+v"(negm)); \
        const float f=__builtin_amdgcn_exp2f(-dl); l_reg*=f; if(hi==0)wsf[r32]=f; resc=true; } } \
    SBAR(); \
    GAPB(o[0]=__builtin_amdgcn_mfma_f32_32x32x16_bf16(PAF(0),VFR(0),o[0],0,0,0), C0,0); \
    GAPB(o[1]=__builtin_amdgcn_mfma_f32_32x32x16_bf16(PAF(0),VFR(4),o[1],0,0,0), C0,4); \
    KRD(GL,0); GAPB(o[0]=__builtin_amdgcn_mfma_f32_32x32x16_bf16(PAF(1),VFR(1),o[0],0,0,0), C0,8); \
    KRD(GL,1); GAPB(o[1]=__builtin_amdgcn_mfma_f32_32x32x16_bf16(PAF(1),VFR(5),o[1],0,0,0), C0,12); \
    KRD(GL,2); GAPB(o[0]=__builtin_amdgcn_mfma_f32_32x32x16_bf16(PAF(2),VFR(2),o[0],0,0,0), C1,0); \
    KRD(GL,3); GAPB(o[1]=__builtin_amdgcn_mfma_f32_32x32x16_bf16(PAF(2),VFR(6),o[1],0,0,0), C1,4); \
    GAPB(o[0]=__builtin_amdgcn_mfma_f32_32x32x16_bf16(PAF(3),VFR(3),o[0],0,0,0), C1,8); \
    GAPB(o[1]=__builtin_amdgcn_mfma_f32_32x32x16_bf16(PAF(3),VFR(7),o[1],0,0,0), C1,12); \
    }while(0)
  int t=1;
  #undef CMASK
  #define CMASK(P0,P1,t) do{}while(0)
  for(;t+5<NT;t+=2){
    STEP(pB0,pB1,pA0,pA1,t,true,true,true);     WAIT_BAR(2); RESC(); ROT();
    STEP(pA0,pA1,pB0,pB1,t+1,true,true,true);   WAIT_BAR(2); RESC(); ROT();
  }
  #undef CMASK
  #define CMASK(P0,P1,t) do{int jb_=(t)-(NT-4); if(jb_>=0)cmask(P0,P1,jb_,qrel,hi);}while(0)
  #define ENDW(tt) do{ if((tt)+3<NT){WAIT_BAR(2);} else if((tt)+2<NT){WAIT_BAR(1);} else {WAIT_BAR(0);} }while(0)
  for(;t+1<NT;t+=2){
    STEP(pB0,pB1,pA0,pA1,t,(t+3<NT),(t+1<NT),(t+1<NT));       ENDW(t);   RESC(); ROT();
    STEP(pA0,pA1,pB0,pB1,t+1,(t+4<NT),(t+2<NT),(t+2<NT));     ENDW(t+1); RESC(); ROT();
  }
  STEP(pB0,pB1,pA0,pA1,NT-1,false,false,false); RESC();
  { float sacc=pB0[0]+pB0[1]; _Pragma("unroll") for(int r=2;r<16;++r)sacc+=pB0[r]; _Pragma("unroll") for(int r=0;r<16;++r)sacc+=pB1[r]; l_reg+=sacc;
    pw0=(u32x4){PKW(pB0,0),PKW(pB0,2),PKW(pB0,4),PKW(pB0,6)};pw1=(u32x4){PKW(pB0,8),PKW(pB0,10),PKW(pB0,12),PKW(pB0,14)};pw2=(u32x4){PKW(pB1,0),PKW(pB1,2),PKW(pB1,4),PKW(pB1,6)};pw3=(u32x4){PKW(pB1,8),PKW(pB1,10),PKW(pB1,12),PKW(pB1,14)};
    SBAR(); pv(o,vb0+sl_cur,PAF(0),PAF(1),PAF(2),PAF(3)); }
  #undef PKW
  #undef PAF
  #undef VFR
  #undef PIN
  #undef MX3
  #undef GAPA
  #undef GAPB
  #undef EX
  #undef VRD
  #undef KRD
  #undef STEP
  #undef ENDW
  {auto rr=__builtin_amdgcn_permlane32_swap(__float_as_uint(l_reg),__float_as_uint(l_reg),false,false);l_reg=__uint_as_float(rr[0])+__uint_as_float(rr[1]);}
  if(hi==0)wsf[32+r32]=l_reg;asm volatile("s_waitcnt lgkmcnt(0)":::"memory");
  float rli[16];
  #pragma unroll
  for(int r=0;r<16;++r)rli[r]=__builtin_amdgcn_rcpf(wsf[32+crow(r,hi)]);
  bf16*Ow=Oh+(long)(q0+wid*QBLK)*DM;
  { bf16*stg=(bf16*)(shm+LDS_OST)+wid*2048;
    #pragma unroll
    for(int r=0;r<16;++r){const int orow=crow(r,hi);
      #pragma unroll
      for(int d0=0;d0<2;++d0)stg[orow*64+d0*32+r32]=__float2bfloat16(o[d0][r]*rli[r]);}
    asm volatile("s_waitcnt lgkmcnt(0)":::"memory");
    #pragma unroll
    for(int i=0;i<4;++i){const int row=i*8+(lane>>3),ch=lane&7; const u32x4 v=*(const u32x4*)(stg+row*64+ch*8); ATTN_STORE16(Ow+(long)row*DM+ch*8,v);} }
  asm volatile("s_waitcnt lgkmcnt(0)\n\ts_barrier":::"memory");
  #undef DMA_K
  #undef DMA_V
  #undef CMASK
  #undef START
  #undef RESC
  #undef ROT
}
constexpr int ATTN_LDS_BYTES=LDS_BYTES;
constexpr int W_K=0, W_V=4*SLOTB, W_WS=W_V+4*2*SLOTB, W_OST=0, W_LDS_BYTES=W_WS+NW*64*4;
__device__ __forceinline__ void pv4(f32x16*o,int vb,bf16x8 pa0,bf16x8 pa1,bf16x8 pa2,bf16x8 pa3){
  #pragma unroll
  for(int d0=0;d0<4;++d0){s16x4 lo[4],hi[4];
    #pragma unroll
    for(int ks=0;ks<4;++ks){
      asm volatile("ds_read_b64_tr_b16 %0,%1 offset:%c2":"=&v"(lo[ks]):"v"(vb),"i"(d0*4096+ks*1024):"memory");
      asm volatile("ds_read_b64_tr_b16 %0,%1 offset:%c2":"=&v"(hi[ks]):"v"(vb),"i"(d0*4096+ks*1024+512):"memory");}
    asm volatile("s_waitcnt lgkmcnt(0)":::"memory");SBAR();
    #define PK(k) (bf16x8){lo[k][0],lo[k][1],lo[k][2],lo[k][3],hi[k][0],hi[k][1],hi[k][2],hi[k][3]}
    o[d0]=__builtin_amdgcn_mfma_f32_32x32x16_bf16(pa0,PK(0),o[d0],0,0,0);
    o[d0]=__builtin_amdgcn_mfma_f32_32x32x16_bf16(pa1,PK(1),o[d0],0,0,0);
    o[d0]=__builtin_amdgcn_mfma_f32_32x32x16_bf16(pa2,PK(2),o[d0],0,0,0);
    o[d0]=__builtin_amdgcn_mfma_f32_32x32x16_bf16(pa3,PK(3),o[d0],0,0,0);
    #undef PK
  }
}
__device__ __forceinline__ void cmask1(f32x16&p0,f32x16&p1,int jb,int qrel,int hi){
  int th=qrel-64*jb-4*hi; asm volatile("":"+v"(th));
  #pragma unroll
  for(int r=0;r<16;++r){ const int c=(r&3)+8*(r>>2); p0[r]=(c>th)?-INFINITY:p0[r]; p1[r]=(c+32>th)?-INFINITY:p1[r]; }
}
template<int THRL> __device__ __forceinline__ void attn_unit128(int qb,const bf16*Qh,const bf16*__restrict__ Kh,const bf16*__restrict__ Vh,bf16*Oh,char*shm,const int wid){
  const int lane=opaque_lane(),r32=lane&31,hi=lane>>5;
  const int q0=qb*QB;
  const bf16*Qw=Qh+(long)(q0+wid*QBLK)*DM;
  const unsigned lds0=(unsigned)(uintptr_t)shm;
  const bf16*ksrc=Kh+(long)lane*DM+wid*8;
  const bf16*vsrc=Vh+(long)(16*(wid&3)+(lane>>2))*DM+(wid>>2)*32+(lane&3)*8;
  const unsigned kdst=lds0+W_K+wid*1024, vdst=lds0+W_V+wid*1024;
  #define DMA_K(t,slot) glds16(ksrc+(long)(t)*KVBLK*DM,kdst+(slot))
  #define DMA_V(t,slot) do{ glds16(vsrc+(long)(t)*KVBLK*DM,vdst+(slot)); glds16(vsrc+64+(long)(t)*KVBLK*DM,vdst+8192+(slot)); }while(0)
  const int vb0=(int)(lds0+W_V)+((lane>>4)&1)*32+(lane&3)*8+(4*hi+((lane&15)>>2))*64;
  const char*Kbase=shm+W_K;
  const lds_cptr shm3=(lds_cptr)shm; const lds_cptr kp0=shm3+W_K+hi*1024+r32*16; const lds_cptr vp0=shm3+W_V+((lane>>4)&1)*32+(lane&3)*8+(4*hi+((lane&15)>>2))*64;
  const int NT=(q0+QB)/KVBLK;
  DMA_K(0,0);DMA_V(0,0);DMA_K(1,SLOTB);DMA_V(1,2*SLOTB);
  bf16x8 qr[4];
  #pragma unroll
  for(int d0=0;d0<4;++d0)qr[d0]=*reinterpret_cast<const bf16x8*>(&Qw[(long)r32*DM+d0*16+hi*8]);
  float l_reg=0.f; float zz_=0.f; asm volatile("":"+v"(zz_));
  f32x16 o[4]; const f32x16 zero16=f32x16{};
  #pragma unroll
  for(int r=0;r<16;++r){o[0][r]=zz_;o[1][r]=zz_;o[2][r]=zz_;o[3][r]=zz_;}
  const int qrel=wid*QBLK+r32;
  #define CMASK(P0,P1,t) do{int jb_=(t)-(NT-4); if(jb_>=0)cmask1(P0,P1,jb_,qrel,hi);}while(0)
  DMA_K(2,2*SLOTB);DMA_K(3,3*SLOTB);
  WAIT_BAR(7);
  f32x16 SA0,SA1,SB0,SB1; u32x4 pw0,pw1,pw2,pw3;
  qkt(SA0,SA1,Kbase,qr,zero16,r32,hi); CMASK(SA0,SA1,0);
  WAIT_BAR(4);
  DMA_K(4,0);DMA_V(2,4*SLOTB);
  s16x4 vlo[16],vhi[16]; bf16x8 kfr[8];
  #define PKW(P,B) cvtpk_s(P[B],P[B+1])
  #define PAF(k) __builtin_bit_cast(bf16x8,pw##k)
  #define VFR(i) (bf16x8){vlo[i][0],vlo[i][1],vlo[i][2],vlo[i][3],vhi[i][0],vhi[i][1],vhi[i][2],vhi[i][3]}
  #define PIN(x) asm volatile("":"+v"(x))
  #define EX(v) __builtin_amdgcn_exp2f(v)
  #define VRD(i) do{ vlo[i]=vtr(vp_+(((i)>>2)*4096+((i)&3)*1024)); vhi[i]=vtr(vp_+(((i)>>2)*4096+((i)&3)*1024+512)); }while(0)
  #define KFR(q) do{ kfr[q]=*(const __attribute__((address_space(3))) bf16x8*)(kp_+((q)>>1)*2048+((q)&1)*512); }while(0)
  #define EXA_(X,B) do{ X[B]=EX(X[B]); X[B+1]=EX(X[B+1]); sacc+=X[B]; sacc+=X[B+1]; PIN(sacc); PIN(X); }while(0)
  #define PCK_(X,B,PN,I) do{ PN[I]=PKW(X,B); PIN(PN); }while(0)
  #define STEP(X0,X1,Y0,Y1,t,HQ,HP,GK,GV) do{ SBAR(); \
    const lds_cptr vp_=vp0+(((t)-1)&3)*(2*SLOTB); const lds_cptr kp_=kp0+(((t)+1)&3)*SLOTB; float sacc=0.f; \
    if(HP){VRD(0);VRD(4);VRD(8);VRD(12);} if(HQ){KFR(0);KFR(1);} SBAR(); \
    EXA(0); EXA(1); EXA(2); SBAR(); \
    if(HP){VRD(1);} SBAR(); if(HP){o[0]=__builtin_amdgcn_mfma_f32_32x32x16_bf16(PAF(0),VFR(0),o[0],0,0,0);} EXA(3); SBAR(); \
    if(HP){VRD(5);} SBAR(); if(HP){o[1]=__builtin_amdgcn_mfma_f32_32x32x16_bf16(PAF(0),VFR(4),o[1],0,0,0);} EXA(4); SBAR(); \
    if(HQ){KFR(2);} SBAR(); if(HQ){Y0=__builtin_amdgcn_mfma_f32_32x32x16_bf16(kfr[0],qr[0],zero16,0,0,0);} SBAR(); \
    if(HP){VRD(9);} SBAR(); if(HP){o[2]=__builtin_amdgcn_mfma_f32_32x32x16_bf16(PAF(0),VFR(8),o[2],0,0,0);} EXA(5); SBAR(); \
    if(HP){VRD(13);} SBAR(); if(HP){o[3]=__builtin_amdgcn_mfma_f32_32x32x16_bf16(PAF(0),VFR(12),o[3],0,0,0);} SBAR(); \
    if(HQ){KFR(3);} SBAR(); if(HQ){Y1=__builtin_amdgcn_mfma_f32_32x32x16_bf16(kfr[1],qr[0],zero16,0,0,0);} EXA(6); PCK(0); SBAR(); \
    if(HP){VRD(2);} SBAR(); if(HP){o[0]=__builtin_amdgcn_mfma_f32_32x32x16_bf16(PAF(1),VFR(1),o[0],0,0,0);} PCK(1); SBAR(); \
    if(HP){VRD(6);} SBAR(); if(HP){o[1]=__builtin_amdgcn_mfma_f32_32x32x16_bf16(PAF(1),VFR(5),o[1],0,0,0);} EXA(7); PCK(2); SBAR(); \
    if(HQ){KFR(4);} SBAR(); if(HQ){Y0=__builtin_amdgcn_mfma_f32_32x32x16_bf16(kfr[2],qr[1],Y0,0,0,0);} EXA(8); PCK(3); SBAR(); \
    if(HP){VRD(10);} SBAR(); if(HP){o[2]=__builtin_amdgcn_mfma_f32_32x32x16_bf16(PAF(1),VFR(9),o[2],0,0,0);} SBAR(); \
    if(HP){VRD(14);} SBAR(); if(HP){o[3]=__builtin_amdgcn_mfma_f32_32x32x16_bf16(PAF(1),VFR(13),o[3],0,0,0);} EXA(9); SBAR(); \
    if(HQ){KFR(5);} SBAR(); if(HQ){Y1=__builtin_amdgcn_mfma_f32_32x32x16_bf16(kfr[3],qr[1],Y1,0,0,0);} PCK(4); if(GK){DMA_K((t)+4,((t)&3)*SLOTB);} if(GV){DMA_V((t)+2,(((t)+2)&3)*(2*SLOTB));} SBAR(); \
    if(HP){VRD(3);} SBAR(); if(HP){o[0]=__builtin_amdgcn_mfma_f32_32x32x16_bf16(PAF(2),VFR(2),o[0],0,0,0);} EXA(10); PCK(5); SBAR(); \
    if(HP){VRD(7);} SBAR(); if(HP){o[1]=__builtin_amdgcn_mfma_f32_32x32x16_bf16(PAF(2),VFR(6),o[1],0,0,0);} PCK(6); SBAR(); \
    if(HQ){KFR(6);} SBAR(); if(HQ){Y0=__builtin_amdgcn_mfma_f32_32x32x16_bf16(kfr[4],qr[2],Y0,0,0,0);} EXA(11); PCK(7); SBAR(); \
    if(HP){VRD(11);} SBAR(); if(HP){o[2]=__builtin_amdgcn_mfma_f32_32x32x16_bf16(PAF(2),VFR(10),o[2],0,0,0);} EXA(12); SBAR(); \
    if(HP){VRD(15);} SBAR(); if(HP){o[3]=__builtin_amdgcn_mfma_f32_32x32x16_bf16(PAF(2),VFR(14),o[3],0,0,0);} SBAR(); \
    if(HQ){KFR(7);} SBAR(); if(HQ){Y1=__builtin_amdgcn_mfma_f32_32x32x16_bf16(kfr[5],qr[2],Y1,0,0,0);} EXA(13); PCK(8); SBAR(); \
    if(HP){o[0]=__builtin_amdgcn_mfma_f32_32x32x16_bf16(PAF(3),VFR(3),o[0],0,0,0);} PCK(9); SBAR(); \
    if(HP){o[1]=__builtin_amdgcn_mfma_f32_32x32x16_bf16(PAF(3),VFR(7),o[1],0,0,0);} EXA(14); PCK(10); SBAR(); \
    if(HQ){Y0=__builtin_amdgcn_mfma_f32_32x32x16_bf16(kfr[6],qr[3],Y0,0,0,0);} PCK(11); SBAR(); \
    if(HP){o[2]=__builtin_amdgcn_mfma_f32_32x32x16_bf16(PAF(3),VFR(11),o[2],0,0,0);} EXA(15); SBAR(); \
    if(HP){o[3]=__builtin_amdgcn_mfma_f32_32x32x16_bf16(PAF(3),VFR(15),o[3],0,0,0);} SBAR(); \
    if(HQ){Y1=__builtin_amdgcn_mfma_f32_32x32x16_bf16(kfr[7],qr[3],Y1,0,0,0);} PCK(12); SBAR(); \
    PCK(13); PCK(14); PCK(15); SBAR(); \
    l_reg+=sacc; if(HQ){CMASK(Y0,Y1,(t)+1);} \
    }while(0)
  #define EXA(u) EXAX(u)
  #define PCK(u) PCKX(u)
  #define EXA_E(u) do{ if((u)<8)EXA_(SA0,2*(u)); else EXA_(SA1,2*((u)-8)); }while(0)
  #define EXA_O(u) do{ if((u)<8)EXA_(SB0,2*(u)); else EXA_(SB1,2*((u)-8)); }while(0)
  #define PCK_E(u) do{ if((u)<4)PCK_(SA0,2*(u),pw0,(u)&3); else if((u)<8)PCK_(SA0,2*(u),pw1,(u)&3); else if((u)<12)PCK_(SA1,2*((u)-8),pw2,(u)&3); else PCK_(SA1,2*((u)-8),pw3,(u)&3); }while(0)
  #define PCK_O(u) do{ if((u)<4)PCK_(SB0,2*(u),pw0,(u)&3); else if((u)<8)PCK_(SB0,2*(u),pw1,(u)&3); else if((u)<12)PCK_(SB1,2*((u)-8),pw2,(u)&3); else PCK_(SB1,2*((u)-8),pw3,(u)&3); }while(0)
  #define EXAX(u) EXA_E(u)
  #define PCKX(u) PCK_E(u)
  #define STEP_E(t,HQ,HP,GK,GV) STEP(SA0,SA1,SB0,SB1,t,HQ,HP,GK,GV)
  STEP_E(0,true,false,false,false);
  WAIT_BAR(4);
  #undef EXAX
  #undef PCKX
  #define EXAX(u) EXA_O(u)
  #define PCKX(u) PCK_O(u)
  #define STEP_O(t,HQ,HP,GK,GV) STEP(SB0,SB1,SA0,SA1,t,HQ,HP,GK,GV)
  int t=1;
  #undef CMASK
  #define CMASK(P0,P1,t) do{}while(0)
  for(;t+6<NT;t+=2){
    { STEP_O(t,true,true,true,true); } WAIT_BAR(6);
  #undef EXAX
  #undef PCKX
  #define EXAX(u) EXA_E(u)
  #define PCKX(u) PCK_E(u)
    { STEP_E(t+1,true,true,true,true); } WAIT_BAR(6);
  #undef EXAX
  #undef PCKX
  #define EXAX(u) EXA_O(u)
  #define PCKX(u) PCK_O(u)
  }
  #undef CMASK
  const int lane_b=opaque_lane(),qrel_b=wid*QBLK+(lane_b&31),hi_b=lane_b>>5;
  #define CMASK(P0,P1,t) do{int jb_=(t)-(NT-4); if(jb_>=0)cmask1(P0,P1,jb_,qrel_b,hi_b);}while(0)
  #define ENDW(tt) do{ if((tt)+4<NT){WAIT_BAR(6);} else if((tt)+3<NT){WAIT_BAR(5);} else if((tt)+2<NT){WAIT_BAR(4);} else {WAIT_BAR(0);} }while(0)
  for(;t+1<NT;t+=2){
    { STEP_O(t,(t+1<NT),true,(t+4<NT),(t+2<NT)); } ENDW(t);
  #undef EXAX
  #undef PCKX
  #define EXAX(u) EXA_E(u)
  #define PCKX(u) PCK_E(u)
    { STEP_E(t+1,(t+2<NT),true,(t+5<NT),(t+3<NT)); } ENDW(t+1);
  #undef EXAX
  #undef PCKX
  #define EXAX(u) EXA_O(u)
  #define PCKX(u) PCK_O(u)
  }
  { STEP_O(NT-1,false,true,false,false); }
  SBAR(); pv4(o,vb0+((NT-1)&3)*(2*SLOTB),PAF(0),PAF(1),PAF(2),PAF(3));
  #undef PKW
  #undef PAF
  #undef VFR
  #undef PIN
  #undef EX
  #undef VRD
  #undef KFR
  #undef EXA_
  #undef PCK_
  #undef EXA
  #undef PCK
  #undef EXAX
  #undef PCKX
  #undef EXA_E
  #undef EXA_O
  #undef PCK_E
  #undef PCK_O
  #undef STEP
  #undef STEP_E
  #undef STEP_O
  #undef ENDW
  float*wsf=(float*)(shm+W_WS)+wid*64;
  const int lane_e=opaque_lane(),r32e=lane_e&31,hie=lane_e>>5;
  {auto rr=__builtin_amdgcn_permlane32_swap(__float_as_uint(l_reg),__float_as_uint(l_reg),false,false);l_reg=__uint_as_float(rr[0])+__uint_as_float(rr[1]);}
  if(hie==0)wsf[32+r32e]=l_reg;asm volatile("s_waitcnt lgkmcnt(0)":::"memory");
  float rli[16];
  #pragma unroll
  for(int r=0;r<16;++r)rli[r]=__builtin_amdgcn_rcpf(wsf[32+crow(r,hie)]);
  bf16*Ow=Oh+(long)(q0+wid*QBLK)*DM;
  asm volatile("s_waitcnt lgkmcnt(0)\n\ts_barrier":::"memory");
  { bf16*stg=(bf16*)(shm+W_OST)+wid*4096;
    #pragma unroll
    for(int r=0;r<16;++r){const int orow=crow(r,hie);
      #pragma unroll
      for(int d0=0;d0<4;++d0)stg[orow*128+d0*32+r32e]=__float2bfloat16(o[d0][r]*rli[r]);}
    asm volatile("s_waitcnt lgkmcnt(0)":::"memory");
    #pragma unroll
    for(int i=0;i<8;++i){const int row=i*4+(lane_e>>4),ch=lane_e&15; const u32x4 v=*(const u32x4*)(stg+row*128+ch*8); ATTN_STORE16(Ow+(long)row*DM+ch*8,v);} }
  asm volatile("s_waitcnt lgkmcnt(0)\n\ts_barrier":::"memory");
  #undef DMA_K
  #undef DMA_V
  #undef CMASK
}
constexpr int DSW_K=0, DSW_V=6*SLOTB, DSW_WS=12*SLOTB, DSW_OST=DSW_WS+NW*64*4, DSW_LDS_BYTES=DSW_OST+NW*4096;
__device__ __forceinline__ void dsw_unit(int dil,int r,int blk,const bf16*Qh,const bf16*__restrict__ Kh,const bf16*__restrict__ Vh,bf16*Oh,float*lse,char*shm,const int wid){
  const int lane=opaque_lane(),r32=lane&31,hi=lane>>5;
  const int L=256*blk;
  const unsigned lds0=(unsigned)(uintptr_t)shm;
  float*wsf=(float*)(shm+DSW_WS)+wid*64;
  #pragma unroll
  for(int tau=0;tau<6;++tau){
    int lk=L-128+64*tau+lane; lk=lk<0?0:lk;
    glds16(Kh+((long)lk*dil+r)*DM+wid*8,(unsigned)__builtin_amdgcn_readfirstlane(lds0+DSW_K+tau*SLOTB+wid*1024));
    int lv=L-128+64*tau+16*(wid&3)+(lane>>2); lv=lv<0?0:lv;
    glds16(Vh+((long)lv*dil+r)*DM+(wid>>2)*32+(lane&3)*8,(unsigned)__builtin_amdgcn_readfirstlane(lds0+DSW_V+tau*SLOTB+wid*1024));
  }
  const long tq=(long)(L+wid*QBLK+r32)*dil+r;
  bf16x8 qr[4];
  #pragma unroll
  for(int d0=0;d0<4;++d0)qr[d0]=*reinterpret_cast<const bf16x8*>(&Qh[tq*DM+d0*16+hi*8]);
  WAIT_BAR(0);
  const int tau0=wid>>1;
  const f32x16 zero=f32x16{};
  f32x16 s00,s01,s10,s11,s20,s21;
  qkt(s00,s01,shm+DSW_K+(tau0+0)*SLOTB,qr,zero,r32,hi);
  qkt(s10,s11,shm+DSW_K+(tau0+1)*SLOTB,qr,zero,r32,hi);
  qkt(s20,s21,shm+DSW_K+(tau0+2)*SLOTB,qr,zero,r32,hi);
  const int lq=wid*QBLK+r32;
  { const int th=lq-128-(-128+64*tau0+4*hi);
    _Pragma("unroll") for(int rr=0;rr<16;++rr){ const int c0=(rr&3)+8*(rr>>2); s00[rr]=(c0>=th)?s00[rr]:-INFINITY; s01[rr]=(c0+32>=th)?s01[rr]:-INFINITY; } }
  { const int th=lq-(-128+64*(tau0+2)+4*hi);
    _Pragma("unroll") for(int rr=0;rr<16;++rr){ const int c0=(rr&3)+8*(rr>>2); s20[rr]=(c0<=th)?s20[rr]:-INFINITY; s21[rr]=(c0+32<=th)?s21[rr]:-INFINITY; } }
  if(blk==0){
    if(tau0<2){ _Pragma("unroll") for(int rr=0;rr<16;++rr){ s00[rr]=-INFINITY; s01[rr]=-INFINITY; } }
    if(tau0<1){ _Pragma("unroll") for(int rr=0;rr<16;++rr){ s10[rr]=-INFINITY; s11[rr]=-INFINITY; } }
  }
  float l=0.f;
  #define DSW_EXP(P) do{ _Pragma("unroll") for(int rr=0;rr<16;++rr){ P[rr]=__builtin_amdgcn_exp2f(P[rr]); l+=P[rr]; } }while(0)
  DSW_EXP(s00); DSW_EXP(s01); DSW_EXP(s10); DSW_EXP(s11); DSW_EXP(s20); DSW_EXP(s21);
  #undef DSW_EXP
  { auto pr=__builtin_amdgcn_permlane32_swap(__float_as_uint(l),__float_as_uint(l),false,false); l=__uint_as_float(pr[0])+__uint_as_float(pr[1]); }
  f32x16 o[2]; o[0]=f32x16{}; o[1]=f32x16{};
  const int vb0=(int)(lds0+DSW_V)+((lane>>4)&1)*32+(lane&3)*8+(4*hi+((lane&15)>>2))*64;
  #define DSW_PV(P0,P1,jj) do{ u32x4 w0,w1,w2,w3; \
      w0=(u32x4){cvtpk_s(P0[0],P0[1]),cvtpk_s(P0[2],P0[3]),cvtpk_s(P0[4],P0[5]),cvtpk_s(P0[6],P0[7])}; w1=(u32x4){cvtpk_s(P0[8],P0[9]),cvtpk_s(P0[10],P0[11]),cvtpk_s(P0[12],P0[13]),cvtpk_s(P0[14],P0[15])}; \
      w2=(u32x4){cvtpk_s(P1[0],P1[1]),cvtpk_s(P1[2],P1[3]),cvtpk_s(P1[4],P1[5]),cvtpk_s(P1[6],P1[7])}; w3=(u32x4){cvtpk_s(P1[8],P1[9]),cvtpk_s(P1[10],P1[11]),cvtpk_s(P1[12],P1[13]),cvtpk_s(P1[14],P1[15])}; \
      SBAR(); pv(o,vb0+(tau0+(jj))*SLOTB,__builtin_bit_cast(bf16x8,w0),__builtin_bit_cast(bf16x8,w1),__builtin_bit_cast(bf16x8,w2),__builtin_bit_cast(bf16x8,w3)); }while(0)
  DSW_PV(s00,s01,0); DSW_PV(s10,s11,1); DSW_PV(s20,s21,2);
  #undef DSW_PV
  if(hi==0){ wsf[32+r32]=l; lse[tq*8]=__builtin_log2f(l); }
  asm volatile("s_waitcnt lgkmcnt(0)":::"memory");
  float rli[16];
  #pragma unroll
  for(int rr=0;rr<16;++rr)rli[rr]=__builtin_amdgcn_rcpf(wsf[32+crow(rr,hi)]);
  { bf16*stg=(bf16*)(shm+DSW_OST)+wid*2048;
    #pragma unroll
    for(int rr=0;rr<16;++rr){const int orow=crow(rr,hi);
      #pragma unroll
      for(int d0=0;d0<2;++d0)stg[orow*64+d0*32+r32]=__float2bfloat16(o[d0][rr]*rli[rr]);}
    asm volatile("s_waitcnt lgkmcnt(0)":::"memory");
    #pragma unroll
    for(int i=0;i<4;++i){const int row=i*8+(lane>>3),ch=lane&7; const u32x4 v=*(const u32x4*)(stg+row*64+ch*8);
      *(u32x4*)(Oh+((long)(L+wid*QBLK+row)*dil+r)*DM+ch*8)=v;} }
  asm volatile("s_waitcnt lgkmcnt(0)\n\ts_barrier":::"memory");
}
#ifndef NREP_DIFF
#define NREP_DIFF 1
#endif
#ifndef NREP_DSW
#define NREP_DSW 1
#endif
#ifndef ATT_VSPLIT
#define ATT_VSPLIT 0
#endif
struct AttnArgs { const bf16*QD; const bf16*KD; const bf16*VD; bf16*DO0; bf16*DO1; const bf16*QA; const bf16*KA; const bf16*VA; bf16*OP; float*LSE; };
template<int THRL=8> __device__ __forceinline__ void attn_phase_all(char*lds,const AttnArgs&A,int vcu,const int wid){
#ifndef NO_DIFF
#if ATT_VSPLIT
  { const int vh=vcu>>4,s=vcu&15,h=vh>>2,c=(vh>>1)&1,half=vh&1;
    const bf16*Qh=A.QD+(2*h+c)*64; const bf16*Kh=A.KD+(2*h+c)*64; const bf16*Vh=A.VD+h*128+half*64; bf16*Oh=(c?A.DO1:A.DO0)+h*128+half*64;
    for(int rep_=0;rep_<NREP_DIFF;++rep_) for(int i=0;i<4;++i){ const int qb=(i==0)?63-s:(i==1)?32+s:(i==2)?31-s:s; attn_unit<THRL>(qb,Qh,Kh,Vh,Oh,lds,wid); } }
#else
  { const int hc=vcu>>5,s=vcu&31,h=hc>>1,c=hc&1;
    const bf16*Qh=A.QD+hc*64; const bf16*Kh=A.KD+hc*64; const bf16*Vh=A.VD+h*128; bf16*Oh=(c?A.DO1:A.DO0)+h*128;
    for(int rep_=0;rep_<NREP_DIFF;++rep_) for(int i=0;i<2;++i){ const int qb=(i==0)?63-s:s; attn_unit128<THRL>(qb,Qh,Kh,Vh,Oh,lds,wid); } }
#endif
#endif
#ifndef NO_DSW
  for(int rep_=0;rep_<NREP_DSW;++rep_) for(int i=0;i<6;++i){ const int u=vcu+256*i; const int p=u>>9,h=(u>>6)&7,idx=u&63; const int dil=(p==0)?1:(p==1)?4:16; const int nblk=64/dil; const int r=idx/nblk,blk=idx-r*nblk;
    dsw_unit(dil,r,blk,A.QA+h*64,A.KA+h*64,A.VA+h*64,A.OP+(size_t)p*SEQ*DM+h*64,A.LSE+(size_t)p*SEQ*8+h,lds,wid); }
#endif
}
#undef SBAR
#undef WAIT_BAR
}
#define GAS __attribute__((address_space(1)))
#define LAS __attribute__((address_space(3)))
typedef unsigned short bf16;
typedef unsigned v4u __attribute__((ext_vector_type(4)));
typedef float f32x4 __attribute__((ext_vector_type(4)));
typedef short bf16x8 __attribute__((ext_vector_type(8)));
typedef GAS unsigned gu32;
typedef GAS unsigned long long gu64;
#define RLX_AGENT __ATOMIC_RELAXED, __HIP_MEMORY_SCOPE_AGENT
#define LDS_WAIT() asm volatile("s_waitcnt lgkmcnt(0)" ::: "memory")
#define VM_WAIT() asm volatile("s_waitcnt vmcnt(0)" ::: "memory")
__device__ __forceinline__ unsigned long long rt() { return __builtin_amdgcn_s_memrealtime(); }
__device__ __forceinline__ unsigned f2bf(float f) { unsigned u = __builtin_bit_cast(unsigned, f); return (u + 0x7fffu + ((u >> 16) & 1u)) >> 16; }
__device__ __forceinline__ unsigned pk2(float lo, float hi) { return f2bf(lo) | (f2bf(hi) << 16); }

#define XB_TMO      128
#define XB_XCNT(j)  (256  + 64 * (j))
#define XB_XSUB(j)  (1280 + 64 * (j))
#define XB_XGEN(j)  (2304 + 64 * (j))
#define XB_TOP      3328
#define XB_TOPGEN   3392
#define XCD_BAR_WORDS 3456
#define XB_SPIN_CAP (1u << 18)

__device__ __forceinline__ unsigned xb_ld(unsigned* p)              { return __hip_atomic_load(p, __ATOMIC_RELAXED, __HIP_MEMORY_SCOPE_AGENT); }
__device__ __forceinline__ unsigned xb_add(unsigned* p, unsigned v) { return __hip_atomic_fetch_add(p, v, __ATOMIC_RELAXED, __HIP_MEMORY_SCOPE_AGENT); }
__device__ __forceinline__ unsigned xb_xcc_id() { return (unsigned)__builtin_amdgcn_s_getreg((3 << 11) | 20) & 0xFu; }
#define XB_SPIN(cond, bar) do { unsigned _sp = 0; while (cond) { __builtin_amdgcn_s_sleep(1); \
    if ((++_sp & 255u) == 0u) { if (xb_ld(&(bar)[XB_TMO])) break; if (_sp > XB_SPIN_CAP) { atomicAdd(&(bar)[XB_TMO], 1u); break; } } } } while (0)

struct XcdBarrier {
    unsigned* bar; unsigned x; int wave;
    volatile LAS unsigned* st;
};

__device__ __forceinline__ XcdBarrier xcd_barrier_post(unsigned* bar, volatile LAS unsigned* st) {
    XcdBarrier b; b.bar = bar; b.x = xb_xcc_id(); b.st = st;
    if (threadIdx.x == 0) (void)xb_add(&bar[XB_XCNT(b.x)], 1u);
    return b;
}
__device__ __forceinline__ void xcd_barrier_complete(unsigned* bar, unsigned x, unsigned& nloc, unsigned& nx) {
    const unsigned G = gridDim.x * gridDim.y * gridDim.z;
    unsigned sum, cnt, mine, sp = 0u;
    for (;;) {
        sum = 0u; cnt = 0u; mine = 0u;
#pragma unroll
        for (unsigned j = 0; j < 16; ++j) { const unsigned c = xb_ld(&bar[XB_XCNT(j)]); sum += c; cnt += (c > 0u) ? 1u : 0u; mine = (j == x) ? c : mine; }
        if (sum == G) break;
        __builtin_amdgcn_s_sleep(1);
        if ((++sp & 255u) == 0u) { if (xb_ld(&bar[XB_TMO])) break; if (sp > XB_SPIN_CAP) { atomicAdd(&bar[XB_TMO], 1u); break; } }
    }
    nloc = mine > 0u ? mine : 1u; nx = cnt > 0u ? cnt : 1u;
}

__device__ __forceinline__ void xcd_barrier(const XcdBarrier& b) {
    asm volatile("s_waitcnt vmcnt(0)" ::: "memory");
    __syncthreads();
    if (b.wave == 0 && opaque_lane() == 0) {
        unsigned* bar = b.bar;
        __builtin_amdgcn_s_waitcnt(0);
        unsigned nloc = b.st[0], nx = b.st[1];
        if (nloc == 0u) { xcd_barrier_complete(bar, b.x, nloc, nx); b.st[0] = nloc; b.st[1] = nx; }
        const unsigned old = xb_add(&bar[XB_XSUB(b.x)], 1u);
        const unsigned gen = old / nloc;
        if (old + 1u == (gen + 1u) * nloc) {
            __builtin_amdgcn_fence(__ATOMIC_RELEASE, "agent");
            asm volatile("s_waitcnt vmcnt(0)" ::: "memory");
            const unsigned og = xb_add(&bar[XB_TOP], 1u);
            const unsigned tg = og / nx;
            if (og + 1u == (tg + 1u) * nx) xb_add(&bar[XB_TOPGEN], 1u);
            else XB_SPIN(xb_ld(&bar[XB_TOPGEN]) == tg, bar);
            __builtin_amdgcn_fence(__ATOMIC_ACQUIRE, "agent");
            xb_add(&bar[XB_XGEN(b.x)], 1u);
            asm volatile("s_waitcnt vmcnt(0)" ::: "memory");
        } else {
            XB_SPIN(xb_ld(&bar[XB_XGEN(b.x)]) == gen, bar);
            __builtin_amdgcn_fence(__ATOMIC_ACQUIRE, "agent");
            asm volatile("s_waitcnt vmcnt(0)" ::: "memory");
        }
    }
    __syncthreads();
}
constexpr int NWAVES = 8;
constexpr int RING_OFF = 0, RING_BYTES = 135168;
constexpr int LDSCTL_OFF = RING_BYTES, MISC_OFF = LDSCTL_OFF + 320;
constexpr int LDS_BYTES = 147456;
static_assert(MISC_OFF + 128 <= LDS_BYTES && attn_body::DSW_LDS_BYTES <= RING_BYTES && attn_body::ATTN_LDS_BYTES <= RING_BYTES, "LDS map");
constexpr int CW_TMO = 0, CW_CODE = 1;
constexpr int CW_BAR = 4096;
constexpr int N_PHASES = 9;
static_assert((CW_BAR + N_PHASES * XCD_BAR_WORDS) * 4 <= (int)CTL_ZERO_BYTES, "CTL words inside the memset region");

struct Frame {
    LAS unsigned char* lds; volatile LAS unsigned* MISC; gu32* ctl;
    int tid, lane, wave, vcu, G;
};

__device__ __forceinline__ void p0_transpose_item(const float* W, int K, int N, bf16* WT, int n0p, int n0l, int k0, LAS float* scr, int lane) {
#pragma unroll 8
    for (int i = 0; i < 32; ++i) { const int kk = 2 * i + (lane >> 5); scr[kk * 33 + (lane & 31)] = W[(size_t)(k0 + kk) * N + n0l + (lane & 31)]; }
    LDS_WAIT(); asm volatile("" ::: "memory");
    const int c = lane & 7;
#pragma unroll
    for (int j = 0; j < 4; ++j) { const int n = (lane >> 3) + 8 * j; const LAS float* s = scr + (8 * c) * 33 + n;
        v4u o; o.x = pk2(s[0 * 33], s[1 * 33]); o.y = pk2(s[2 * 33], s[3 * 33]); o.z = pk2(s[4 * 33], s[5 * 33]); o.w = pk2(s[6 * 33], s[7 * 33]);
        *(GAS v4u*)(WT + (size_t)(n0p + n) * K + k0 + 8 * c) = o; }
    LDS_WAIT(); asm volatile("" ::: "memory");
}
__device__ __forceinline__ void rms_row_to_bf16(int lane, const float* xrow, const float* g, bf16* orow) {
    const GAS f32x4* xr = (const GAS f32x4*)xrow + lane;
    f32x4 v[4]; float s = 0.f;
#pragma unroll
    for (int j = 0; j < 4; ++j) { v[j] = xr[64 * j]; s += (v[j].x * v[j].x + v[j].y * v[j].y) + (v[j].z * v[j].z + v[j].w * v[j].w); }
    const float r = rsqrtf(wave_sum(s) * (1.f / DM) + RMS_EPS);
    GAS unsigned long long* o8 = (GAS unsigned long long*)orow + lane;
#pragma unroll
    for (int j = 0; j < 4; ++j) { const f32x4 gg = ((const GAS f32x4*)g)[lane + 64 * j];
        o8[64 * j] = (unsigned long long)pk2(v[j].x * r * gg.x, v[j].y * r * gg.y) | ((unsigned long long)pk2(v[j].z * r * gg.z, v[j].w * r * gg.w) << 32); }
}
__device__ __forceinline__ float2 rope_entry(int pos, int i) {
    const double inv[8] = {1.0, 0.19392274474868576, 0.03760603093086393, 0.007292664737217109, 0.001414213562373095, 0.0002742481756762073, 5.318295896944988e-05, 1.031338537721246e-05};
    double iv = inv[0];
#pragma unroll
    for (int k = 1; k < 8; ++k) iv = (i == k) ? inv[k] : iv;
    const double a = (double)pos * iv * 0.63661977236758134308;
    const double q = __builtin_rint(a);
    const double th = (a - q) * 1.57079632679489661923, t2 = th * th;
    const double sn = th * (1.0 + t2 * (-1.0 / 6 + t2 * (1.0 / 120 + t2 * (-1.0 / 5040 + t2 * (1.0 / 362880 + t2 * (-1.0 / 39916800 + t2 * (1.0 / 6227020800.0)))))));
    const double cs = 1.0 + t2 * (-0.5 + t2 * (1.0 / 24 + t2 * (-1.0 / 720 + t2 * (1.0 / 40320 + t2 * (-1.0 / 3628800 + t2 * (1.0 / 479001600.0 + t2 * (-1.0 / 87178291200.0)))))));
    const int qi = ((int)q) & 3;
    double c, s;
    if (qi == 0) { c = cs; s = sn; } else if (qi == 1) { c = -sn; s = cs; } else if (qi == 2) { c = -cs; s = -sn; } else { c = sn; s = -cs; }
    return make_float2((float)c, (float)s);
}
__device__ __forceinline__ void p0_prologue(Frame& F, const Ptrs& P) {
    unsigned char* ws = P.ws;
    LAS float* scr = (LAS float*)(F.lds + RING_OFF + F.wave * 16384);
    const int gw = F.vcu * NWAVES + F.wave, NGW = F.G * NWAVES;
    constexpr int I1 = 16 * 128, IO = 16 * 32, I2 = 16 * 192, I3 = 32 * 32, NITEMS = I1 + IO + I2 + I3;
    for (int it = gw; it < NITEMS; it += NGW) {
        int r = it;
        if (r < I1) { const int kb = r >> 7, n0p = (r & 127) * 32, rho = n0p & 255, n0l = (n0p & ~255) + 64 * ((rho >> 5) & 3) + 32 * (rho >> 7);
            p0_transpose_item(P.att_w_in, DM, ATT_IN, (bf16*)(ws + WS_W1T), n0p, n0l, kb * 64, scr, F.lane); continue; } r -= I1;
        if (r < IO) { const int kb = r >> 5, n0p = (r & 31) * 32; p0_transpose_item(P.att_w_out, DM, DM, (bf16*)(ws + WS_WOT), n0p, n0p, kb * 64, scr, F.lane); continue; } r -= IO;
        if (r < I2) { const int kb = r / 192, n0p = (r % 192) * 32, pn = n0p >> 8, rho = n0p & 255;
            const int n0l = (pn < 16) ? ((rho < 128) ? 128 * pn + rho : 4096 + 128 * pn + (rho - 128)) : 2048 + 256 * (pn - 16) + rho;
            p0_transpose_item(P.sgu_w_in, DM, SGU_IN, (bf16*)(ws + WS_W2T), n0p, n0l, kb * 64, scr, F.lane); continue; } r -= I2;
        { const int kb = r >> 5, n0p = (r & 31) * 32; p0_transpose_item(P.sgu_w_out, SGU_W, DM, (bf16*)(ws + WS_W3T), n0p, n0p, kb * 64, scr, F.lane); }
    }
    const int gt = gw * 64 + F.lane, NGT = NGW * 64;
    for (int i = gt; i < SEQ * 8; i += NGT) ((float2*)(ws + WS_ROPE))[i] = rope_entry(i >> 3, i & 7);
    for (int i = gt; i < 8 * 128 * 128; i += NGT) { const int t = (i >> 7) & 127, s = i & 127; ((bf16*)(ws + WS_WSB))[i] = (bf16)((s <= t) ? f2bf(P.w_s[i]) : 0u); }
    if (gt < 64) { float* gd = (float*)(ws + WS_GAIN); gd[gt] = P.dsw_qg[gt]; gd[64 + gt] = P.dsw_kg[gt]; gd[128 + gt] = P.diff_qg[gt]; gd[192 + gt] = P.diff_kg[gt]; }
    for (int m = gw; m < SEQ; m += NGW) rms_row_to_bf16(F.lane, P.x + (size_t)m * DM, P.att_norm, (bf16*)(ws + WS_XN) + (size_t)m * DM);
}

__device__ __forceinline__ void merge_row(const Ptrs& P, int t, int lane, float lam, bf16* yout) {
    unsigned char* ws = P.ws;
    bf16* G = (bf16*)(ws + WS_G) + (size_t)t * 1024 + lane * 16;
    const uint4 g0 = *(const uint4*)G, g1 = *(const uint4*)(G + 8);
    const unsigned gw[8] = {g0.x, g0.y, g0.z, g0.w, g1.x, g1.y, g1.z, g1.w};
    float y[16];
    if (lane < 32) {
        const int h = lane >> 2; const float* L = (const float*)(ws + WS_LSE);
        const float l0 = L[((size_t)0 * SEQ + t) * 8 + h], l1 = L[((size_t)1 * SEQ + t) * 8 + h], l2 = L[((size_t)2 * SEQ + t) * 8 + h];
        const float mx = fmaxf(l0, fmaxf(l1, l2)); float w0 = exp2f(l0 - mx), w1 = exp2f(l1 - mx), w2 = exp2f(l2 - mx); const float wi = 1.f / (w0 + w1 + w2); w0 *= wi; w1 *= wi; w2 *= wi;
        const bf16* O = (const bf16*)(ws + WS_OP) + (size_t)t * 512 + lane * 16;
        const float wt[3] = {w0, w1, w2};
#pragma unroll
        for (int i = 0; i < 16; ++i) y[i] = 0.f;
#pragma unroll
        for (int p = 0; p < 3; ++p) { const uint4 a = *(const uint4*)(O + (size_t)p * SEQ * 512), b = *(const uint4*)(O + (size_t)p * SEQ * 512 + 8);
            const unsigned ow[8] = {a.x, a.y, a.z, a.w, b.x, b.y, b.z, b.w};
#pragma unroll
            for (int i = 0; i < 8; ++i) { y[2 * i] += wt[p] * bf2f(ow[i] & 0xffffu); y[2 * i + 1] += wt[p] * bf2f(ow[i] >> 16); } }
    } else {
        const int cidx = (lane - 32) * 16;
        const bf16* A = (const bf16*)(ws + WS_DO0) + (size_t)t * 512 + cidx; const bf16* B = (const bf16*)(ws + WS_DO1) + (size_t)t * 512 + cidx;
        const uint4 a0 = *(const uint4*)A, a1 = *(const uint4*)(A + 8), b0 = *(const uint4*)B, b1 = *(const uint4*)(B + 8);
        const unsigned aw[8] = {a0.x, a0.y, a0.z, a0.w, a1.x, a1.y, a1.z, a1.w}, bw[8] = {b0.x, b0.y, b0.z, b0.w, b1.x, b1.y, b1.z, b1.w};
#pragma unroll
        for (int i = 0; i < 8; ++i) { y[2 * i] = bf2f(aw[i] & 0xffffu) - lam * bf2f(bw[i] & 0xffffu); y[2 * i + 1] = bf2f(aw[i] >> 16) - lam * bf2f(bw[i] >> 16); }
    }
    float ss = 0.f;
#pragma unroll
    for (int i = 0; i < 16; ++i) ss += y[i] * y[i];
    ss += __shfl_xor(ss, 1); ss += __shfl_xor(ss, 2); ss += __shfl_xor(ss, 4);
    if (lane >= 32) {
        const float r = rsqrtf(ss * (1.f / 128.f) + RMS_EPS) * (1.f - LAM_INIT);
        const float* sg = P.subln + ((lane - 32) & 7) * 16;
#pragma unroll
        for (int i = 0; i < 16; ++i) y[i] = y[i] * r * sg[i];
    }
    unsigned ow[8];
#pragma unroll
    for (int i = 0; i < 8; ++i) ow[i] = f2bf(y[2 * i] * bf2f(gw[i] & 0xffffu)) | (f2bf(y[2 * i + 1] * bf2f(gw[i] >> 16)) << 16);
    bf16* Y = yout + (size_t)t * 1024 + lane * 16;
    *(uint4*)Y = make_uint4(ow[0], ow[1], ow[2], ow[3]); *(uint4*)(Y + 8) = make_uint4(ow[4], ow[5], ow[6], ow[7]);
}
__device__ __forceinline__ float lam_value(const Ptrs& P, int lane) {
    const float a = wave_sum(P.lq1[lane] * P.lk1[lane]), b = wave_sum(P.lq2[lane] * P.lk2[lane]);
    return expf(a) - expf(b) + LAM_INIT;
}

typedef float f32x16 __attribute__((ext_vector_type(16)));
typedef short s16x4v __attribute__((ext_vector_type(4)));
__device__ __forceinline__ void sgu_phase(Frame& F, const Ptrs& P) {
    unsigned char* ws = P.ws;
    const int lane = F.lane, w = F.wave, r32 = lane & 31, hi = lane >> 5;
    const int n = F.vcu >> 1;
    typedef float f32x2s __attribute__((ext_vector_type(2)));
    LAS f32x2s* stt = (LAS f32x2s*)(F.lds + 131072);
    {
        const int row = 16 * w + (lane >> 2), part = lane & 3;
        const f32x4* sp = (const f32x4*)((const float2*)(ws + WS_STAT) + (size_t)(n * 128 + row) * 32 + part * 8);
        float s = 0.f, s2 = 0.f;
#pragma unroll
        for (int i = 0; i < 4; ++i) { const f32x4 v = sp[i]; s += v.x + v.z; s2 += v.y + v.w; }
        s += __shfl_xor(s, 1); s += __shfl_xor(s, 2); s2 += __shfl_xor(s2, 1); s2 += __shfl_xor(s2, 2);
        const float mu = s * (1.f / SGU_W), var = s2 * (1.f / SGU_W) - mu * mu;
        if (part == 0) stt[row] = (f32x2s){mu, rsqrtf(var + LN_EPS)};
    }
    __syncthreads();
    LAS unsigned char* wl = F.lds + w * 16384;
    const unsigned wl_addr = (unsigned)(uintptr_t)wl;
    const bf16* GV = (const bf16*)(ws + WS_GV); bf16* UG = (bf16*)(ws + WS_UG); const bf16* WSB = (const bf16*)(ws + WS_WSB);
    const int cc = (lane & 3) * 8, rq = lane >> 2, g0 = 4 * (F.vcu & 1), rot = n & 3;
#define SGU_G(i) (g0 + (((i) + rot) & 3))
    v4u gvr[8], ugr[8];
#pragma unroll
    for (int it = 0; it < 8; ++it) { const size_t off = (size_t)(n * 128 + 16 * it + rq) * SGU_W + SGU_G(0) * 256 + 32 * w + cc; gvr[it] = *(const v4u*)(GV + off); ugr[it] = *(const v4u*)(UG + off); }
#pragma unroll 1
    for (int gi = 0; gi < 4; ++gi) {
        const int g = SGU_G(gi), c0 = g * 256 + 32 * w, c0n = SGU_G(gi + 1) * 256 + 32 * w;
        {
            const f32x4 lg0 = *(const f32x4*)(P.ln_g + c0 + cc), lg1 = *(const f32x4*)(P.ln_g + c0 + cc + 4), lb0 = *(const f32x4*)(P.ln_b + c0 + cc), lb1 = *(const f32x4*)(P.ln_b + c0 + cc + 4);
#pragma unroll
            for (int it = 0; it < 8; ++it) {
                const int s = 16 * it + rq; const v4u raw = gvr[it];
                const f32x2s mr = stt[s];
                f32x4 a = {bf2f(raw.x & 0xffffu), bf2f(raw.x >> 16), bf2f(raw.y & 0xffffu), bf2f(raw.y >> 16)}, b = {bf2f(raw.z & 0xffffu), bf2f(raw.z >> 16), bf2f(raw.w & 0xffffu), bf2f(raw.w >> 16)};
                a = (a - mr.x) * mr.y * lg0 + lb0; b = (b - mr.x) * mr.y * lg1 + lb1;
                v4u o; o.x = pk2(a.x, a.y); o.y = pk2(a.z, a.w); o.z = pk2(b.x, b.y); o.w = pk2(b.z, b.w);
                *(LAS v4u*)(wl + s * 64 + cc * 2) = o;
            }
        }
        if (gi < 3) {
#pragma unroll
            for (int it = 0; it < 8; ++it) gvr[it] = *(const v4u*)(GV + (size_t)(n * 128 + 16 * it + rq) * SGU_W + c0n + cc);
        }
        LDS_WAIT(); asm volatile("" ::: "memory");
        bf16x8 bfr[8];
        {
            const unsigned va = wl_addr + (unsigned)((8 * hi + ((lane & 15) >> 2)) * 64 + ((lane >> 4) & 1) * 32 + (lane & 3) * 8);
#pragma unroll
            for (int ks = 0; ks < 8; ++ks) { s16x4v lo, hh;
                asm volatile("ds_read_b64_tr_b16 %0,%1 offset:%c2" : "=&v"(lo) : "v"(va), "i"(ks * 1024) : "memory");
                asm volatile("ds_read_b64_tr_b16 %0,%1 offset:%c2" : "=&v"(hh) : "v"(va), "i"(ks * 1024 + 256) : "memory");
                asm volatile("s_waitcnt lgkmcnt(0)" : "+v"(lo), "+v"(hh) :: "memory");
                bfr[ks] = (bf16x8){lo[0], lo[1], lo[2], lo[3], hh[0], hh[1], hh[2], hh[3]}; }
        }
        __builtin_amdgcn_sched_barrier(0);
        f32x16 acc[4];
#pragma unroll
        for (int i = 0; i < 4; ++i) {
            acc[i] = f32x16{};
            const bf16* wrow = WSB + ((size_t)g * 128 + 32 * i + r32) * 128 + 8 * hi;
#pragma unroll
            for (int ks = 0; ks < 2 * i + 2; ++ks) { const bf16x8 af = *(const bf16x8*)(wrow + 16 * ks); acc[i] = __builtin_amdgcn_mfma_f32_32x32x16_bf16(af, bfr[ks], acc[i], 0, 0, 0); }
            __builtin_amdgcn_sched_barrier(0);
        }
#pragma unroll
        for (int i = 0; i < 4; ++i)
#pragma unroll
            for (int rr = 0; rr < 16; ++rr) { const int t = 32 * i + (rr & 3) + 8 * (rr >> 2) + 4 * hi; *(LAS float*)(wl + t * 128 + r32 * 4) = acc[i][rr]; }
        LDS_WAIT(); asm volatile("" ::: "memory");
#pragma unroll
        for (int it = 0; it < 8; ++it) {
            const int t = 16 * it + rq; bf16* up = UG + (size_t)(n * 128 + t) * SGU_W + c0 + cc;
            const float bs = P.b_s[g * 128 + t];
            const v4u raw = ugr[it]; const f32x4 s0 = *(LAS f32x4*)(wl + t * 128 + cc * 4) + bs, s1 = *(LAS f32x4*)(wl + t * 128 + cc * 4 + 16) + bs;
            v4u o; o.x = pk2(bf2f(raw.x & 0xffffu) * s0.x, bf2f(raw.x >> 16) * s0.y); o.y = pk2(bf2f(raw.y & 0xffffu) * s0.z, bf2f(raw.y >> 16) * s0.w);
            o.z = pk2(bf2f(raw.z & 0xffffu) * s1.x, bf2f(raw.z >> 16) * s1.y); o.w = pk2(bf2f(raw.w & 0xffffu) * s1.z, bf2f(raw.w >> 16) * s1.w);
            *(v4u*)up = o;
        }
        if (gi < 3) {
#pragma unroll
            for (int it = 0; it < 8; ++it) ugr[it] = *(const v4u*)(UG + (size_t)(n * 128 + 16 * it + rq) * SGU_W + c0n + cc);
        }
        LDS_WAIT(); asm volatile("" ::: "memory");
    }
}

struct Args { Ptrs p; int ph_lo, ph_hi, li, pad; };
__global__ void __launch_bounds__(NWAVES * 64, 2) mega_fwd(Args args) {
    extern __shared__ __attribute__((aligned(16))) unsigned char lds[];
    Frame F;
    F.lds = (LAS unsigned char*)lds;
    F.MISC = (volatile LAS unsigned*)(F.lds + MISC_OFF);
    F.wave = __builtin_amdgcn_readfirstlane((int)threadIdx.x >> 6); F.lane = opaque_lane(); F.tid = F.wave * 64 + F.lane;
    F.G = gridDim.x; { const int bx = blockIdx.x; F.vcu = (F.G % 8 == 0) ? (bx % 8) * (F.G / 8) + bx / 8 : bx; }
    const Ptrs& P = args.p;
    unsigned char* ws = P.ws;
    F.ctl = (gu32*)(ws + WS_CTL);
    for (int u = F.tid; u < (LDS_BYTES - LDSCTL_OFF) / 4; u += NWAVES * 64) ((LAS unsigned*)(F.lds + LDSCTL_OFF))[u] = 0u;
    __syncthreads();
    const int lo = args.ph_lo, hi = args.ph_hi;
    XcdBarrier bar; bar.bar = (unsigned*)(F.ctl + CW_BAR) + args.li * XCD_BAR_WORDS; bar.x = 0; bar.st = nullptr;
    if (hi - lo > 1) bar = xcd_barrier_post((unsigned*)(F.ctl + CW_BAR) + args.li * XCD_BAR_WORDS, F.MISC + 8);
    bar.wave = F.wave;
#ifndef PH_EN
#define PH_EN 0x1FF
#endif
#define IN(k) (((PH_EN >> (k)) & 1) && lo <= (k) && (k) < hi)
#ifndef REPEAT_PHASE
#define REPEAT_PHASE -1
#endif
#define REP(k) for (int rep_ = 0; rep_ < ((REPEAT_PHASE == (k)) ? 2 : 1); ++rep_, (rep_ < ((REPEAT_PHASE == (k)) ? 2 : 1) ? xcd_barrier(bar) : (void)0))
#define SEAM(k) do { if (IN(k) && IN((k) + 1)) xcd_barrier(bar); { F.lane = opaque_lane(); F.tid = F.wave * 64 + F.lane; } } while (0)

    if (IN(0)) REP(0) { p0_prologue(F, P); }
    SEAM(0);
    if (IN(1)) REP(1) {
        pg8::Gemm g{(const bf16*)(ws + WS_XN), (const bf16*)(ws + WS_W1T), SEQ, ATT_IN, DM}; pg8::StaticOrder S; S.init(SEQ, ATT_IN, F.G, (int)blockIdx.x);
        pg8::EpiProj1 E{ws};
        pg8::gemm_phase<pg8::EpiProj1, pg8::StaticOrder, PG8_ALIGN, PG8_SP2>(F.lds + RING_OFF, g, S, E, F.wave);
    }
    SEAM(1);
    if (IN(2)) REP(2) {
        using abf = attn_body::bf16;
        const attn_body::AttnArgs A{(const abf*)(ws + WS_QD), (const abf*)(ws + WS_KD), (const abf*)(ws + WS_VD), (abf*)(ws + WS_DO0), (abf*)(ws + WS_DO1),
                                    (const abf*)(ws + WS_QA), (const abf*)(ws + WS_KA), (const abf*)(ws + WS_VA), (abf*)(ws + WS_OP), (float*)(ws + WS_LSE)};
        attn_body::attn_phase_all<8>((char*)lds + RING_OFF, A, F.vcu, F.wave);
    }
    SEAM(2);
    if (IN(3)) REP(3) {
        const float lam = lam_value(P, F.lane);
        for (int t = F.vcu * NWAVES + F.wave; t < SEQ; t += F.G * NWAVES) merge_row(P, t, F.lane, lam, (bf16*)(ws + ((REPEAT_PHASE == 3 && rep_ == 0) ? WS_QA : WS_G)));
    }
    SEAM(3);
    if (IN(4)) REP(4) {
        pg8::Gemm g{(const bf16*)(ws + WS_G), (const bf16*)(ws + WS_WOT), SEQ, DM, DM}; pg8::StaticOrder S; S.init(SEQ, DM, F.G, (int)blockIdx.x);
        pg8::EpiRes E{P.x, P.out};
        pg8::gemm_phase<pg8::EpiRes, pg8::StaticOrder, false, PG8_SP2>(F.lds + RING_OFF, g, S, E, F.wave);
    }
    SEAM(4);
    if (IN(5)) REP(5) {
        for (int m = F.vcu * NWAVES + F.wave; m < SEQ; m += F.G * NWAVES) rms_row_to_bf16(F.lane, P.out + (size_t)m * DM, P.sgu_norm, (bf16*)(ws + WS_XN) + (size_t)m * DM);
    }
    SEAM(5);
    if (IN(6)) REP(6) {
        pg8::Gemm g{(const bf16*)(ws + WS_XN), (const bf16*)(ws + WS_W2T), SEQ, SGU_IN, DM}; pg8::StaticOrder S; S.init(SEQ, SGU_IN, F.G, (int)blockIdx.x);
        pg8::EpiProj2 E{ws};
        pg8::gemm_phase<pg8::EpiProj2, pg8::StaticOrder, PG8_ALIGN, PG8_SP2>(F.lds + RING_OFF, g, S, E, F.wave);
    }
    SEAM(6);
    if (IN(7)) REP(7) { sgu_phase(F, P); }
    SEAM(7);
    if (IN(8)) REP(8) {
        pg8::Gemm g{(const bf16*)(ws + WS_UG), (const bf16*)(ws + WS_W3T), SEQ, DM, SGU_W}; pg8::StaticOrder S; S.init(SEQ, DM, F.G, (int)blockIdx.x);
        pg8::EpiRes E{P.out, (REPEAT_PHASE == 8 && rep_ == 0) ? (float*)(ws + WS_GV) : P.out};
        pg8::gemm_phase<pg8::EpiRes, pg8::StaticOrder, false, PG8_SP2>(F.lds + RING_OFF, g, S, E, F.wave);
    }
#undef IN
#undef SEAM
}
#if DEBUG_NAIVE
__global__ void k_rope(float2* tab) {
    const int idx = blockIdx.x * blockDim.x + threadIdx.x; if (idx >= SEQ * 8) return;
    const int pos = idx >> 3, i = idx & 7;
    const double inv[8] = {1.0, 0.19392274474868576, 0.03760603093086393, 0.007292664737217109, 0.001414213562373095, 0.0002742481756762073, 5.318295896944988e-05, 1.031338537721246e-05};
    double iv = inv[0];
#pragma unroll
    for (int k = 1; k < 8; ++k) iv = (i == k) ? inv[k] : iv;
    const double ang = (double)pos * iv;
    const double a = ang * 0.63661977236758134308;
    const double q = __builtin_rint(a);
    const double th = (a - q) * 1.57079632679489661923;
    const double t2 = th * th;
    double sn = th * (1.0 + t2 * (-1.0 / 6 + t2 * (1.0 / 120 + t2 * (-1.0 / 5040 + t2 * (1.0 / 362880 + t2 * (-1.0 / 39916800 + t2 * (1.0 / 6227020800.0)))))));
    double cs = 1.0 + t2 * (-0.5 + t2 * (1.0 / 24 + t2 * (-1.0 / 720 + t2 * (1.0 / 40320 + t2 * (-1.0 / 3628800 + t2 * (1.0 / 479001600.0 + t2 * (-1.0 / 87178291200.0)))))));
    const int qi = ((int)q) & 3;
    double c, s;
    if (qi == 0) { c = cs; s = sn; } else if (qi == 1) { c = -sn; s = cs; } else if (qi == 2) { c = -cs; s = -sn; } else { c = sn; s = -cs; }
    tab[idx] = make_float2((float)c, (float)s);
}

__global__ void __launch_bounds__(256) k_rmsnorm(const float* x, const float* g, bf16* out) {
    const int row = blockIdx.x * 4 + (threadIdx.x >> 6), lane = threadIdx.x & 63;
    const f32x4* xr = (const f32x4*)(x + (size_t)row * DM) + lane;
    f32x4 v[4]; float s = 0.f;
#pragma unroll
    for (int j = 0; j < 4; ++j) { v[j] = xr[64 * j]; s += (v[j].x * v[j].x + v[j].y * v[j].y) + (v[j].z * v[j].z + v[j].w * v[j].w); }
    const float r = rsqrtf(wave_sum(s) * (1.f / DM) + RMS_EPS);
    unsigned long long* o8 = (unsigned long long*)(out + (size_t)row * DM) + lane;
#pragma unroll
    for (int j = 0; j < 4; ++j) { const f32x4 gg = ((const f32x4*)g)[lane + 64 * j];
        const unsigned lo = f2bf(v[j].x * r * gg.x) | (f2bf(v[j].y * r * gg.y) << 16), hi = f2bf(v[j].z * r * gg.z) | (f2bf(v[j].w * r * gg.w) << 16);
        o8[64 * j] = (unsigned long long)lo | ((unsigned long long)hi << 32); }
}

template <int MODE> __global__ void __launch_bounds__(256) k_ngemm(const bf16* A, int lda, const float* B, int N, int K, Ptrs P) {
    __shared__ float As[16][68];
    __shared__ float Bs[16][68];
    __shared__ float Bs2[16][68];
    __shared__ float T[64][65];
    __shared__ float T2[64][65];
    __shared__ float rinv[64];
    constexpr bool DUAL = (MODE == 3);
    const int tid = threadIdx.x, tx = tid & 15, ty = tid >> 4;
    const int row0 = blockIdx.y * 64, grp = blockIdx.x;
    int col0 = grp * 64, col0b = 0;
    bool dual = false;
    if (MODE == 3) { if (grp < 32) { col0 = grp * 64; col0b = 4096 + grp * 64; dual = true; } else { col0 = 2048 + (grp - 32) * 64; } }
    float acc[4][4], acc2[4][4];
#pragma unroll
    for (int i = 0; i < 4; ++i)
#pragma unroll
        for (int j = 0; j < 4; ++j) { acc[i][j] = 0.f; acc2[i][j] = 0.f; }
    for (int k0 = 0; k0 < K; k0 += 16) {
        { const int r = tid >> 2, kk = (tid & 3) * 4; const uint2 a = *(const uint2*)(A + (size_t)(row0 + r) * lda + k0 + kk);
          As[kk + 0][r] = bf2f(a.x & 0xffffu); As[kk + 1][r] = bf2f(a.x >> 16); As[kk + 2][r] = bf2f(a.y & 0xffffu); As[kk + 3][r] = bf2f(a.y >> 16); }
        { const int kk = tid >> 4, c = (tid & 15) * 4; const f32x4 b = *(const f32x4*)(B + (size_t)(k0 + kk) * N + col0 + c);
          Bs[kk][c] = b.x; Bs[kk][c + 1] = b.y; Bs[kk][c + 2] = b.z; Bs[kk][c + 3] = b.w;
          if (DUAL && dual) { const f32x4 b2 = *(const f32x4*)(B + (size_t)(k0 + kk) * N + col0b + c); Bs2[kk][c] = b2.x; Bs2[kk][c + 1] = b2.y; Bs2[kk][c + 2] = b2.z; Bs2[kk][c + 3] = b2.w; } }
        __syncthreads();
#pragma unroll
        for (int k = 0; k < 16; ++k) {
            float a[4], b[4], b2[4];
#pragma unroll
            for (int i = 0; i < 4; ++i) { a[i] = As[k][ty * 4 + i]; b[i] = Bs[k][tx * 4 + i]; b2[i] = DUAL ? Bs2[k][tx * 4 + i] : 0.f; }
#pragma unroll
            for (int i = 0; i < 4; ++i)
#pragma unroll
                for (int j = 0; j < 4; ++j) { acc[i][j] += a[i] * b[j]; if (DUAL) acc2[i][j] += a[i] * b2[j]; }
        }
        __syncthreads();
    }
#pragma unroll
    for (int i = 0; i < 4; ++i)
#pragma unroll
        for (int j = 0; j < 4; ++j) { T[ty * 4 + i][tx * 4 + j] = acc[i][j]; if (DUAL) T2[ty * 4 + i][tx * 4 + j] = acc2[i][j]; }
    __syncthreads();
    unsigned char* ws = P.ws;
    if (MODE == 1) {
        const int type = grp >> 3, hd = grp & 7;
        const bool isq = (type == 0 || type == 4), isk = (type == 1 || type == 5), isg = (type == 3 || type == 7);
        const float* gain = (type == 0) ? P.dsw_qg : (type == 1) ? P.dsw_kg : (type == 4) ? P.diff_qg : P.diff_kg;
        if (isq || isk) {
            if (tid < 64) { float ss = 0.f; for (int j = 0; j < 64; ++j) ss += T[tid][j] * T[tid][j]; rinv[tid] = rsqrtf(ss * (1.f / 64.f) + RMS_EPS); }
            __syncthreads();
        }
        bf16* dst; int pitch, cb;
        if (type == 0) { dst = (bf16*)(ws + WS_QA); pitch = 512; cb = hd * 64; } else if (type == 1) { dst = (bf16*)(ws + WS_KA); pitch = 512; cb = hd * 64; }
        else if (type == 2) { dst = (bf16*)(ws + WS_VA); pitch = 512; cb = hd * 64; } else if (type == 3) { dst = (bf16*)(ws + WS_G); pitch = 1024; cb = hd * 64; }
        else if (type == 4) { dst = (bf16*)(ws + WS_QD); pitch = 512; cb = hd * 64; } else if (type == 5) { dst = (bf16*)(ws + WS_KD); pitch = 512; cb = hd * 64; }
        else if (type == 6) { dst = (bf16*)(ws + WS_VD); pitch = 512; cb = hd * 64; } else { dst = (bf16*)(ws + WS_G); pitch = 1024; cb = 512 + hd * 64; }
        const float2* tab = (const float2*)(ws + WS_ROPE);
        const int r = tid >> 2;
        for (int jj = 0; jj < 16; ++jj) {
            const int j = (tid & 3) * 16 + jj; float val = T[r][j];
            if (isq || isk) {
                const float ri = rinv[r];
                val = val * ri * gain[j];
                if (j < 16) { const int i = j & 7; const float2 cs = tab[(size_t)(row0 + r) * 8 + i];
                    const float x1 = T[r][i] * ri * gain[i], x2 = T[r][i + 8] * ri * gain[i + 8];
                    val = (j < 8) ? (x1 * cs.x - x2 * cs.y) : (x2 * cs.x + x1 * cs.y); }
                if (isq) val *= C2;
            } else if (isg) val = silu_f(val);
            dst[(size_t)(row0 + r) * pitch + cb + j] = (bf16)f2bf(val);
        }
    } else if (MODE == 2) {
        const int r = tid >> 2;
        for (int jj = 0; jj < 16; ++jj) { const int j = (tid & 3) * 16 + jj; const size_t o = (size_t)(row0 + r) * DM + col0 + j; P.out[o] = P.x[o] + T[r][j]; }
    } else if (MODE == 3) {
        const int r = tid >> 2;
        if (dual) {
            bf16* ug = (bf16*)(ws + WS_UG);
            for (int jj = 0; jj < 16; ++jj) { const int j = (tid & 3) * 16 + jj; ug[(size_t)(row0 + r) * SGU_W + col0 + j] = (bf16)f2bf(gelu_f(T[r][j]) * silu_f(T2[r][j])); }
        } else {
            bf16* gv = (bf16*)(ws + WS_GV);
            for (int jj = 0; jj < 16; ++jj) { const int j = (tid & 3) * 16 + jj; const float v = gelu_f(T[r][j]); T[r][j] = v; gv[(size_t)(row0 + r) * SGU_W + (col0 - 2048) + j] = (bf16)f2bf(v); }
            __syncthreads();
            if (tid < 64) { float s = 0.f, s2 = 0.f; for (int j = 0; j < 64; ++j) { const float v = T[tid][j]; s += v; s2 += v * v; }
                ((float2*)(ws + WS_STAT))[(size_t)(row0 + tid) * 32 + (grp - 32)] = make_float2(s, s2); }
        }
    } else {
        const int r = tid >> 2;
        for (int jj = 0; jj < 16; ++jj) { const int j = (tid & 3) * 16 + jj; const size_t o = (size_t)(row0 + r) * DM + col0 + j; P.out[o] = P.out[o] + T[r][j]; }
    }
}

__global__ void __launch_bounds__(256) k_ndsw(Ptrs P) {
    const int w = blockIdx.x * 4 + (threadIdx.x >> 6), lane = threadIdx.x & 63;
    const int p = w / (SEQ * 8), rem = w % (SEQ * 8), t = rem >> 3, h = rem & 7;
    const int dil = (p == 0) ? 1 : (p == 1) ? 4 : 16;
    const bf16* QA = (const bf16*)(P.ws + WS_QA); const bf16* KA = (const bf16*)(P.ws + WS_KA); const bf16* VA = (const bf16*)(P.ws + WS_VA);
    const float q = bf2f(QA[(size_t)t * 512 + h * 64 + lane]);
    float m = -INFINITY, l = 0.f, o = 0.f;
    for (int j = 0; j <= 128; ++j) {
        const int tk = t - j * dil; if (tk < 0) break;
        const float s = wave_sum(q * bf2f(KA[(size_t)tk * 512 + h * 64 + lane]));
        const float mn = fmaxf(m, s), a = exp2f(m - mn), pe = exp2f(s - mn);
        l = l * a + pe; o = o * a + pe * bf2f(VA[(size_t)tk * 512 + h * 64 + lane]); m = mn;
    }
    ((bf16*)(P.ws + WS_OP))[((size_t)p * SEQ + t) * 512 + h * 64 + lane] = (bf16)f2bf(o / l);
    if (lane == 0) ((float*)(P.ws + WS_LSE))[((size_t)p * SEQ + t) * 8 + h] = m + log2f(l);
}
__global__ void __launch_bounds__(256) k_ndiff(Ptrs P) {
    const int w = blockIdx.x * 4 + (threadIdx.x >> 6), lane = threadIdx.x & 63;
    const int t = SEQ - 1 - (w >> 3), vq = w & 7, h = vq >> 1, c = vq & 1;
    const bf16* QD = (const bf16*)(P.ws + WS_QD); const bf16* KD = (const bf16*)(P.ws + WS_KD); const bf16* VD = (const bf16*)(P.ws + WS_VD);
    const float q = bf2f(QD[(size_t)t * 512 + vq * 64 + lane]);
    float m = -INFINITY, l = 0.f, o0 = 0.f, o1 = 0.f;
    int tk = 0;
    for (; tk + 3 <= t; tk += 4) {
        float s[4];
#pragma unroll
        for (int u = 0; u < 4; ++u) s[u] = q * bf2f(KD[(size_t)(tk + u) * 512 + vq * 64 + lane]);
#pragma unroll
        for (int o = 1; o < 64; o <<= 1) {
#pragma unroll
            for (int u = 0; u < 4; ++u) s[u] += __shfl_xor(s[u], o); }
        const float mn = fmaxf(fmaxf(m, fmaxf(s[0], s[1])), fmaxf(s[2], s[3])), a = exp2f(m - mn);
        l *= a; o0 *= a; o1 *= a; m = mn;
#pragma unroll
        for (int u = 0; u < 4; ++u) { const float pe = exp2f(s[u] - mn); l += pe;
            o0 += pe * bf2f(VD[(size_t)(tk + u) * 512 + h * 128 + lane]); o1 += pe * bf2f(VD[(size_t)(tk + u) * 512 + h * 128 + 64 + lane]); }
    }
    for (; tk <= t; ++tk) {
        const float s = wave_sum(q * bf2f(KD[(size_t)tk * 512 + vq * 64 + lane]));
        const float mn = fmaxf(m, s), a = exp2f(m - mn), pe = exp2f(s - mn);
        l = l * a + pe; o0 = o0 * a + pe * bf2f(VD[(size_t)tk * 512 + h * 128 + lane]); o1 = o1 * a + pe * bf2f(VD[(size_t)tk * 512 + h * 128 + 64 + lane]); m = mn;
    }
    bf16* O = (bf16*)(P.ws + (c ? WS_DO1 : WS_DO0));
    O[(size_t)t * 512 + h * 128 + lane] = (bf16)f2bf(o0 / l); O[(size_t)t * 512 + h * 128 + 64 + lane] = (bf16)f2bf(o1 / l);
}

__global__ void __launch_bounds__(256) k_merge(Ptrs P) {
    const int t = blockIdx.x * 4 + (threadIdx.x >> 6), lane = threadIdx.x & 63;
    const float lam = lam_value(P, lane);
    merge_row(P, t, lane, lam, (bf16*)(P.ws + WS_G));
}

__global__ void k_nstats(Ptrs P) {
    const int t = blockIdx.x * blockDim.x + threadIdx.x; if (t >= SEQ) return;
    const float2* st = (const float2*)(P.ws + WS_STAT) + (size_t)t * 32; float s = 0.f, s2 = 0.f;
    for (int i = 0; i < 32; ++i) { s += st[i].x; s2 += st[i].y; }
    const float mu = s * (1.f / SGU_W), var = s2 * (1.f / SGU_W) - mu * mu;
    ((float2*)(P.ws + WS_MUR))[t] = make_float2(mu, rsqrtf(var + LN_EPS));
}
__global__ void __launch_bounds__(256) k_nsgu(Ptrs P) {
    const int n = blockIdx.x >> 3, g = blockIdx.x & 7, c = g * 256 + threadIdx.x;
    const bf16* GV = (const bf16*)(P.ws + WS_GV); bf16* UG = (bf16*)(P.ws + WS_UG); const float2* mur = (const float2*)(P.ws + WS_MUR);
    const float lg = P.ln_g[c], lb = P.ln_b[c];
    for (int t = 0; t < 128; ++t) {
        const float* wrow = P.w_s + ((size_t)g * 128 + t) * 128; float acc = 0.f;
        for (int s = 0; s <= t; ++s) { const float2 mr = mur[n * 128 + s]; const float vn = (bf2f(GV[(size_t)(n * 128 + s) * SGU_W + c]) - mr.x) * mr.y * lg + lb; acc += wrow[s] * vn; }
        acc += P.b_s[g * 128 + t];
        const size_t o = (size_t)(n * 128 + t) * SGU_W + c;
        UG[o] = (bf16)f2bf(bf2f(UG[o]) * acc);
    }
}

#endif
#ifndef FAST_MASK
#define FAST_MASK 0x1FF
#endif
extern "C" void kernel_launch(void* const* d_in, const int* in_sizes, int n_in, void* d_out, int out_size, void* d_ws, size_t ws_size, hipStream_t stream) {
    static int grid = 0;
    if (grid == 0) {
        if (n_in != 20 || in_sizes[0] != SEQ * DM || out_size != SEQ * DM || ws_size < WS_END) { fprintf(stderr, "kernel_launch: unexpected shapes (n_in %d out %d ws %zu); nothing launched\n", n_in, out_size, ws_size); grid = -1; return; }
        int dev = 0, cus = 0, per_cu = 0;
        if (hipGetDevice(&dev) != hipSuccess || hipDeviceGetAttribute(&cus, hipDeviceAttributeMultiprocessorCount, dev) != hipSuccess) { grid = -1; return; }
        if (hipFuncSetAttribute((const void*)mega_fwd, hipFuncAttributeMaxDynamicSharedMemorySize, LDS_BYTES) != hipSuccess) { fprintf(stderr, "kernel_launch: hipFuncSetAttribute failed\n"); grid = -1; return; }
        if (hipOccupancyMaxActiveBlocksPerMultiprocessor(&per_cu, (const void*)mega_fwd, NWAVES * 64, LDS_BYTES) != hipSuccess || per_cu < 1) fprintf(stderr, "kernel_launch: occupancy query reports %d blocks per CU\n", per_cu);
        (void)hipGetLastError();
        grid = cus;
        if (grid != 256) { fprintf(stderr, "kernel_launch: this kernel needs a 256-CU device (got %d)\n", grid); grid = -1; return; }
    }
    if (grid < 0) return;
    if (hipMemsetAsync((char*)d_ws + WS_CTL, 0, CTL_ZERO_BYTES, stream) != hipSuccess) return;
    Args a{};
    { const float** pp = (const float**)&a.p; for (int i = 0; i < 20; ++i) pp[i] = (const float*)d_in[i]; }
    a.p.out = (float*)d_out; a.p.ws = (unsigned char*)d_ws;
    const unsigned mask = FAST_MASK;
    int li = 0;
#if DEBUG_NAIVE
    const Ptrs P = a.p; unsigned char* ws = P.ws;
    if (mask && !(mask & 1u)) { a.ph_lo = 0; a.ph_hi = 1; a.li = li++; hipLaunchKernelGGL(mega_fwd, dim3(grid), dim3(NWAVES * 64), LDS_BYTES, stream, a); }
#endif
    for (int k = 0; k < N_PHASES;) {
        if (mask & (1u << k)) {
            int e = k; while (e < N_PHASES && (mask & (1u << e))) ++e;
            a.ph_lo = k; a.ph_hi = e; a.li = li++;
            hipLaunchKernelGGL(mega_fwd, dim3(grid), dim3(NWAVES * 64), LDS_BYTES, stream, a);
            k = e; continue;
        }
#if DEBUG_NAIVE
        switch (k) {
            case 0: k_rope<<<SEQ * 8 / 256, 256, 0, stream>>>((float2*)(ws + WS_ROPE)); k_rmsnorm<<<SEQ / 4, 256, 0, stream>>>(P.x, P.att_norm, (bf16*)(ws + WS_XN)); break;
            case 1: k_ngemm<1><<<dim3(64, SEQ / 64), 256, 0, stream>>>((const bf16*)(ws + WS_XN), DM, P.att_w_in, ATT_IN, DM, P); break;
            case 2: k_ndsw<<<3 * SEQ * 8 / 4, 256, 0, stream>>>(P); k_ndiff<<<SEQ * 8 / 4, 256, 0, stream>>>(P); break;
            case 3: k_merge<<<SEQ / 4, 256, 0, stream>>>(P); break;
            case 4: k_ngemm<2><<<dim3(16, SEQ / 64), 256, 0, stream>>>((const bf16*)(ws + WS_G), DM, P.att_w_out, DM, DM, P); break;
            case 5: k_rmsnorm<<<SEQ / 4, 256, 0, stream>>>(P.out, P.sgu_norm, (bf16*)(ws + WS_XN)); break;
            case 6: k_ngemm<3><<<dim3(64, SEQ / 64), 256, 0, stream>>>((const bf16*)(ws + WS_XN), DM, P.sgu_w_in, SGU_IN, DM, P); break;
            case 7: k_nstats<<<SEQ / 256, 256, 0, stream>>>(P); k_nsgu<<<128 * 8, 256, 0, stream>>>(P); break;
            case 8: k_ngemm<4><<<dim3(16, SEQ / 64), 256, 0, stream>>>((const bf16*)(ws + WS_UG), SGU_W, P.sgu_w_out, DM, SGU_W, P); break;
        }
#endif
        ++k;
    }
}
```
